# Optimizing an MI355X kernel written in HIP

```python
import math
import jax, jax.numpy as jnp
from jax import lax
import numpy as np

D_MODEL = 1024
BATCH = 8
SEQ = 2048
DEPTH = 1
DEC_BATCH = 128
DEC_SEQ = 8
PAST_LEN = 16384
PAGE_SIZE = 128

DN_HEADS = D_MODEL // 128
DN_DK = 128
DN_DV = 128
DN_KEY_WIDTH = DN_HEADS * DN_DK
DN_VAL_WIDTH = DN_HEADS * DN_DV
DN_QKV = 2 * DN_KEY_WIDTH + DN_VAL_WIDTH
CONV_W = 4
DN_CHUNK = 64
SGU_CHUNK = 128
SGU_GC = 128
SGU_GROUPS = D_MODEL // 256
SGU_WIDTH = SGU_GROUPS * SGU_GC
MEM_TOKENS = 256
MEM_HEADS = 4
MEM_HD = D_MODEL // 8
MEM_WIDTH = MEM_HEADS * MEM_HD
N_BRANCH = 3
D_FF = -(-8 * D_MODEL // (3 * 256)) * 256
IN_SPLITS = (DN_QKV, DN_VAL_WIDTH, DN_HEADS, DN_HEADS, SGU_WIDTH, SGU_WIDTH, MEM_WIDTH, N_BRANCH * D_MODEL)
D_IN = sum(IN_SPLITS)
RMS_EPS = 1e-6
L2_EPS = 1e-6

kernel_name = 'hybrid_deltanet_sgu_memory_step'


def rmsnorm(x, gain):
    xf = x.astype(jnp.float32)
    y = xf * lax.rsqrt(jnp.mean(xf * xf, axis=-1, keepdims=True) + RMS_EPS)
    return (y * gain.astype(jnp.float32)).astype(x.dtype)


def l2norm(x):
    return x * lax.rsqrt(jnp.sum(x * x, axis=-1, keepdims=True) + L2_EPS)


def short_conv(x_raw, conv0, conv_w):
    T = x_raw.shape[1]
    xc = jnp.concatenate([conv0.astype(x_raw.dtype), x_raw], axis=1)
    y = xc[:, 0:T] * conv_w[0]
    for i in range(1, CONV_W):
        y = y + xc[:, i:i + T] * conv_w[i]
    return jax.nn.silu(y), xc[:, xc.shape[1] - (CONV_W - 1):]


def gated_delta_rule(q, k, v, g, beta, s0):
    B, T, H, DK = q.shape
    DV = v.shape[-1]
    C = DN_CHUNK
    n = -(-T // C)
    pad = n * C - T

    def to_blocks(a):
        a = jnp.pad(a, [(0, 0), (0, pad)] + [(0, 0)] * (a.ndim - 2))
        a = a.reshape((B, n, C) + a.shape[2:])
        return jnp.moveaxis(a, 3, 1)

    q, k, v, g, beta = (to_blocks(a) for a in (q, k, v, g, beta))
    q = q * DK ** -0.5
    g = jnp.cumsum(g, axis=-1)
    causal = jnp.tril(jnp.ones((C, C), dtype=bool))
    strict = jnp.tril(jnp.ones((C, C), dtype=bool), -1)
    decay = jnp.exp(jnp.where(causal, g[..., :, None] - g[..., None, :], -jnp.inf))
    k_beta = k * beta[..., None]
    lmat = jnp.where(strict, jnp.einsum('bhnid,bhnjd->bhnij', k_beta, k) * decay, 0.0)
    eye = jnp.eye(C, dtype=jnp.float32)
    tmat = lax.linalg.triangular_solve(eye + lmat, jnp.broadcast_to(eye, lmat.shape),
                                       left_side=True, lower=True, unit_diagonal=True)
    u = jnp.einsum('bhnij,bhnje->bhnie', tmat, v * beta[..., None])
    w = jnp.einsum('bhnij,bhnjd->bhnid', tmat, k_beta * jnp.exp(g)[..., None])
    a_intra = jnp.where(causal, jnp.einsum('bhnid,bhnjd->bhnij', q, k) * decay, 0.0)
    q_dec = q * jnp.exp(g)[..., None]
    k_dec = k * jnp.exp(g[..., -1:] - g)[..., None]
    chunk_decay = jnp.exp(g[..., -1])

    def chunk_step(S, blk):
        q_i, k_i, u_i, w_i, a_i, dl = blk
        v_new = u_i - jnp.einsum('bhcd,bhde->bhce', w_i, S)
        o_i = jnp.einsum('bhcd,bhde->bhce', q_i, S) + jnp.einsum('bhcj,bhje->bhce', a_i, v_new)
        S = S * dl[..., None, None] + jnp.einsum('bhcd,bhce->bhde', k_i, v_new)
        return S, o_i

    xs = tuple(jnp.moveaxis(a, 2, 0) for a in (q_dec, k_dec, u, w, a_intra, chunk_decay))
    s_fin, o = lax.scan(chunk_step, s0, xs)
    o = jnp.transpose(o, (1, 0, 3, 2, 4)).reshape(B, n * C, H, DV)[:, :T]
    return o, s_fin


def spatial_gating(u, v, w_s, b_s):
    B, T, W = v.shape
    n = -(-T // SGU_CHUNK)
    pad = n * SGU_CHUNK - T
    vb = jnp.pad(v, ((0, 0), (0, pad), (0, 0))).reshape(B, n, SGU_CHUNK, SGU_GROUPS, SGU_GC)
    causal = jnp.tril(jnp.ones((SGU_CHUNK, SGU_CHUNK), dtype=bool))
    w_c = jnp.where(causal, w_s, 0.0)
    mixed = jnp.einsum('gts,bnsgc->bntgc', w_c, vb) + b_s.T[None, None, :, :, None]
    mixed = mixed.reshape(B, n * SGU_CHUNK, W)[:, :T]
    return u * mixed.astype(u.dtype)


def memory_kv(mem, gain, w_kv):
    B, M, _ = mem.shape
    kv = rmsnorm(mem, gain) @ w_kv
    mk, mv = jnp.split(kv, 2, axis=-1)
    return mk.reshape(B, M, MEM_HEADS, MEM_HD), mv.reshape(B, M, MEM_HEADS, MEM_HD)


def memory_attention(q, mem_k, mem_v):
    s = jnp.einsum('bthd,bmhd->bhtm', q.astype(jnp.float32), mem_k.astype(jnp.float32)) * MEM_HD ** -0.5
    p = jax.nn.softmax(s, axis=-1)
    return jnp.einsum('bhtm,bmhd->bthd', p, mem_v.astype(jnp.float32)).astype(q.dtype)


def block(x, mem_k, mem_v, s0, conv0, lw):
    (norm_mix, w_in, conv_w, a_log, dt_bias, dn_norm, sgu_norm, sgu_w, sgu_b,
     w_br_dn, w_br_sgu, w_br_mem, w_o, norm_ffn, w_gate_up, w_down) = lw
    f32 = jnp.float32
    B, T, _ = x.shape
    xn = rmsnorm(x, norm_mix)
    offsets = np.cumsum(IN_SPLITS)[:-1].tolist()
    qkv_raw, z, beta_raw, a_raw, u_raw, v_raw, q_mem, gate_raw = jnp.split(xn @ w_in, offsets, axis=-1)

    qkv, conv_new = short_conv(qkv_raw, conv0, conv_w)
    q, k, v = jnp.split(qkv.astype(f32), [DN_KEY_WIDTH, 2 * DN_KEY_WIDTH], axis=-1)
    q = l2norm(q.reshape(B, T, DN_HEADS, DN_DK))
    k = l2norm(k.reshape(B, T, DN_HEADS, DN_DK))
    v = v.reshape(B, T, DN_HEADS, DN_DV)
    beta = jax.nn.sigmoid(beta_raw.astype(f32))
    g = -jnp.exp(a_log.astype(f32)) * jax.nn.softplus(a_raw.astype(f32) + dt_bias.astype(f32))
    o_dn, s_new = gated_delta_rule(q, k, v, g, beta, s0.astype(f32))
    o_dn = rmsnorm(o_dn, dn_norm) * jax.nn.silu(z.astype(f32).reshape(B, T, DN_HEADS, DN_DV))
    o_dn = o_dn.reshape(B, T, DN_VAL_WIDTH).astype(x.dtype)

    u_sg = jax.nn.gelu(u_raw)
    v_sg = rmsnorm(jax.nn.gelu(v_raw), sgu_norm)
    o_sg = spatial_gating(u_sg, v_sg, sgu_w, sgu_b)

    o_mem = memory_attention(q_mem.reshape(B, T, MEM_HEADS, MEM_HD), mem_k, mem_v).reshape(B, T, MEM_WIDTH)

    gates = jax.nn.sigmoid(gate_raw).reshape(B, T, N_BRANCH, D_MODEL)
    merged = (gates[:, :, 0] * (o_dn @ w_br_dn)
              + gates[:, :, 1] * (o_sg @ w_br_sgu)
              + gates[:, :, 2] * (o_mem @ w_br_mem))
    x = x + merged @ w_o

    hg, hu = jnp.split(rmsnorm(x, norm_ffn) @ w_gate_up, 2, axis=-1)
    x = x + (jax.nn.silu(hg) * hu) @ w_down
    return x, s_new.astype(s0.dtype), conv_new, v_sg


def setup_inputs(seed: int = 0) -> dict:
    key = jax.random.key(seed)
    ks = jax.random.split(key, 26)
    f32 = jnp.float32
    L = DEPTH

    def nrm(k, shape, scale=1.0):
        return jax.random.normal(k, shape, f32) * scale

    def gain(k, shape):
        return 1.0 + 0.02 * jax.random.normal(k, shape, f32)

    dt = jnp.exp(jax.random.uniform(ks[11], (L, DN_HEADS), f32, math.log(1e-3), math.log(1e-1)))
    dt_bias = dt + jnp.log(-jnp.expm1(-dt))
    return {
        'x_prompt': nrm(ks[0], (BATCH, SEQ, D_MODEL)),
        'x_sample': nrm(ks[1], (DEC_BATCH, DEC_SEQ, D_MODEL)),
        'state_delta': nrm(ks[2], (L, DEC_BATCH, DN_HEADS, DN_DK, DN_DV), 0.5),
        'state_conv': nrm(ks[3], (L, DEC_BATCH, CONV_W - 1, DN_QKV)),
        'cache_mem_k': nrm(ks[4], (L, DEC_BATCH, MEM_TOKENS, MEM_HEADS, MEM_HD)),
        'cache_mem_v': nrm(ks[5], (L, DEC_BATCH, MEM_TOKENS, MEM_HEADS, MEM_HD)),
        'mem_prompt': nrm(ks[6], (BATCH, MEM_TOKENS, D_MODEL)),
        'norm_mix': gain(ks[7], (L, D_MODEL)),
        'w_in': nrm(ks[8], (L, D_MODEL, D_IN), D_MODEL ** -0.5),
        'conv_w': nrm(ks[9], (L, CONV_W, DN_QKV), CONV_W ** -0.5),
        'a_log': jnp.log(jax.random.uniform(ks[10], (L, DN_HEADS), f32, 1.0, 16.0)),
        'dt_bias': dt_bias,
        'dn_norm': gain(ks[12], (L, DN_DV)),
        'sgu_norm': gain(ks[13], (L, SGU_WIDTH)),
        'sgu_w': nrm(ks[14], (L, SGU_GROUPS, SGU_CHUNK, SGU_CHUNK), SGU_CHUNK ** -0.5),
        'sgu_b': gain(ks[15], (L, SGU_GROUPS, SGU_CHUNK)),
        'w_br_dn': nrm(ks[16], (L, DN_VAL_WIDTH, D_MODEL), DN_VAL_WIDTH ** -0.5),
        'w_br_sgu': nrm(ks[17], (L, SGU_WIDTH, D_MODEL), SGU_WIDTH ** -0.5),
        'w_br_mem': nrm(ks[18], (L, MEM_WIDTH, D_MODEL), MEM_WIDTH ** -0.5),
        'w_o': nrm(ks[19], (L, D_MODEL, D_MODEL), D_MODEL ** -0.5),
        'mem_norm': gain(ks[20], (L, D_MODEL)),
        'w_mem_kv': nrm(ks[21], (L, D_MODEL, 2 * MEM_WIDTH), D_MODEL ** -0.5),
        'norm_ffn': gain(ks[22], (L, D_MODEL)),
        'w_gate_up': nrm(ks[23], (L, D_MODEL, 2 * D_FF), D_MODEL ** -0.5),
        'w_down': nrm(ks[24], (L, D_FF, D_MODEL), D_FF ** -0.5),
        'norm_final': gain(ks[25], (D_MODEL,)),
    }


def reference(x_prompt, x_sample, state_delta, state_conv, cache_mem_k, cache_mem_v, mem_prompt,
              norm_mix, w_in, conv_w, a_log, dt_bias, dn_norm, sgu_norm, sgu_w, sgu_b,
              w_br_dn, w_br_sgu, w_br_mem, w_o, mem_norm, w_mem_kv, norm_ffn, w_gate_up, w_down, norm_final):
    xp, xs = x_prompt, x_sample
    bp = xp.shape[0]
    s0_p = jnp.zeros((bp, DN_HEADS, DN_DK, DN_DV), xp.dtype)
    c0_p = jnp.zeros((bp, CONV_W - 1, DN_QKV), xp.dtype)
    dn_p, cv_p, mk_p, mv_p, dn_s, cv_s, sg_s = [], [], [], [], [], [], []
    for l in range(DEPTH):
        lw = (norm_mix[l], w_in[l], conv_w[l], a_log[l], dt_bias[l], dn_norm[l], sgu_norm[l], sgu_w[l], sgu_b[l],
              w_br_dn[l], w_br_sgu[l], w_br_mem[l], w_o[l], norm_ffn[l], w_gate_up[l], w_down[l])
        mem_k, mem_v = memory_kv(mem_prompt, mem_norm[l], w_mem_kv[l])
        xp, s_p, c_p, _ = block(xp, mem_k, mem_v, s0_p, c0_p, lw)
        xs, s_s, c_s, v_s = block(xs, cache_mem_k[l], cache_mem_v[l], state_delta[l], state_conv[l], lw)
        dn_p.append(s_p); cv_p.append(c_p); mk_p.append(mem_k); mv_p.append(mem_v)
        dn_s.append(s_s); cv_s.append(c_s); sg_s.append(v_s)
    y_prompt = rmsnorm(xp, norm_final)
    y_sample = rmsnorm(xs, norm_final)
    return (y_prompt, y_sample, jnp.stack(dn_p), jnp.stack(cv_p), jnp.stack(mk_p), jnp.stack(mv_p),
            jnp.stack(dn_s), jnp.stack(cv_s), jnp.stack(sg_s))
```

```cpp
#ifndef HOST_EMU
#include <hip/hip_runtime.h>
#include <cstdio>
#include <cstdint>
#endif

namespace cfg {
constexpr int D = 1024, NB = 8, SEQ = 2048, DB = 128, DT = 8;
constexpr int MP = NB * SEQ, MS = DB * DT, M = MP + MS;
constexpr int H = 8, DK = 128, DV = 128, QKVW = 3072, CH = 64, NCH = SEQ / CH;
constexpr int SGW = 512, SGG = 4, SGC = 128;
constexpr int MEMT = 256, MEMH = 4, MEMD = 128, MEMW = 512;
constexpr int FF = 2816, DIN = 8720, N1 = 5632, NGATE = 3072, NIN = N1 + NGATE;
constexpr float RMS_EPS = 1e-6f, L2_EPS = 1e-6f;
constexpr float LOG2E = 1.4426950408889634f;
constexpr float QSCALE_MEM = 0.08838834764831845f * 1.4426950408889634f;
constexpr float QSCALE_DN = 0.08838834764831845f;
constexpr size_t O_Y = 0, O_DSP = 17825792, O_CSP = 18874368, O_MK = 18948096, O_MV = 19996672, O_DSS = 21045248, O_CSS = 37822464, O_SGV = 39002112, O_END = 39526400;
constexpr size_t MiB = 1u << 20;
constexpr size_t WS_CTL = 0, CTL_ZERO_BYTES = 1 * MiB;
constexpr size_t WS_RSTDX = 1 * MiB, WS_RSTDM = WS_RSTDX + 128 * 1024, WS_DL = WS_RSTDM + 64 * 1024, WS_BA = 1 * MiB + 256 * 1024;
constexpr size_t WS_SS1 = 5 * MiB / 2, WS_SS2 = 15 * MiB / 4;
constexpr size_t WS_WIN = 5 * MiB, WS_WBR = 22 * MiB, WS_WO = 26 * MiB, WS_WKV = 28 * MiB, WS_WGU = 30 * MiB, WS_WDN = 41 * MiB, WS_SGW = 93 * MiB / 2;
constexpr size_t WS_XB = 47 * MiB;
constexpr size_t WS_MB = 81 * MiB;
constexpr size_t WS_QMEM = 85 * MiB;
constexpr size_t WS_HALO = 102 * MiB;
constexpr size_t WS_QKV = 107 * MiB;
constexpr size_t WS_OCAT = WS_QKV, WS_X1B = WS_QKV + 68 * MiB;
constexpr size_t WS_INTER = 209 * MiB;
constexpr size_t WS_WB = WS_INTER, WS_QD = WS_INTER + 32 * MiB, WS_KDT = WS_INTER + 64 * MiB, WS_UB = WS_INTER + 96 * MiB, WS_AB = WS_INTER + 128 * MiB;
constexpr size_t WS_GATES = WS_INTER, WS_HB = WS_INTER, WS_MERGED = WS_XB;
constexpr size_t WS_END = 353 * MiB;
static_assert(WS_BA + (size_t)M * 16 * 4 <= WS_SS1 && WS_SS1 + (size_t)M * 64 <= WS_SS2 && WS_SS2 + (size_t)M * 64 <= WS_WIN, "small buffers");
static_assert(WS_WIN + (size_t)NIN * D * 2 <= WS_WBR && WS_WGU + (size_t)2 * FF * D * 2 <= WS_WDN && WS_WDN + (size_t)D * FF * 2 <= WS_SGW && WS_SGW + 4 * 128 * 128 * 2 <= WS_XB, "weights");
static_assert(WS_XB + (size_t)M * D * 2 <= WS_MB && WS_MB + 2048 * 1024 * 2 <= WS_QMEM && WS_QMEM + (size_t)M * 512 * 2 <= WS_HALO && WS_HALO + 272 * 3 * 3072 * 2 <= WS_QKV, "acts");
static_assert(WS_QKV + (size_t)M * 3072 * 2 <= WS_INTER && WS_X1B + (size_t)M * D * 2 <= WS_INTER && WS_OCAT + (size_t)M * 2048 * 2 <= WS_X1B, "qkv region");
static_assert(WS_AB + (size_t)2048 * 8192 <= WS_END && WS_GATES + (size_t)M * 3072 * 2 <= WS_END && WS_HB + (size_t)M * FF * 2 <= WS_END, "inter region");
constexpr int CW_TMO = 0, CW_CODE = 1, CW_BAR = 4096;
constexpr int RING_BYTES = 131072, LDS_BYTES = 163840, MISC_OFF = LDS_BYTES - 512;
constexpr int P2_LDS = MISC_OFF;
}

typedef unsigned short bf16;
typedef short bf16x8 __attribute__((ext_vector_type(8)));
typedef float f32x4 __attribute__((ext_vector_type(4)));
typedef float f32x16 __attribute__((ext_vector_type(16)));
typedef unsigned u32x4 __attribute__((ext_vector_type(4)));
typedef unsigned u32x2 __attribute__((ext_vector_type(2)));

#ifndef HOST_EMU
#define DI __device__ __forceinline__
#define LP(T) __attribute__((address_space(3))) T*
DI int t_id() { int t = (int)threadIdx.x; asm volatile("" : "+v"(t)); return t; }
DI void wg_sync() { __syncthreads(); }
DI f32x4 mfma16(bf16x8 a, bf16x8 b, f32x4 c) { return __builtin_amdgcn_mfma_f32_16x16x32_bf16(a, b, c, 0, 0, 0); }
DI f32x16 mfma32(bf16x8 a, bf16x8 b, f32x16 c) { return __builtin_amdgcn_mfma_f32_32x32x16_bf16(a, b, c, 0, 0, 0); }
DI f32x4 mfma16f(float a, float b, f32x4 c) { return __builtin_amdgcn_mfma_f32_16x16x4f32(a, b, c, 0, 0, 0); }
DI float shfl_xor_f(float v, int m) { return __shfl_xor(v, m); }
DI float shfl_f(float v, int src) { return __shfl(v, src); }
DI float fexp2(float x) { return __builtin_amdgcn_exp2f(x); }
DI float frcp(float x) { return __builtin_amdgcn_rcpf(x); }
DI float frsq(float x) { return __builtin_amdgcn_rsqf(x); }
#endif

DI unsigned f2bf(float f) { unsigned u = __builtin_bit_cast(unsigned, f); return (u + 0x7fffu + ((u >> 16) & 1u)) >> 16; }
DI unsigned pk2(float lo, float hi) { return f2bf(lo) | (f2bf(hi) << 16); }
DI float bf_lo(unsigned w) { return __builtin_bit_cast(float, w << 16); }
DI float bf_hi(unsigned w) { return __builtin_bit_cast(float, w & 0xffff0000u); }
DI float bf2f(bf16 b) { return __builtin_bit_cast(float, ((unsigned)b) << 16); }
DI float sigmoid_f(float x) { return frcp(1.0f + fexp2(-cfg::LOG2E * x)); }
DI float silu_f(float x) { return x * sigmoid_f(x); }
DI float gelu_tanh_f(float x) { return x * frcp(1.0f + fexp2(-2.302208198f * (x + 0.044715f * x * x * x))); }
DI float wave_sum(float v) {
#pragma unroll
    for (int o = 1; o < 64; o <<= 1) v += shfl_xor_f(v, o);
    return v;
}
DI int perm32k(int k) { const int kk = k & 31; return (k & ~31) + 8 * ((kk & 15) >> 2) + 4 * (kk >> 4) + (kk & 3); }
DI int iperm32k(int p) { const int pp = p & 31; return (p & ~31) + 16 * ((pp >> 2) & 1) + 4 * (pp >> 3) + (pp & 3); }
DI int perm16k(int k) { const int kk = k & 15; return (k & ~15) + 8 * ((kk >> 2) & 1) + 4 * (kk >> 3) + (kk & 3); }
#ifndef HOST_EMU
namespace pg8 {
#define PG8_LAS __attribute__((address_space(3)))
typedef unsigned short bf16_t;
typedef unsigned u32x4 __attribute__((ext_vector_type(4)));
constexpr int BM = 256, BK = 64, HALF = 128, HTB = HALF * BK * 2  , STAGE_BYTES = 8 * HTB, NXCD = 8, WGM = 8;

__host__ __device__ __forceinline__ int lds_byte(int r, int c) { const int st = (r >> 4) * 2 + (c >> 5), rr = r & 15, cc = c & 31, ob = rr * 64 + cc * 2; return st * 1024 + (ob ^ (((ob >> 9) & 1) << 5)); }
__host__ __device__ __forceinline__ void stage_rc(int b, int& R, int& C) { const int st = b / 1024, sb = b % 1024, swz = sb ^ (((sb >> 9) & 1) << 5); R = (st >> 1) * 16 + swz / 64; C = (st & 1) * 32 + (swz % 64) / 2; }
__host__ __device__ __forceinline__ int perm32(int rho) { const int n = rho >> 4, i = rho & 15; return 8 * (i >> 2) + 4 * n + (i & 3); }

struct Unit { int pm, pn; };
struct Gemm { const bf16_t* A; const bf16_t* Bt; int M, N, K, lda, ldb; };

struct StaticOrder {
    int nM, nN, nwg, G, c;
    __host__ __device__ void init(int M, int N, int G_, int c_) { nM = M / BM; nN = N / BM; nwg = nM * nN; G = G_; c = c_; }
    __host__ __device__ bool next(int i, Unit& u) const {
        const long L = (long)i * G + c; if (L >= nwg) return false;
        int wgid = (int)L; { const int q = nwg / NXCD, r = nwg % NXCD, xcd = wgid % NXCD, off = wgid / NXCD; wgid = (xcd < r ? xcd * (q + 1) : r * (q + 1) + (xcd - r) * q) + off; }
        const int nig = WGM * nN, gid = wgid / nig, fm = gid * WGM, gsz = (nM - fm) < WGM ? (nM - fm) : WGM;
        u.pm = fm + ((wgid % nig) % gsz); u.pn = (wgid % nig) / gsz; return true;
    }
    __device__ __forceinline__ void a_ready(const Unit&) const {}
    __device__ __forceinline__ void done(const Unit&) const {}
};

__device__ __forceinline__ unsigned cvt_pk_bf16(float lo, float hi) { unsigned r; asm volatile("v_cvt_pk_bf16_f32 %0, %1, %2" : "=v"(r) : "v"(lo), "v"(hi)); return r; }
template <class Epi, class Sched, bool ALIGN_EPI = false, bool SP2 = false>
__device__ __forceinline__ void gemm_phase(PG8_LAS unsigned char* lds, const Gemm g, const Sched& S, const Epi& E) {
    const int tid = t_id(), wid = __builtin_amdgcn_readfirstlane(tid >> 6), lane = tid & 63, wr = wid >> 2, wc = wid & 3, fr = lane & 15, fq = lane >> 4;
    const int K = g.K, nt = K / BK;
    unsigned voffA[2], voffB[2];
#pragma unroll
    for (int i = 0; i < 2; ++i) { int R, C; stage_rc(tid * 16 + i * 8192, R, C); const int Rb = Epi::PERM ? ((R & ~31) + perm32(R & 31)) : R;
        voffA[i] = (unsigned)(R * g.lda + C) * 2u; voffB[i] = (unsigned)(Rb * g.ldb + C) * 2u; }
    const size_t kstep = (size_t)(BK * 2);
    const size_t hstepA = (size_t)HALF * g.lda * 2, hstepB = (size_t)HALF * g.ldb * 2;
    const size_t tstepA = 2 * hstepA, tstepB = 2 * hstepB;
    const unsigned ldsw = (unsigned)wid * 1024u;
    const int aoff = lds_byte(wr * 64 + fr, fq * 8), boff = lds_byte(wc * 32 + fr, fq * 8);
#define PG8_SA(b, h) (((b) * 2 + (h)) * HTB)
#define PG8_SB(b, h) ((4 + (b) * 2 + (h)) * HTB)
#define PG8_STAGE(bufoff, gbase, voff) do { _Pragma("unroll") for (int _i = 0; _i < 2; ++_i) \
        __builtin_amdgcn_global_load_lds((const unsigned*)((const char*)(gbase) + (voff)[_i]), (PG8_LAS unsigned*)(lds + (bufoff) + ldsw + _i * 8192), 16, 0, 0); } while (0)
#define PG8_LDA(dst, b, h) do { _Pragma("unroll") for (int m = 0; m < 4; ++m) _Pragma("unroll") for (int k = 0; k < 2; ++k) dst[m][k] = *(const PG8_LAS bf16x8*)(lds + PG8_SA(b, h) + aoff + m * 2048 + k * 1024); } while (0)
#define PG8_LDB(dst, b, h) do { _Pragma("unroll") for (int n = 0; n < 2; ++n) _Pragma("unroll") for (int k = 0; k < 2; ++k) dst[n][k] = *(const PG8_LAS bf16x8*)(lds + PG8_SB(b, h) + boff + n * 2048 + k * 1024); } while (0)
#define PG8_MMA(ai, bj, At, Bt) do { __builtin_amdgcn_s_setprio(1); _Pragma("unroll") for (int m = 0; m < 4; ++m) _Pragma("unroll") for (int n = 0; n < 2; ++n) _Pragma("unroll") for (int k = 0; k < 2; ++k) \
        acc[ai][bj][m][n] = __builtin_amdgcn_mfma_f32_16x16x32_bf16(Bt[n][k], At[m][k], acc[ai][bj][m][n], 0, 0, 0); __builtin_amdgcn_s_setprio(0); } while (0)
#define PG8_WAIT_V(n) asm volatile("s_waitcnt vmcnt(" #n ")" ::: "memory")
#define PG8_WAIT_L(n) asm volatile("s_waitcnt lgkmcnt(" #n ")" ::: "memory")
#define PG8_BAR __builtin_amdgcn_s_barrier()
#define PG8_SCHED __builtin_amdgcn_sched_barrier(0)
    Unit cur, nxt; int ui = 0;
    if (!S.next(0, cur)) return;
    f32x4 acc[2][2][4][2];
#pragma unroll
    for (int a = 0; a < 2; ++a)
#pragma unroll
        for (int b = 0; b < 2; ++b)
#pragma unroll
            for (int m = 0; m < 4; ++m)
#pragma unroll
                for (int n = 0; n < 2; ++n) acc[a][b][m][n] = (f32x4){0.f, 0.f, 0.f, 0.f};
    bf16x8 At[4][2], B0[2][2], B1[2][2];
    const char* cA = (const char*)g.A + (size_t)cur.pm * tstepA; const char* cB = (const char*)g.Bt + (size_t)cur.pn * tstepB;
    S.a_ready(cur);
    if constexpr (SP2) {
        PG8_STAGE(PG8_SB(0, 0), cB, voffB); PG8_STAGE(PG8_SB(0, 1), cB + hstepB, voffB); PG8_STAGE(PG8_SA(0, 0), cA, voffA); PG8_STAGE(PG8_SA(0, 1), cA + hstepA, voffA);
        if (wr == 1) PG8_BAR;
        PG8_WAIT_V(2); PG8_BAR;
        PG8_STAGE(PG8_SB(1, 0), cB + kstep, voffB); PG8_STAGE(PG8_SA(1, 0), cA + kstep, voffA); PG8_STAGE(PG8_SB(1, 1), cB + hstepB + kstep, voffB);
        PG8_WAIT_V(6); PG8_BAR;
    } else {
        PG8_STAGE(PG8_SB(0, 0), cB, voffB); PG8_STAGE(PG8_SA(0, 0), cA, voffA); PG8_STAGE(PG8_SB(0, 1), cB + hstepB, voffB); PG8_STAGE(PG8_SA(0, 1), cA + hstepA, voffA);
        if (wr == 1) PG8_BAR;
        PG8_WAIT_V(4); PG8_BAR;
        PG8_STAGE(PG8_SB(1, 0), cB + kstep, voffB); PG8_STAGE(PG8_SA(1, 0), cA + kstep, voffA); PG8_STAGE(PG8_SB(1, 1), cB + hstepB + kstep, voffB);
        PG8_WAIT_V(6); PG8_BAR;
    }
    for (;;) {
        const bool has_next = S.next(ui + 1, nxt);
        const char* nA = has_next ? (const char*)g.A + (size_t)nxt.pm * tstepA : cA; const char* nB = has_next ? (const char*)g.Bt + (size_t)nxt.pn * tstepB : cB;
        for (int t = 0; t < nt; t += 2) {
            const bool last = (t == nt - 2);
            const char* a1 = cA + (size_t)(t + 1) * kstep;
            const char* a2 = last ? nA : cA + (size_t)(t + 2) * kstep; const char* b2 = last ? nB : cB + (size_t)(t + 2) * kstep;
            const char* a3 = a2 + kstep; const char* b3 = b2 + kstep;
            if (last && has_next) S.a_ready(nxt);
            if constexpr (SP2) {
            PG8_LDB(B0, 0, 0); PG8_LDB(B1, 0, 1); PG8_SCHED; PG8_LDA(At, 0, 0); PG8_STAGE(PG8_SA(1, 1), a1 + hstepA, voffA);
            PG8_WAIT_V(8); PG8_WAIT_L(0); PG8_BAR; PG8_MMA(0, 0, At, B0); PG8_MMA(0, 1, At, B1); PG8_BAR; PG8_SCHED;
            PG8_LDA(At, 0, 1); PG8_STAGE(PG8_SB(0, 0), b2, voffB); PG8_STAGE(PG8_SB(0, 1), b2 + hstepB, voffB); PG8_STAGE(PG8_SA(0, 0), a2, voffA);
            PG8_WAIT_V(8); PG8_WAIT_L(0); PG8_BAR; PG8_MMA(1, 0, At, B0); PG8_MMA(1, 1, At, B1); PG8_BAR; PG8_SCHED;
            PG8_LDB(B0, 1, 0); PG8_LDB(B1, 1, 1); PG8_SCHED; PG8_LDA(At, 1, 0); PG8_STAGE(PG8_SA(0, 1), a2 + hstepA, voffA);
            PG8_WAIT_V(8); PG8_WAIT_L(0); PG8_BAR; PG8_MMA(0, 0, At, B0); PG8_MMA(0, 1, At, B1); PG8_BAR; PG8_SCHED;
            PG8_LDA(At, 1, 1); PG8_STAGE(PG8_SB(1, 0), b3, voffB); PG8_STAGE(PG8_SB(1, 1), b3 + hstepB, voffB); PG8_STAGE(PG8_SA(1, 0), a3, voffA);
            PG8_WAIT_V(8); PG8_WAIT_L(0); PG8_BAR; PG8_MMA(1, 0, At, B0); PG8_MMA(1, 1, At, B1); PG8_BAR; PG8_SCHED;
            } else {
            PG8_LDB(B0, 0, 0); PG8_SCHED; PG8_LDA(At, 0, 0); PG8_STAGE(PG8_SA(1, 1), a1 + hstepA, voffA);
            PG8_WAIT_L(8); PG8_BAR; PG8_WAIT_L(0); PG8_MMA(0, 0, At, B0); PG8_BAR; PG8_SCHED;
            PG8_LDB(B1, 0, 1); PG8_STAGE(PG8_SB(0, 0), b2, voffB);
            PG8_BAR; PG8_WAIT_L(0); PG8_MMA(0, 1, At, B1); PG8_BAR;
            PG8_LDA(At, 0, 1); PG8_STAGE(PG8_SA(0, 0), a2, voffA);
            PG8_BAR; PG8_WAIT_L(0); PG8_MMA(1, 0, At, B0); PG8_BAR; PG8_SCHED;
            PG8_STAGE(PG8_SB(0, 1), b2 + hstepB, voffB);
            PG8_WAIT_V(6); PG8_BAR; PG8_MMA(1, 1, At, B1); PG8_BAR;
            PG8_LDB(B0, 1, 0); PG8_SCHED; PG8_LDA(At, 1, 0); PG8_STAGE(PG8_SA(0, 1), a2 + hstepA, voffA);
            PG8_WAIT_L(8); PG8_BAR; PG8_WAIT_L(0); PG8_MMA(0, 0, At, B0); PG8_BAR; PG8_SCHED;
            PG8_LDB(B1, 1, 1); PG8_STAGE(PG8_SB(1, 0), b3, voffB);
            PG8_BAR; PG8_WAIT_L(0); PG8_MMA(0, 1, At, B1); PG8_BAR;
            PG8_LDA(At, 1, 1); PG8_STAGE(PG8_SA(1, 0), a3, voffA);
            PG8_BAR; PG8_WAIT_L(0); PG8_MMA(1, 0, At, B0); PG8_BAR; PG8_SCHED;
            PG8_STAGE(PG8_SB(1, 1), b3 + hstepB, voffB);
            PG8_WAIT_V(6); PG8_BAR; PG8_MMA(1, 1, At, B1); PG8_BAR;
            }
        }
        if constexpr (ALIGN_EPI) { if (wr == 0) PG8_BAR; }
        if constexpr (!Epi::AFTER_DRAIN) { E(acc, cur, wr, wc, fr, fq); S.done(cur); }
        if (!has_next) break;
#pragma unroll
        for (int a = 0; a < 2; ++a)
#pragma unroll
            for (int b = 0; b < 2; ++b)
#pragma unroll
                for (int m = 0; m < 4; ++m)
#pragma unroll
                    for (int n = 0; n < 2; ++n) acc[a][b][m][n] = (f32x4){0.f, 0.f, 0.f, 0.f};
        cur = nxt; cA = nA; cB = nB; ++ui;
        if constexpr (ALIGN_EPI) { if (wr == 1) PG8_BAR; }
    }
    PG8_WAIT_V(0);
    if constexpr (!ALIGN_EPI) { if (wr == 0) PG8_BAR; }
    PG8_BAR;
    if constexpr (Epi::AFTER_DRAIN) { E.fused(acc, cur, wr, wc, fr, fq, lds, wid, lane); S.done(cur); }
#undef PG8_SA
#undef PG8_SB
#undef PG8_STAGE
#undef PG8_LDA
#undef PG8_LDB
#undef PG8_MMA
#undef PG8_WAIT_V
#undef PG8_WAIT_L
#undef PG8_BAR
#undef PG8_SCHED
}
}
#define GAS __attribute__((address_space(1)))
#define LAS __attribute__((address_space(3)))
typedef unsigned short bf16;
typedef unsigned v4u __attribute__((ext_vector_type(4)));
typedef float f32x4 __attribute__((ext_vector_type(4)));
typedef short bf16x8 __attribute__((ext_vector_type(8)));
typedef GAS unsigned gu32;
typedef GAS unsigned long long gu64;
#define RLX_AGENT __ATOMIC_RELAXED, __HIP_MEMORY_SCOPE_AGENT
#define LDS_WAIT() asm volatile("s_waitcnt lgkmcnt(0)" ::: "memory")
#define VM_WAIT() asm volatile("s_waitcnt vmcnt(0)" ::: "memory")
__device__ __forceinline__ unsigned long long rt() { return __builtin_amdgcn_s_memrealtime(); }

#define XB_TMO      128
#define XB_XCNT(j)  (256  + 64 * (j))
#define XB_XSUB(j)  (1280 + 64 * (j))
#define XB_XGEN(j)  (2304 + 64 * (j))
#define XB_TOP      3328
#define XB_TOPGEN   3392
#define XCD_BAR_WORDS 3456
#define XB_SPIN_CAP (1u << 18)

__device__ __forceinline__ unsigned xb_ld(unsigned* p)              { return __hip_atomic_load(p, __ATOMIC_RELAXED, __HIP_MEMORY_SCOPE_AGENT); }
__device__ __forceinline__ unsigned xb_add(unsigned* p, unsigned v) { return __hip_atomic_fetch_add(p, v, __ATOMIC_RELAXED, __HIP_MEMORY_SCOPE_AGENT); }
__device__ __forceinline__ unsigned xb_xcc_id() { return (unsigned)__builtin_amdgcn_s_getreg((3 << 11) | 20) & 0xFu; }
#define XB_SPIN(cond, bar) do { unsigned _sp = 0; while (cond) { __builtin_amdgcn_s_sleep(1); \
    if ((++_sp & 255u) == 0u) { if (xb_ld(&(bar)[XB_TMO])) break; if (_sp > XB_SPIN_CAP) { atomicAdd(&(bar)[XB_TMO], 1u); break; } } } } while (0)

struct XcdBarrier {
    unsigned* bar; unsigned x;
    volatile LAS unsigned* st;
};

__device__ __forceinline__ XcdBarrier xcd_barrier_post(unsigned* bar, volatile LAS unsigned* st) {
    XcdBarrier b; b.bar = bar; b.x = xb_xcc_id(); b.st = st;
    if (threadIdx.x == 0) (void)xb_add(&bar[XB_XCNT(b.x)], 1u);
    return b;
}
__device__ __forceinline__ void xcd_barrier_complete(unsigned* bar, unsigned x, unsigned& nloc, unsigned& nx) {
    const unsigned G = gridDim.x * gridDim.y * gridDim.z;
    unsigned sum, cnt, mine, sp = 0u;
    for (;;) {
        sum = 0u; cnt = 0u; mine = 0u;
#pragma unroll
        for (unsigned j = 0; j < 16; ++j) { const unsigned c = xb_ld(&bar[XB_XCNT(j)]); sum += c; cnt += (c > 0u) ? 1u : 0u; mine = (j == x) ? c : mine; }
        if (sum == G) break;
        __builtin_amdgcn_s_sleep(1);
        if ((++sp & 255u) == 0u) { if (xb_ld(&bar[XB_TMO])) break; if (sp > XB_SPIN_CAP) { atomicAdd(&bar[XB_TMO], 1u); break; } }
    }
    nloc = mine > 0u ? mine : 1u; nx = cnt > 0u ? cnt : 1u;
}

__device__ __forceinline__ void xcd_barrier(const XcdBarrier& b) {
    asm volatile("s_waitcnt vmcnt(0)" ::: "memory");
    __syncthreads();
    if (threadIdx.x == 0) {
        unsigned* bar = b.bar;
        __builtin_amdgcn_s_waitcnt(0);
        unsigned nloc = b.st[0], nx = b.st[1];
        if (nloc == 0u) { xcd_barrier_complete(bar, b.x, nloc, nx); b.st[0] = nloc; b.st[1] = nx; }
        const unsigned old = xb_add(&bar[XB_XSUB(b.x)], 1u);
        const unsigned gen = old / nloc;
        if (old + 1u == (gen + 1u) * nloc) {
            __builtin_amdgcn_fence(__ATOMIC_RELEASE, "agent");
            asm volatile("s_waitcnt vmcnt(0)" ::: "memory");
            const unsigned og = xb_add(&bar[XB_TOP], 1u);
            const unsigned tg = og / nx;
            if (og + 1u == (tg + 1u) * nx) xb_add(&bar[XB_TOPGEN], 1u);
            else XB_SPIN(xb_ld(&bar[XB_TOPGEN]) == tg, bar);
            __builtin_amdgcn_fence(__ATOMIC_ACQUIRE, "agent");
            xb_add(&bar[XB_XGEN(b.x)], 1u);
            asm volatile("s_waitcnt vmcnt(0)" ::: "memory");
        } else {
            XB_SPIN(xb_ld(&bar[XB_XGEN(b.x)]) == gen, bar);
            __builtin_amdgcn_fence(__ATOMIC_ACQUIRE, "agent");
            asm volatile("s_waitcnt vmcnt(0)" ::: "memory");
        }
    }
    __syncthreads();
}
#endif
struct DnPtrs {
    const bf16* QKV; const bf16* HALO; const float* BA; const float* conv_w; const float* a_log; const float* dt_bias; const float* dn_norm;
    bf16* WB; bf16* QD; bf16* KDT; unsigned* UB; bf16* AB; float* DL;
    const bf16* Z; bf16* OCAT; float* DSP;
    const float* state_delta; const float* state_conv; float* DSS;
};
namespace dn {
using namespace cfg;
constexpr int QN_LD = 136, TB_LD = 72, LM_LD = 65;
constexpr int L_QN = 0, L_KN = L_QN + 64 * QN_LD * 2, L_VBT = L_KN + 64 * QN_LD * 2, L_KBGT = L_VBT + 128 * TB_LD * 2, L_KDT = L_KBGT + 128 * TB_LD * 2,
              L_LM = L_KDT + 128 * 64 * 2, L_TM = L_LM + 64 * LM_LD * 4, L_TB = L_TM + 64 * LM_LD * 4, L_GC = L_TB + 64 * TB_LD * 2, L_BETA = L_GC + 256, L_PREP_END = L_BETA + 256;
static_assert(L_PREP_END <= P2_LDS, "prep LDS");

DI float softplus_f(float x) { return (x > 0.f ? x : 0.f) + log1pf(expf(-fabsf(x))); }

DI void prep_item(LP(unsigned char) lds, const DnPtrs& P, int b, int h, int n) {
    const int tid = t_id(), w = tid >> 6, l = tid & 63, fr = l & 15, fq = l >> 4;
    const int row0 = b * SEQ + n * CH, it = (b * H + h) * NCH + n, gch = row0 >> 6;
    LP(bf16) QN = (LP(bf16))(lds + L_QN); LP(bf16) KN = (LP(bf16))(lds + L_KN); LP(bf16) VBT = (LP(bf16))(lds + L_VBT); LP(bf16) KBGT = (LP(bf16))(lds + L_KBGT);
    LP(bf16) KDTl = (LP(bf16))(lds + L_KDT); LP(float) LM = (LP(float))(lds + L_LM); LP(float) TM = (LP(float))(lds + L_TM); LP(bf16) TB = (LP(bf16))(lds + L_TB);
    LP(float) GC = (LP(float))(lds + L_GC); LP(float) BETA = (LP(float))(lds + L_BETA);
    wg_sync();
    float beta_t, gc_t;
    {
        const float* ba = P.BA + (size_t)(row0 + l) * 16;
        beta_t = 1.0f / (1.0f + expf(-ba[h]));
        const float g = -expf(P.a_log[h]) * softplus_f(ba[8 + h] + P.dt_bias[h]);
        gc_t = g;
#pragma unroll
        for (int o = 1; o < 64; o <<= 1) { const float up = shfl_f(gc_t, (l - o) & 63); if (l >= o) gc_t += up; }
        if (w == 0) { GC[l] = gc_t; BETA[l] = beta_t; }
    }
    const float gc_last = shfl_f(gc_t, 63);
    {
        const int c0 = iperm32k(2 * l);
        float wq[4][2], wk[4][2], wv[4][2];
#pragma unroll
        for (int i = 0; i < 4; ++i)
#pragma unroll
            for (int e = 0; e < 2; ++e) { wq[i][e] = P.conv_w[i * QKVW + h * 128 + c0 + e]; wk[i][e] = P.conv_w[i * QKVW + 1024 + h * 128 + c0 + e]; wv[i][e] = P.conv_w[i * QKVW + 2048 + h * 128 + c0 + e]; }
        float xq[11][2], xk[11][2], xv[11][2];
#pragma unroll
        for (int i = 0; i < 11; ++i) {
            const int rt = 8 * w - 3 + i;
            unsigned uq = 0, uk = 0, uv = 0;
            if (rt >= 0) { const bf16* p = P.QKV + (size_t)(row0 + rt) * QKVW + h * 128 + c0; uq = *(const unsigned*)p; uk = *(const unsigned*)(p + 1024); uv = *(const unsigned*)(p + 2048); }
            else if (n > 0) { const bf16* p = P.HALO + ((size_t)(gch - 1) * 3 + (rt + 3)) * QKVW + h * 128 + c0; uq = *(const unsigned*)p; uk = *(const unsigned*)(p + 1024); uv = *(const unsigned*)(p + 2048); }
            xq[i][0] = bf_lo(uq); xq[i][1] = bf_hi(uq); xk[i][0] = bf_lo(uk); xk[i][1] = bf_hi(uk); xv[i][0] = bf_lo(uv); xv[i][1] = bf_hi(uv);
        }
        float kbg_prev[2] = {0.f, 0.f}, kd_prev[2] = {0.f, 0.f}, vb_prev[2] = {0.f, 0.f};
#pragma unroll
        for (int j = 0; j < 8; ++j) {
            const int t = 8 * w + j;
            float q[2], k[2], v[2];
#pragma unroll
            for (int e = 0; e < 2; ++e) {
                q[e] = silu_f(xq[j][e] * wq[0][e] + xq[j + 1][e] * wq[1][e] + xq[j + 2][e] * wq[2][e] + xq[j + 3][e] * wq[3][e]);
                k[e] = silu_f(xk[j][e] * wk[0][e] + xk[j + 1][e] * wk[1][e] + xk[j + 2][e] * wk[2][e] + xk[j + 3][e] * wk[3][e]);
                v[e] = silu_f(xv[j][e] * wv[0][e] + xv[j + 1][e] * wv[1][e] + xv[j + 2][e] * wv[2][e] + xv[j + 3][e] * wv[3][e]);
            }
            const float sq = wave_sum(q[0] * q[0] + q[1] * q[1]), sk = wave_sum(k[0] * k[0] + k[1] * k[1]);
            const float rq = 1.0f / sqrtf(sq + L2_EPS), rk = 1.0f / sqrtf(sk + L2_EPS);
            const float bt = shfl_f(beta_t, t), gt = shfl_f(gc_t, t);
            const float eg = expf(gt), egl = expf(gc_last - gt);
            q[0] *= rq; q[1] *= rq; k[0] *= rk; k[1] *= rk;
            *(LP(unsigned))(QN + t * QN_LD + 2 * l) = pk2(q[0], q[1]);
            *(LP(unsigned))(KN + t * QN_LD + 2 * l) = pk2(k[0], k[1]);
            *(unsigned*)(P.QD + (size_t)(row0 + t) * D + h * 128 + 2 * l) = pk2(q[0] * eg * QSCALE_DN, q[1] * eg * QSCALE_DN);
            const float kbg[2] = {k[0] * bt * eg, k[1] * bt * eg}, kd[2] = {k[0] * egl, k[1] * egl}, vb[2] = {v[0] * bt, v[1] * bt};
            if (j & 1) {
#pragma unroll
                for (int e = 0; e < 2; ++e) {
                    *(LP(unsigned))(KBGT + (c0 + e) * TB_LD + (t - 1)) = pk2(kbg_prev[e], kbg[e]);
                    *(LP(unsigned))(VBT + (c0 + e) * TB_LD + (t - 1)) = pk2(vb_prev[e], vb[e]);
                    *(LP(unsigned))(KDTl + (c0 + e) * 64 + perm32k(t - 1)) = pk2(kd_prev[e], kd[e]);
                }
            }
            kbg_prev[0] = kbg[0]; kbg_prev[1] = kbg[1]; kd_prev[0] = kd[0]; kd_prev[1] = kd[1]; vb_prev[0] = vb[0]; vb_prev[1] = vb[1];
        }
    }
    wg_sync();
    {
        const int s = w >> 2;
        {
            const int in = w & 3;
            f32x4 acc[2] = {{0.f, 0.f, 0.f, 0.f}, {0.f, 0.f, 0.f, 0.f}};
#pragma unroll
            for (int mm = 0; mm < 2; ++mm) {
                const int jm = 2 * s + mm;
                if (in >= jm) {
#pragma unroll
                    for (int ks = 0; ks < 4; ++ks) {
                        const bf16x8 a = *(LP(bf16x8))(KN + (16 * jm + fr) * QN_LD + 32 * ks + 8 * fq);
                        const bf16x8 bq = *(LP(bf16x8))(QN + (16 * in + fr) * QN_LD + 32 * ks + 8 * fq);
                        acc[mm] = mfma16(a, bq, acc[mm]);
                    }
                }
            }
            const int ti = 16 * in + fr; const float gi = GC[ti];
            float o[8];
#pragma unroll
            for (int mm = 0; mm < 2; ++mm)
#pragma unroll
                for (int r = 0; r < 4; ++r) { const int tj = 32 * s + 16 * mm + 4 * fq + r; o[4 * mm + r] = (ti >= tj) ? acc[mm][r] * expf(gi - GC[tj]) * QSCALE_DN : 0.f; }
            u32x4 pk; pk.x = pk2(o[0], o[1]); pk.y = pk2(o[2], o[3]); pk.z = pk2(o[4], o[5]); pk.w = pk2(o[6], o[7]);
            *(u32x4*)(P.AB + (size_t)it * 4096 + ti * 64 + 32 * s + 8 * fq) = pk;
        }
        const int im = w >> 1;
#pragma unroll
        for (int jj = 0; jj < 2; ++jj) {
            const int jn = 2 * (w & 1) + jj;
            if (jn <= im) {
                f32x4 acc = {0.f, 0.f, 0.f, 0.f};
#pragma unroll
                for (int ks = 0; ks < 4; ++ks) {
                    const bf16x8 a = *(LP(bf16x8))(KN + (16 * im + fr) * QN_LD + 32 * ks + 8 * fq);
                    const bf16x8 bk = *(LP(bf16x8))(KN + (16 * jn + fr) * QN_LD + 32 * ks + 8 * fq);
                    acc = mfma16(a, bk, acc);
                }
                const int tj = 16 * jn + fr; const float gj = GC[tj];
#pragma unroll
                for (int r = 0; r < 4; ++r) { const int ti = 16 * im + 4 * fq + r; LM[ti * LM_LD + tj] = (ti > tj) ? BETA[ti] * acc[r] * expf(GC[ti] - gj) : 0.f; }
            }
        }
    }
    wg_sync();
    if (w == 0) {
        const int I = fq, c = fr;
        float X[16];
#pragma unroll
        for (int r = 0; r < 16; ++r) {
            float a = (c == r) ? 1.f : 0.f;
#pragma unroll
            for (int j = 0; j < r; ++j) a -= LM[(16 * I + r) * LM_LD + 16 * I + j] * X[j];
            X[r] = a;
        }
#pragma unroll
        for (int r = 0; r < 16; ++r) TM[(16 * I + r) * LM_LD + 16 * I + c] = X[r];
    }
    wg_sync();
#pragma unroll
    for (int lev = 1; lev <= 3; ++lev) {
        if (w < 4 - lev) {
            const int J = w, I = w + lev;
            f32x4 y = {0.f, 0.f, 0.f, 0.f};
            for (int K = J; K < I; ++K)
#pragma unroll
                for (int s = 0; s < 4; ++s) y = mfma16f(LM[(16 * I + fr) * LM_LD + 16 * K + 4 * fq + s], TM[(16 * K + 4 * fq + s) * LM_LD + 16 * J + fr], y);
            f32x4 x = {0.f, 0.f, 0.f, 0.f};
#pragma unroll
            for (int s = 0; s < 4; ++s) x = mfma16f(TM[(16 * I + fr) * LM_LD + 16 * I + 4 * fq + s], y[s], x);
#pragma unroll
            for (int r = 0; r < 4; ++r) TM[(16 * I + 4 * fq + r) * LM_LD + 16 * J + fr] = -x[r];
        }
        wg_sync();
    }
    {
        const int i = tid >> 3, j0 = (tid & 7) * 8;
        float v[8];
#pragma unroll
        for (int e = 0; e < 8; ++e) v[e] = ((j0 >> 4) <= (i >> 4)) ? TM[i * LM_LD + j0 + e] : 0.f;
        u32x4 pk; pk.x = pk2(v[0], v[1]); pk.y = pk2(v[2], v[3]); pk.z = pk2(v[4], v[5]); pk.w = pk2(v[6], v[7]);
        *(LP(u32x4))(TB + i * TB_LD + j0) = pk;
    }
    wg_sync();
    {
        f32x4 u[4];
#pragma unroll
        for (int i = 0; i < 4; ++i) {
            u[i] = (f32x4){0.f, 0.f, 0.f, 0.f};
#pragma unroll
            for (int ks = 0; ks < 2; ++ks) if (ks == 0 || i >= 2) {
                const bf16x8 a = *(LP(bf16x8))(TB + (16 * i + fr) * TB_LD + 32 * ks + 8 * fq);
                const bf16x8 bv = *(LP(bf16x8))(VBT + (16 * w + fr) * TB_LD + 32 * ks + 8 * fq);
                u[i] = mfma16(a, bv, u[i]);
            }
            unsigned* ub = P.UB + (size_t)it * 4096 + ((w * 4 + i) * 2) * 64 + l;
            ub[0] = pk2(u[i][0], u[i][1]); ub[64] = pk2(u[i][2], u[i][3]);
        }
        const int s = w >> 1;
#pragma unroll
        for (int nn = 0; nn < 2; ++nn) {
            const int nt = 2 * (w & 1) + nn;
            f32x4 acc[2] = {{0.f, 0.f, 0.f, 0.f}, {0.f, 0.f, 0.f, 0.f}};
#pragma unroll
            for (int mm = 0; mm < 2; ++mm)
#pragma unroll
                for (int ks = 0; ks < 2; ++ks) if (ks == 0 || nt >= 2) {
                    const bf16x8 a = *(LP(bf16x8))(KBGT + (32 * s + 16 * mm + fr) * TB_LD + 32 * ks + 8 * fq);
                    const bf16x8 bt = *(LP(bf16x8))(TB + (16 * nt + fr) * TB_LD + 32 * ks + 8 * fq);
                    acc[mm] = mfma16(a, bt, acc[mm]);
                }
            u32x4 pk; pk.x = pk2(acc[0][0], acc[0][1]); pk.y = pk2(acc[0][2], acc[0][3]); pk.z = pk2(acc[1][0], acc[1][1]); pk.w = pk2(acc[1][2], acc[1][3]);
            *(u32x4*)(P.WB + (size_t)(row0 + 16 * nt + fr) * D + h * 128 + 32 * s + 8 * fq) = pk;
        }
#pragma unroll
        for (int e = 0; e < 2; ++e) { const int o = (tid + 512 * e) * 8; *(u32x4*)(P.KDT + (size_t)it * 8192 + o) = *(LP(u32x4))(KDTl + o); }
        if (tid == 0) P.DL[it] = expf(gc_last);
    }
}

constexpr int W_LD = 136, A_LD = 72;
constexpr int SB_W = 0, SB_Q = SB_W + 64 * W_LD * 2, SB_A = SB_Q + 64 * W_LD * 2, SB_KD = SB_A + 64 * A_LD * 2, SB_SIZE = SB_KD + 128 * A_LD * 2;
constexpr int L_PL = 2 * SB_SIZE, L_RL = L_PL + 8 * 64 * 4, L_OL = L_RL + 64 * 4, L_SCAN_END = L_OL + 64 * W_LD * 2;
static_assert(L_SCAN_END <= P2_LDS, "scan LDS");
DI bf16x8 pack8(const f32x4& a, const f32x4& b) { u32x4 p; p.x = pk2(a[0], a[1]); p.y = pk2(a[2], a[3]); p.z = pk2(b[0], b[1]); p.w = pk2(b[2], b[3]); return __builtin_bit_cast(bf16x8, p); }

DI void scan_item(LP(unsigned char) lds, const DnPtrs& P, int b, int h) {
    const int tid = t_id(), w = tid >> 6, l = tid & 63, fr = l & 15, fq = l >> 4;
    const int it0 = (b * H + h) * NCH;
    LP(float) PL = (LP(float))(lds + L_PL); LP(float) RL = (LP(float))(lds + L_RL); LP(bf16) OL = (LP(bf16))(lds + L_OL);
    f32x4 S[8];
#pragma unroll
    for (int m = 0; m < 8; ++m) S[m] = (f32x4){0.f, 0.f, 0.f, 0.f};
    u32x4 pw[2], pq[2], pa, pkd[2]; unsigned pu[8], ucur[8];
    const float dnn = P.dn_norm[16 * w + fr];
#define DN_LOAD(n_) do { const int it_ = it0 + (n_); const size_t r0_ = (size_t)(b * SEQ + (n_) * CH); \
        _Pragma("unroll") for (int e = 0; e < 2; ++e) { const int p_ = tid + 512 * e; \
            pw[e] = *(const u32x4*)(P.WB + (r0_ + (p_ >> 4)) * D + h * 128 + (p_ & 15) * 8); pq[e] = *(const u32x4*)(P.QD + (r0_ + (p_ >> 4)) * D + h * 128 + (p_ & 15) * 8); \
            pkd[e] = *(const u32x4*)(P.KDT + (size_t)it_ * 8192 + (p_ >> 3) * 64 + (p_ & 7) * 8); } \
        pa = *(const u32x4*)(P.AB + (size_t)it_ * 4096 + (tid >> 3) * 64 + (tid & 7) * 8); \
        _Pragma("unroll") for (int e = 0; e < 8; ++e) pu[e] = P.UB[(size_t)it_ * 4096 + (w * 8 + e) * 64 + l]; } while (0)
#define DN_STORE(buf_) do { LP(unsigned char) sb_ = lds + (buf_) * SB_SIZE; \
        _Pragma("unroll") for (int e = 0; e < 2; ++e) { const int p_ = tid + 512 * e; \
            *(LP(u32x4))(sb_ + SB_W + ((p_ >> 4) * W_LD + (p_ & 15) * 8) * 2) = pw[e]; *(LP(u32x4))(sb_ + SB_Q + ((p_ >> 4) * W_LD + (p_ & 15) * 8) * 2) = pq[e]; \
            *(LP(u32x4))(sb_ + SB_KD + ((p_ >> 3) * A_LD + (p_ & 7) * 8) * 2) = pkd[e]; } \
        *(LP(u32x4))(sb_ + SB_A + ((tid >> 3) * A_LD + (tid & 7) * 8) * 2) = pa; } while (0)
    wg_sync();
    DN_LOAD(0); DN_STORE(0);
#pragma unroll
    for (int e = 0; e < 8; ++e) ucur[e] = pu[e];
    wg_sync();
    for (int n = 0; n < NCH; ++n) {
        const int it = it0 + n; const size_t row0 = (size_t)(b * SEQ + n * CH);
        if (n + 1 < NCH) DN_LOAD(n + 1);
        LP(unsigned char) sb = lds + (n & 1) * SB_SIZE;
        LP(bf16) Wl = (LP(bf16))(sb + SB_W); LP(bf16) Ql = (LP(bf16))(sb + SB_Q); LP(bf16) Al = (LP(bf16))(sb + SB_A); LP(bf16) KDl = (LP(bf16))(sb + SB_KD);
        const float dl = P.DL[it];
        bf16x8 Bs[4];
#pragma unroll
        for (int ks = 0; ks < 4; ++ks) Bs[ks] = pack8(S[2 * ks], S[2 * ks + 1]);
        f32x4 vn[4];
#pragma unroll
        for (int i = 0; i < 4; ++i) {
            f32x4 acc = {0.f, 0.f, 0.f, 0.f};
#pragma unroll
            for (int ks = 0; ks < 4; ++ks) acc = mfma16(*(LP(bf16x8))(Wl + (16 * i + fr) * W_LD + 32 * ks + 8 * fq), Bs[ks], acc);
            vn[i][0] = bf_lo(ucur[2 * i]) - acc[0]; vn[i][1] = bf_hi(ucur[2 * i]) - acc[1]; vn[i][2] = bf_lo(ucur[2 * i + 1]) - acc[2]; vn[i][3] = bf_hi(ucur[2 * i + 1]) - acc[3];
        }
        bf16x8 Bv[2];
        Bv[0] = pack8(vn[0], vn[1]); Bv[1] = pack8(vn[2], vn[3]);
        f32x4 o[4];
#pragma unroll
        for (int i = 0; i < 4; ++i) {
            f32x4 acc = {0.f, 0.f, 0.f, 0.f};
#pragma unroll
            for (int ks = 0; ks < 4; ++ks) acc = mfma16(*(LP(bf16x8))(Ql + (16 * i + fr) * W_LD + 32 * ks + 8 * fq), Bs[ks], acc);
#pragma unroll
            for (int s2 = 0; s2 < 2; ++s2) if (s2 == 0 || i >= 2) acc = mfma16(*(LP(bf16x8))(Al + (16 * i + fr) * A_LD + 32 * s2 + 8 * fq), Bv[s2], acc);
            o[i] = acc;
        }
#pragma unroll
        for (int m = 0; m < 8; ++m) {
            f32x4 acc = S[m] * dl;
#pragma unroll
            for (int s2 = 0; s2 < 2; ++s2) acc = mfma16(*(LP(bf16x8))(KDl + (16 * m + fr) * A_LD + 32 * s2 + 8 * fq), Bv[s2], acc);
            S[m] = acc;
        }
#pragma unroll
        for (int i = 0; i < 4; ++i)
#pragma unroll
            for (int r = 0; r < 4; ++r) {
                float s = o[i][r] * o[i][r];
                s += shfl_xor_f(s, 1); s += shfl_xor_f(s, 2); s += shfl_xor_f(s, 4); s += shfl_xor_f(s, 8);
                if (fr == 0) PL[w * 64 + 16 * i + 4 * fq + r] = s;
            }
        wg_sync();
        {
            const int tok = 8 * w + (l >> 3);
            float s = PL[(l & 7) * 64 + tok];
            s += shfl_xor_f(s, 1); s += shfl_xor_f(s, 2); s += shfl_xor_f(s, 4);
            if ((l & 7) == 0) RL[tok] = 1.0f / sqrtf(s * (1.0f / 128.0f) + RMS_EPS);
        }
        if (n + 1 < NCH) DN_STORE((n + 1) & 1);
        wg_sync();
#pragma unroll
        for (int i = 0; i < 4; ++i)
#pragma unroll
            for (int r = 0; r < 4; ++r) { const int tok = 16 * i + 4 * fq + r; OL[tok * W_LD + 16 * w + fr] = (bf16)f2bf(o[i][r] * RL[tok] * dnn); }
        wg_sync();
#pragma unroll
        for (int e = 0; e < 2; ++e) {
            const int p = tid + 512 * e, row = p >> 4, c8 = (p & 15) * 8;
            const u32x4 ov = *(LP(u32x4))(OL + row * W_LD + c8);
            const u32x4 zv = *(const u32x4*)(P.Z + (row0 + row) * D + h * 128 + c8);
            u32x4 r;
            r.x = pk2(bf_lo(ov.x) * bf_lo(zv.x), bf_hi(ov.x) * bf_hi(zv.x)); r.y = pk2(bf_lo(ov.y) * bf_lo(zv.y), bf_hi(ov.y) * bf_hi(zv.y));
            r.z = pk2(bf_lo(ov.z) * bf_lo(zv.z), bf_hi(ov.z) * bf_hi(zv.z)); r.w = pk2(bf_lo(ov.w) * bf_lo(zv.w), bf_hi(ov.w) * bf_hi(zv.w));
            *(u32x4*)(P.OCAT + (row0 + row) * 2048 + h * 128 + c8) = r;
        }
#pragma unroll
        for (int e = 0; e < 8; ++e) ucur[e] = pu[e];
    }
#undef DN_LOAD
#undef DN_STORE
#pragma unroll
    for (int m = 0; m < 8; ++m)
#pragma unroll
        for (int r = 0; r < 4; ++r) P.DSP[((size_t)(b * H + h) * 128 + 16 * m + 4 * fq + r) * 128 + 16 * w + fr] = S[m][r];
}

constexpr int L_CV = 0, L_QS = L_CV + 8 * 384 * 4, L_KS = L_QS + 8 * 128 * 4, L_VS = L_KS + 8 * 128 * 4, L_BG = L_VS + 8 * 128 * 4, L_RED = L_BG + 256, L_OS = L_RED + 2 * 4 * 128 * 4, L_SAMP_END = L_OS + 8 * 128 * 4;
DI void sample_item(LP(unsigned char) lds, const DnPtrs& P, int b, int h) {
    const int tid = t_id(), w = tid >> 6, l = tid & 63, dv = tid & 127, dkb = tid >> 7;
    LP(float) CV = (LP(float))(lds + L_CV); LP(float) QS = (LP(float))(lds + L_QS); LP(float) KS = (LP(float))(lds + L_KS); LP(float) VS = (LP(float))(lds + L_VS);
    LP(float) BG = (LP(float))(lds + L_BG); LP(float) RED = (LP(float))(lds + L_RED); LP(float) OS = (LP(float))(lds + L_OS);
    const size_t sbase = ((size_t)(b * H + h) * 128 + 32 * dkb) * 128 + dv;
    const int rowb = MP + 8 * b;
    wg_sync();
    float S[32];
#pragma unroll
    for (int i = 0; i < 32; ++i) S[i] = P.state_delta[sbase + (size_t)i * 128];
    if (tid < 384) {
        const int col = (tid >> 7) * 1024 + h * 128 + (tid & 127);
        float x[11], cw[4];
#pragma unroll
        for (int i = 0; i < 4; ++i) cw[i] = P.conv_w[i * QKVW + col];
#pragma unroll
        for (int i = 0; i < 3; ++i) x[i] = P.state_conv[((size_t)b * 3 + i) * QKVW + col];
#pragma unroll
        for (int t = 0; t < 8; ++t) x[3 + t] = bf2f(P.QKV[(size_t)(rowb + t) * QKVW + col]);
#pragma unroll
        for (int t = 0; t < 8; ++t) CV[t * 384 + tid] = silu_f(x[t] * cw[0] + x[t + 1] * cw[1] + x[t + 2] * cw[2] + x[t + 3] * cw[3]);
    }
    wg_sync();
    {
        const int t = w;
        const float q0 = CV[t * 384 + 2 * l], q1 = CV[t * 384 + 2 * l + 1], k0 = CV[t * 384 + 128 + 2 * l], k1 = CV[t * 384 + 128 + 2 * l + 1];
        const float rq = 1.0f / sqrtf(wave_sum(q0 * q0 + q1 * q1) + L2_EPS) * QSCALE_DN, rk = 1.0f / sqrtf(wave_sum(k0 * k0 + k1 * k1) + L2_EPS);
        QS[t * 128 + 2 * l] = q0 * rq; QS[t * 128 + 2 * l + 1] = q1 * rq; KS[t * 128 + 2 * l] = k0 * rk; KS[t * 128 + 2 * l + 1] = k1 * rk;
        VS[t * 128 + 2 * l] = CV[t * 384 + 256 + 2 * l]; VS[t * 128 + 2 * l + 1] = CV[t * 384 + 256 + 2 * l + 1];
        if (l == 0) { const float* ba = P.BA + (size_t)(rowb + t) * 16; BG[2 * t] = 1.0f / (1.0f + expf(-ba[h])); BG[2 * t + 1] = expf(-expf(P.a_log[h]) * softplus_f(ba[8 + h] + P.dt_bias[h])); }
    }
    wg_sync();
    for (int t = 0; t < 8; ++t) {
        const float beta = BG[2 * t], eg = BG[2 * t + 1];
        float p = 0.f;
#pragma unroll
        for (int i = 0; i < 32; ++i) p += KS[t * 128 + 32 * dkb + i] * S[i];
        RED[dkb * 128 + dv] = p;
        wg_sync();
        const float kS = (RED[dv] + RED[128 + dv]) + (RED[256 + dv] + RED[384 + dv]);
        const float d = beta * (VS[t * 128 + dv] - eg * kS);
        float po = 0.f;
#pragma unroll
        for (int i = 0; i < 32; ++i) { S[i] = eg * S[i] + KS[t * 128 + 32 * dkb + i] * d; po += QS[t * 128 + 32 * dkb + i] * S[i]; }
        RED[512 + dkb * 128 + dv] = po;
        wg_sync();
        if (dkb == 0) OS[t * 128 + dv] = (RED[512 + dv] + RED[640 + dv]) + (RED[768 + dv] + RED[896 + dv]);
    }
    wg_sync();
    {
        const int t = w, row = rowb + t;
        const float o0 = OS[t * 128 + 2 * l], o1 = OS[t * 128 + 2 * l + 1];
        const float rs = 1.0f / sqrtf(wave_sum(o0 * o0 + o1 * o1) * (1.0f / 128.0f) + RMS_EPS);
        const unsigned zz = *(const unsigned*)(P.Z + (size_t)row * D + h * 128 + 2 * l);
        *(unsigned*)(P.OCAT + (size_t)row * 2048 + h * 128 + 2 * l) = pk2(o0 * rs * P.dn_norm[2 * l] * bf_lo(zz), o1 * rs * P.dn_norm[2 * l + 1] * bf_hi(zz));
    }
#pragma unroll
    for (int i = 0; i < 32; ++i) P.DSS[sbase + (size_t)i * 128] = S[i];
}
}
struct SgPtrs { const bf16* UV; const bf16* SGWT; const float* sgu_w; const float* sgu_b; const float* sgu_norm; bf16* OCAT; float* SGV; };
namespace sg {
using namespace cfg;
constexpr int VT_LD = 136, L_VT = 0, L_R = 128 * VT_LD * 2, L_SG_END = L_R + 512;
DI void sgu_item(LP(unsigned char) lds, const SgPtrs& P, int b, int c, int g) {
    const int tid = t_id(), w = tid >> 6, l = tid & 63, fr = l & 15, fq = l >> 4;
    const size_t row0 = (size_t)b * SEQ + 128 * c;
    LP(bf16) VT = (LP(bf16))(lds + L_VT); LP(float) R = (LP(float))(lds + L_R);
    wg_sync();
#pragma unroll 4
    for (int j = 0; j < 16; ++j) {
        const int row = 16 * w + j;
        const u32x4 v = *(const u32x4*)(P.UV + (row0 + row) * D + 512 + 8 * l);
        float ss = bf_lo(v.x) * bf_lo(v.x) + bf_hi(v.x) * bf_hi(v.x) + bf_lo(v.y) * bf_lo(v.y) + bf_hi(v.y) * bf_hi(v.y) + bf_lo(v.z) * bf_lo(v.z) + bf_hi(v.z) * bf_hi(v.z) + bf_lo(v.w) * bf_lo(v.w) + bf_hi(v.w) * bf_hi(v.w);
        ss = wave_sum(ss);
        if (l == 0) R[row] = 1.0f / sqrtf(ss * (1.0f / 512.0f) + RMS_EPS);
    }
    wg_sync();
    {
        const int cc = tid & 127, pg = tid >> 7; const float gain = P.sgu_norm[g * 128 + cc];
#pragma unroll 4
        for (int j = 0; j < 16; ++j) {
            const int s = 2 * (pg * 16 + j);
            const float v0 = bf2f(P.UV[(row0 + s) * D + 512 + g * 128 + cc]), v1 = bf2f(P.UV[(row0 + s + 1) * D + 512 + g * 128 + cc]);
            *(LP(unsigned))(VT + cc * VT_LD + s) = pk2(v0 * R[s] * gain, v1 * R[s + 1] * gain);
        }
    }
    wg_sync();
    {
        const int t = 16 * w + fr, kmax = (16 * w + 15) >> 5;
        f32x4 acc[8];
#pragma unroll
        for (int m = 0; m < 8; ++m) acc[m] = (f32x4){0.f, 0.f, 0.f, 0.f};
        for (int ks = 0; ks <= kmax; ++ks) {
            const bf16x8 wf = *(const bf16x8*)(P.SGWT + ((size_t)g * 128 + t) * 128 + 32 * ks + 8 * fq);
#pragma unroll
            for (int m = 0; m < 8; ++m) acc[m] = mfma16(*(LP(bf16x8))(VT + (16 * m + fr) * VT_LD + 32 * ks + 8 * fq), wf, acc[m]);
        }
        const float bias = P.sgu_b[g * 128 + t];
#pragma unroll
        for (int m = 0; m < 8; ++m) {
            const int c0 = g * 128 + 16 * m + 4 * fq;
            const u32x2 uu = *(const u32x2*)(P.UV + (row0 + t) * D + c0);
            u32x2 o; o.x = pk2(bf_lo(uu.x) * (acc[m][0] + bias), bf_hi(uu.x) * (acc[m][1] + bias)); o.y = pk2(bf_lo(uu.y) * (acc[m][2] + bias), bf_hi(uu.y) * (acc[m][3] + bias));
            *(u32x2*)(P.OCAT + (row0 + t) * 2048 + 1024 + c0) = o;
        }
    }
}
DI void sgu_sample_item(LP(unsigned char) lds, const SgPtrs& P, int b) {
    const int tid = t_id(), w = tid >> 6, l = tid & 63, g = tid >> 7;
    LP(float) RED = (LP(float))(lds);
    const size_t rowb = (size_t)MP + 8 * b;
    float v[8], u[8];
    wg_sync();
#pragma unroll
    for (int t = 0; t < 8; ++t) { v[t] = bf2f(P.UV[(rowb + t) * D + 512 + tid]); u[t] = bf2f(P.UV[(rowb + t) * D + tid]); const float s = wave_sum(v[t] * v[t]); if (l == 0) RED[t * 8 + w] = s; }
    wg_sync();
    const float gain = P.sgu_norm[tid];
#pragma unroll
    for (int t = 0; t < 8; ++t) {
        float s = 0.f;
#pragma unroll
        for (int j = 0; j < 8; ++j) s += RED[t * 8 + j];
        v[t] = v[t] * (1.0f / sqrtf(s * (1.0f / 512.0f) + RMS_EPS)) * gain;
        P.SGV[((size_t)b * 8 + t) * 512 + tid] = v[t];
    }
#pragma unroll
    for (int t = 0; t < 8; ++t) {
        float mx = P.sgu_b[g * 128 + t];
#pragma unroll
        for (int s = 0; s <= t; ++s) mx += P.sgu_w[((size_t)g * 128 + t) * 128 + s] * v[s];
        P.OCAT[(rowb + t) * 2048 + 1024 + tid] = (bf16)f2bf(u[t] * mx);
    }
}
}

namespace at {
using namespace cfg;
constexpr int K_LD = 136, V_LD = 264, L_K = 0, L_V = 256 * K_LD * 2, L_AT_END = L_V + 128 * V_LD * 2;
static_assert(L_AT_END <= P2_LDS, "attention LDS");
DI int crow(int i, int h) { return (i & 3) + 8 * (i >> 2) + 4 * h; }
DI void attn_item(LP(unsigned char) lds, const bf16* Q, int nq, const float* K, const float* V, bf16* O) {
    const int tid = t_id(), w = tid >> 6, l = tid & 63, r32 = l & 31, hh = l >> 5;
    LP(bf16) KL = (LP(bf16))(lds + L_K); LP(bf16) VT = (LP(bf16))(lds + L_V);
    wg_sync();
#pragma unroll 4
    for (int e = 0; e < 16; ++e) {
        const int p = tid + 512 * e, key = p >> 5, d4 = (p & 31) * 4;
        const f32x4 kv = *(const f32x4*)(K + (size_t)key * 512 + d4);
        u32x2 pk; pk.x = pk2(kv[0], kv[1]); pk.y = pk2(kv[2], kv[3]);
        *(LP(u32x2))(KL + key * K_LD + d4) = pk;
    }
#pragma unroll 2
    for (int e = 0; e < 8; ++e) {
        const int u = tid + 512 * e, d4 = (u & 31) * 4, key = 2 * (u >> 5);
        const f32x4 v0 = *(const f32x4*)(V + (size_t)key * 512 + d4), v1 = *(const f32x4*)(V + (size_t)(key + 1) * 512 + d4);
        const int kp = perm16k(key);
#pragma unroll
        for (int i = 0; i < 4; ++i) *(LP(unsigned))(VT + (d4 + i) * V_LD + kp) = pk2(v0[i], v1[i]);
    }
    wg_sync();
    const int q0 = 32 * w;
    if (q0 < nq) {
        bf16x8 Bq[8];
        const bool qok = (q0 + r32) < nq;
#pragma unroll
        for (int ks = 0; ks < 8; ++ks) { Bq[ks] = (bf16x8){0, 0, 0, 0, 0, 0, 0, 0}; if (qok) Bq[ks] = *(const bf16x8*)(Q + (size_t)(q0 + r32) * 512 + 16 * ks + 8 * hh); }
        f32x16 acc[8];
#pragma unroll
        for (int kt = 0; kt < 8; ++kt) {
#pragma unroll
            for (int i = 0; i < 16; ++i) acc[kt][i] = 0.f;
#pragma unroll
            for (int ks = 0; ks < 8; ++ks) acc[kt] = mfma32(*(LP(bf16x8))(KL + (32 * kt + r32) * K_LD + 16 * ks + 8 * hh), Bq[ks], acc[kt]);
            asm volatile("" ::: "memory");
        }
        float mx = -3.0e38f;
#pragma unroll
        for (int kt = 0; kt < 8; ++kt)
#pragma unroll
            for (int i = 0; i < 16; ++i) mx = fmaxf(mx, acc[kt][i]);
        mx = fmaxf(mx, shfl_xor_f(mx, 32));
        float sum = 0.f;
        bf16x8 Pf[8][2];
#pragma unroll
        for (int kt = 0; kt < 8; ++kt) {
#pragma unroll
            for (int i = 0; i < 16; ++i) { const float p = fexp2(acc[kt][i] - mx); acc[kt][i] = p; sum += p; }
#pragma unroll
            for (int s = 0; s < 2; ++s) {
                u32x4 pa; pa.x = pk2(acc[kt][8 * s], acc[kt][8 * s + 1]); pa.y = pk2(acc[kt][8 * s + 2], acc[kt][8 * s + 3]); pa.z = pk2(acc[kt][8 * s + 4], acc[kt][8 * s + 5]); pa.w = pk2(acc[kt][8 * s + 6], acc[kt][8 * s + 7]);
                Pf[kt][s] = __builtin_bit_cast(bf16x8, pa);
            }
        }
        sum += shfl_xor_f(sum, 32);
        const float inv = 1.0f / sum;
#pragma unroll
        for (int dh = 0; dh < 2; ++dh) {
            f32x16 o[2];
#pragma unroll
            for (int dt = 0; dt < 2; ++dt)
#pragma unroll
                for (int i = 0; i < 16; ++i) o[dt][i] = 0.f;
#pragma unroll
            for (int kt = 0; kt < 8; ++kt) {
#pragma unroll
                for (int s = 0; s < 2; ++s) {
#pragma unroll
                    for (int dt = 0; dt < 2; ++dt) o[dt] = mfma32(Pf[kt][s], *(LP(bf16x8))(VT + (64 * dh + 32 * dt + r32) * V_LD + 32 * kt + 16 * s + 8 * hh), o[dt]);
                }
                asm volatile("" ::: "memory");
            }
#pragma unroll
            for (int i = 0; i < 16; ++i) {
                const int q = crow(i, hh); const float iv = shfl_f(inv, q);
                if (q0 + q < nq) {
#pragma unroll
                    for (int dt = 0; dt < 2; ++dt) O[(size_t)(q0 + q) * 2048 + 64 * dh + 32 * dt + r32] = (bf16)f2bf(o[dt][i] * iv);
                }
            }
        }
    }
}
}
#ifndef HOST_EMU
namespace ep {
using namespace cfg;
using pg8::Unit; using pg8::HALF; using pg8::BM;
DI u32x4 pack8f(const f32x4& a, const f32x4& b) { u32x4 w; w.x = pg8::cvt_pk_bf16(a[0], a[1]); w.y = pg8::cvt_pk_bf16(a[2], a[3]); w.z = pg8::cvt_pk_bf16(b[0], b[1]); w.w = pg8::cvt_pk_bf16(b[2], b[3]); return w; }
DI void unpack8(const u32x4& w, f32x4& a, f32x4& b) { a[0] = bf_lo(w.x); a[1] = bf_hi(w.x); a[2] = bf_lo(w.y); a[3] = bf_hi(w.y); b[0] = bf_lo(w.z); b[1] = bf_hi(w.z); b[2] = bf_lo(w.w); b[3] = bf_hi(w.w); }

struct EpiG1 {
    static constexpr bool PERM = true, AFTER_DRAIN = false;
    bf16 *QKV, *Z, *UV, *QMEM, *HALO; float *CSP, *CSS; const float* rstd;
    DI void operator()(const f32x4 (&acc)[2][2][4][2], const Unit& u, int wr, int wc, int fr, int fq) const {
        const int row0 = u.pm * BM + wr * 64 + fr, pn = u.pn;
        bf16* base; int ld, colt, mode;
        if (pn < 12) { base = QKV; ld = QKVW; colt = pn * 256; mode = 0; }
        else if (pn < 16) { base = Z; ld = D; colt = (pn - 12) * 256; mode = 1; }
        else if (pn < 20) { base = UV; ld = D; colt = (pn - 16) * 256; mode = 2; }
        else { base = QMEM; ld = MEMW; colt = (pn - 20) * 256; mode = 3; }
        const int col0 = colt + wc * 32 + 8 * fq;
#pragma unroll
        for (int ai = 0; ai < 2; ++ai)
#pragma unroll
            for (int m = 0; m < 4; ++m) {
                const int r = row0 + ai * HALF + m * 16; const float rs = rstd[r];
#pragma unroll
                for (int bj = 0; bj < 2; ++bj) {
                    f32x4 v0 = acc[ai][bj][m][0] * rs, v1 = acc[ai][bj][m][1] * rs;
                    if (mode == 1) {
#pragma unroll
                        for (int j = 0; j < 4; ++j) { v0[j] = silu_f(v0[j]); v1[j] = silu_f(v1[j]); } }
                    else if (mode == 2) {
#pragma unroll
                        for (int j = 0; j < 4; ++j) { v0[j] = gelu_tanh_f(v0[j]); v1[j] = gelu_tanh_f(v1[j]); } }
                    else if (mode == 3) { v0 = v0 * QSCALE_MEM; v1 = v1 * QSCALE_MEM; }
                    const u32x4 w = pack8f(v0, v1);
                    *(u32x4*)(base + (size_t)r * ld + col0 + bj * HALF) = w;
                    if (mode == 0) {
                        const int c = col0 + bj * HALF;
                        if (m == 3 && fr >= 13) {
                            *(u32x4*)(HALO + ((size_t)(r >> 6) * 3 + ((r & 63) - 61)) * QKVW + c) = w;
                            if (r < MP && (r & 2047) >= 2045) { float* d = CSP + ((size_t)(r >> 11) * 3 + ((r & 2047) - 2045)) * QKVW + c; *(f32x4*)d = v0; *(f32x4*)(d + 4) = v1; }
                        }
                        if (r >= MP && (r & 7) >= 5) { float* d = CSS + ((size_t)((r - MP) >> 3) * 3 + ((r & 7) - 5)) * QKVW + c; *(f32x4*)d = v0; *(f32x4*)(d + 4) = v1; }
                    }
                }
            }
    }
};
struct EpiKV {
    static constexpr bool PERM = false, AFTER_DRAIN = false;
    float *MK, *MV; const float* rstd;
    DI void operator()(const f32x4 (&acc)[2][2][4][2], const Unit& u, int wr, int wc, int fr, int fq) const {
        const int row0 = u.pm * BM + wr * 64 + fr, col0 = u.pn * BM + wc * 32 + 4 * fq;
#pragma unroll
        for (int ai = 0; ai < 2; ++ai)
#pragma unroll
            for (int m = 0; m < 4; ++m) {
                const int r = row0 + ai * HALF + m * 16; const float rs = rstd[r];
#pragma unroll
                for (int bj = 0; bj < 2; ++bj)
#pragma unroll
                    for (int n = 0; n < 2; ++n) { const int c = col0 + bj * HALF + n * 16; float* d = (c < MEMW) ? MK + (size_t)r * MEMW + c : MV + (size_t)r * MEMW + (c - MEMW); *(f32x4*)d = acc[ai][bj][m][n] * rs; }
            }
    }
};
struct EpiGate {
    static constexpr bool PERM = true, AFTER_DRAIN = false;
    bf16* G; const float* rstd;
    DI void operator()(const f32x4 (&acc)[2][2][4][2], const Unit& u, int wr, int wc, int fr, int fq) const {
        const int row0 = u.pm * BM + wr * 64 + fr, col0 = u.pn * BM + wc * 32 + 8 * fq;
#pragma unroll
        for (int ai = 0; ai < 2; ++ai)
#pragma unroll
            for (int m = 0; m < 4; ++m) {
                const int r = row0 + ai * HALF + m * 16; const float rs = rstd[r];
#pragma unroll
                for (int bj = 0; bj < 2; ++bj) {
                    f32x4 v0 = acc[ai][bj][m][0] * rs, v1 = acc[ai][bj][m][1] * rs;
#pragma unroll
                    for (int j = 0; j < 4; ++j) { v0[j] = sigmoid_f(v0[j]); v1[j] = sigmoid_f(v1[j]); }
                    *(u32x4*)(G + (size_t)r * NGATE + col0 + bj * HALF) = pack8f(v0, v1);
                }
            }
    }
};
struct EpiBr {
    static constexpr bool PERM = true, AFTER_DRAIN = false;
    const bf16* G; bf16* MG; int b;
    DI void operator()(const f32x4 (&acc)[2][2][4][2], const Unit& u, int wr, int wc, int fr, int fq) const {
        const int row0 = u.pm * BM + wr * 64 + fr, col0 = u.pn * BM + wc * 32 + 8 * fq;
#pragma unroll
        for (int ai = 0; ai < 2; ++ai)
#pragma unroll
            for (int m = 0; m < 4; ++m) {
                const int r = row0 + ai * HALF + m * 16;
#pragma unroll
                for (int bj = 0; bj < 2; ++bj) {
                    const int c = col0 + bj * HALF;
                    f32x4 g0, g1; unpack8(*(const u32x4*)(G + (size_t)r * NGATE + b * D + c), g0, g1);
                    f32x4 v0 = acc[ai][bj][m][0] * g0, v1 = acc[ai][bj][m][1] * g1;
                    if (b > 0) { f32x4 o0, o1; unpack8(*(const u32x4*)(MG + (size_t)r * D + c), o0, o1); v0 = v0 + o0; v1 = v1 + o1; }
                    *(u32x4*)(MG + (size_t)r * D + c) = pack8f(v0, v1);
                }
                asm volatile("" ::: "memory");
            }
    }
};
struct EpiRes {
    static constexpr bool PERM = false, AFTER_DRAIN = false;
    const float* xin_p; const float* xin_s; float* Y; bf16* XB; float* SS;
    DI void operator()(const f32x4 (&acc)[2][2][4][2], const Unit& u, int wr, int wc, int fr, int fq) const {
        const int row0 = u.pm * BM + wr * 64 + fr, col0 = u.pn * BM + wc * 32 + 4 * fq;
#pragma unroll
        for (int ai = 0; ai < 2; ++ai)
#pragma unroll
            for (int m = 0; m < 4; ++m) {
                const int r = row0 + ai * HALF + m * 16;
                const float* xin = (r < MP) ? xin_p + (size_t)r * D : xin_s + (size_t)(r - MP) * D;
                float ss = 0.f;
#pragma unroll
                for (int bj = 0; bj < 2; ++bj)
#pragma unroll
                    for (int n = 0; n < 2; ++n) {
                        const int c = col0 + bj * HALF + n * 16;
                        const f32x4 x = *(const f32x4*)(xin + c) + acc[ai][bj][m][n];
                        *(f32x4*)(Y + (size_t)r * D + c) = x;
                        if (XB) { u32x2 w; w.x = pg8::cvt_pk_bf16(x[0], x[1]); w.y = pg8::cvt_pk_bf16(x[2], x[3]); *(u32x2*)(XB + (size_t)r * D + c) = w; }
                        ss += (x[0] * x[0] + x[1] * x[1]) + (x[2] * x[2] + x[3] * x[3]);
                    }
                ss += __shfl_xor(ss, 16); ss += __shfl_xor(ss, 32);
                if (fq == 0) SS[(size_t)r * 16 + u.pn * 4 + wc] = ss;
                asm volatile("" ::: "memory");
            }
    }
};
DI float rstd_from_ss(const float* SS, int r) {
    const f32x4 a = *(const f32x4*)(SS + (size_t)r * 16), b = *(const f32x4*)(SS + (size_t)r * 16 + 4), c = *(const f32x4*)(SS + (size_t)r * 16 + 8), d = *(const f32x4*)(SS + (size_t)r * 16 + 12);
    const float s = (((a[0] + a[1]) + (a[2] + a[3])) + ((b[0] + b[1]) + (b[2] + b[3]))) + (((c[0] + c[1]) + (c[2] + c[3])) + ((d[0] + d[1]) + (d[2] + d[3])));
    return 1.0f / sqrtf(s * (1.0f / D) + RMS_EPS);
}
struct EpiGU {
    static constexpr bool PERM = true, AFTER_DRAIN = false;
    const float* SS; bf16* HB;
    DI void operator()(const f32x4 (&acc)[2][2][4][2], const Unit& u, int wr, int wc, int fr, int fq) const {
        const int row0 = u.pm * BM + wr * 64 + fr, col0 = u.pn * HALF + wc * 32 + 8 * fq;
#pragma unroll
        for (int ai = 0; ai < 2; ++ai)
#pragma unroll
            for (int m = 0; m < 4; ++m) {
                const int r = row0 + ai * HALF + m * 16; const float rs = rstd_from_ss(SS, r);
                f32x4 h0, h1;
#pragma unroll
                for (int j = 0; j < 4; ++j) { h0[j] = silu_f(acc[ai][0][m][0][j] * rs) * (acc[ai][1][m][0][j] * rs); h1[j] = silu_f(acc[ai][0][m][1][j] * rs) * (acc[ai][1][m][1][j] * rs); }
                *(u32x4*)(HB + (size_t)r * FF + col0) = pack8f(h0, h1);
                asm volatile("" ::: "memory");
            }
    }
};
}
using namespace cfg;
constexpr int NWAVES = 8;
#ifndef MK_N_LAUNCHES
#define MK_N_LAUNCHES 1
#endif
constexpr int N_PHASES = 10;
struct Args { const float* in[26]; float* out; unsigned char* ws; int ph_lo, ph_hi; };
static_assert(sizeof(Args) == 26 * 8 + 8 + 8 + 4 + 4, "no padding bytes in the kernel argument");
enum { I_XP = 0, I_XS, I_SD, I_SC, I_CK, I_CV, I_MEM, I_NMIX, I_WIN, I_CONVW, I_ALOG, I_DTB, I_DNN, I_SGN, I_SGW, I_SGB, I_WBD, I_WBS, I_WBM, I_WO, I_MNORM, I_WKV, I_NFFN, I_WGU, I_WDN, I_NFIN };

DI void p0_transpose_item(const float* W, int ld_src, int n0, int k0, const float* gain, bf16* WT, int ld_dst, int drow0, int koff, LAS float* scr, int lane) {
#pragma unroll 8
    for (int i = 0; i < 32; ++i) { const int kk = 2 * i + (lane >> 5); float v = W[(size_t)(k0 + kk) * ld_src + n0 + (lane & 31)]; if (gain) v *= gain[k0 + kk]; scr[kk * 33 + (lane & 31)] = v; }
    LDS_WAIT(); asm volatile("" ::: "memory");
    const int c = lane & 7;
#pragma unroll
    for (int j = 0; j < 4; ++j) { const int n = (lane >> 3) + 8 * j; const LAS float* s = scr + (8 * c) * 33 + n;
        v4u o; o.x = pk2(s[0 * 33], s[1 * 33]); o.y = pk2(s[2 * 33], s[3 * 33]); o.z = pk2(s[4 * 33], s[5 * 33]); o.w = pk2(s[6 * 33], s[7 * 33]);
        *(GAS v4u*)(WT + (size_t)(drow0 + n) * ld_dst + koff + k0 + 8 * c) = o; }
    LDS_WAIT(); asm volatile("" ::: "memory");
}

DI void p0_prologue(const Args& a, LAS unsigned char* lds, int vcu, int G) {
    const int tid = t_id(), lane = tid & 63, wave = __builtin_amdgcn_readfirstlane(tid >> 6);
    unsigned char* ws = a.ws;
    LAS float* scr = (LAS float*)(lds + wave * 16384);
    const int gw = vcu * NWAVES + wave, NGW = G * NWAVES;
    constexpr int I0 = 16 * 272, I1 = I0 + 16 * 32, I2 = I1 + 8 * 32, I3 = I2 + 8 * 32, I4 = I3 + 16 * 32, I5 = I4 + 16 * 32, I6 = I5 + 16 * 176, I7 = I6 + 44 * 32;
    for (int it = gw; it < I7; it += NGW) {
        if (it < I0) { const int kb = it / 272, nb = it % 272, dr = 32 * nb; p0_transpose_item(a.in[I_WIN], DIN, dr < 4096 ? dr : dr + 16, 64 * kb, a.in[I_NMIX], (bf16*)(ws + WS_WIN), D, dr, 0, scr, lane); }
        else if (it < I1) { const int r = it - I0, kb = r / 32, nb = r % 32; p0_transpose_item(a.in[I_WBD], D, 32 * nb, 64 * kb, nullptr, (bf16*)(ws + WS_WBR), 2048, 32 * nb, 0, scr, lane); }
        else if (it < I2) { const int r = it - I1, kb = r / 32, nb = r % 32; p0_transpose_item(a.in[I_WBS], D, 32 * nb, 64 * kb, nullptr, (bf16*)(ws + WS_WBR), 2048, 32 * nb, 1024, scr, lane); }
        else if (it < I3) { const int r = it - I2, kb = r / 32, nb = r % 32; p0_transpose_item(a.in[I_WBM], D, 32 * nb, 64 * kb, nullptr, (bf16*)(ws + WS_WBR), 2048, 32 * nb, 1536, scr, lane); }
        else if (it < I4) { const int r = it - I3, kb = r / 32, nb = r % 32; p0_transpose_item(a.in[I_WO], D, 32 * nb, 64 * kb, nullptr, (bf16*)(ws + WS_WO), D, 32 * nb, 0, scr, lane); }
        else if (it < I5) { const int r = it - I4, kb = r / 32, nb = r % 32; p0_transpose_item(a.in[I_WKV], D, 32 * nb, 64 * kb, a.in[I_MNORM], (bf16*)(ws + WS_WKV), D, 32 * nb, 0, scr, lane); }
        else if (it < I6) { const int r = it - I5, kb = r / 176, nb = r % 176, n0 = 32 * nb, up = n0 >= FF, f0 = n0 - up * FF;
            p0_transpose_item(a.in[I_WGU], 2 * FF, n0, 64 * kb, a.in[I_NFFN], (bf16*)(ws + WS_WGU), D, 256 * (f0 / 128) + 128 * up + (f0 % 128), 0, scr, lane); }
        else { const int r = it - I6, kb = r / 32, nb = r % 32; p0_transpose_item(a.in[I_WDN], D, 32 * nb, 64 * kb, nullptr, (bf16*)(ws + WS_WDN), FF, 32 * nb, 0, scr, lane); }
    }
    { bf16* sw = (bf16*)(ws + WS_SGW); const float* w = a.in[I_SGW];
      for (int i = (vcu * NWAVES * 64) + tid; i < 4 * 128 * 128; i += G * NWAVES * 64) { const int t = (i >> 7) & 127, s = i & 127; sw[i] = (bf16)f2bf(s <= t ? w[i] : 0.f); } }
    __syncthreads();
    LAS float* img = (LAS float*)lds;
    for (int i = tid; i < 16 * 1024; i += NWAVES * 64) { const int k = i >> 4, c = i & 15; img[c * 1024 + k] = a.in[I_WIN][(size_t)k * DIN + 4096 + c] * a.in[I_NMIX][k]; }
    __syncthreads();
    bf16* XB = (bf16*)(ws + WS_XB); float* RS = (float*)(ws + WS_RSTDX); float* BA = (float*)(ws + WS_BA);
    for (int m = gw; m < M; m += NGW) {
        const float* xrow = (m < MP) ? a.in[I_XP] + (size_t)m * D : a.in[I_XS] + (size_t)(m - MP) * D;
        const GAS f32x4* xr = (const GAS f32x4*)xrow + lane;
        f32x4 v[4]; float s = 0.f;
#pragma unroll
        for (int j = 0; j < 4; ++j) { v[j] = xr[64 * j]; s += (v[j].x * v[j].x + v[j].y * v[j].y) + (v[j].z * v[j].z + v[j].w * v[j].w); }
        const float rstd = 1.f / sqrtf(wave_sum(s) * (1.f / D) + RMS_EPS);
        GAS unsigned long long* o8 = (GAS unsigned long long*)(XB + (size_t)m * D) + lane;
#pragma unroll
        for (int j = 0; j < 4; ++j) o8[64 * j] = (unsigned long long)pk2(v[j].x, v[j].y) | ((unsigned long long)pk2(v[j].z, v[j].w) << 32);
        float mine = 0.f;
#pragma unroll 1
        for (int c = 0; c < 16; ++c) {
            float p = 0.f;
#pragma unroll
            for (int j = 0; j < 4; ++j) { const f32x4 wv = *(const LAS f32x4*)(img + c * 1024 + 256 * j + 4 * lane); p += (v[j].x * wv.x + v[j].y * wv.y) + (v[j].z * wv.z + v[j].w * wv.w); }
            p = wave_sum(p);
            if (lane == c) mine = p;
        }
        if (lane < 16) BA[(size_t)m * 16 + lane] = mine * rstd;
        if (lane == 0) RS[m] = rstd;
    }
    bf16* MB = (bf16*)(ws + WS_MB); float* RM = (float*)(ws + WS_RSTDM);
    for (int m = gw; m < NB * MEMT; m += NGW) {
        const GAS f32x4* xr = (const GAS f32x4*)(a.in[I_MEM] + (size_t)m * D) + lane;
        f32x4 v[4]; float s = 0.f;
#pragma unroll
        for (int j = 0; j < 4; ++j) { v[j] = xr[64 * j]; s += (v[j].x * v[j].x + v[j].y * v[j].y) + (v[j].z * v[j].z + v[j].w * v[j].w); }
        const float rstd = 1.f / sqrtf(wave_sum(s) * (1.f / D) + RMS_EPS);
        GAS unsigned long long* o8 = (GAS unsigned long long*)(MB + (size_t)m * D) + lane;
#pragma unroll
        for (int j = 0; j < 4; ++j) o8[64 * j] = (unsigned long long)pk2(v[j].x, v[j].y) | ((unsigned long long)pk2(v[j].z, v[j].w) << 32);
        if (lane == 0) RM[m] = rstd;
    }
}

struct RotOrder : pg8::StaticOrder { };

__global__ void __launch_bounds__(NWAVES * 64, 2) hyb_fwd(Args args) {
    extern __shared__ __attribute__((aligned(16))) unsigned char lds_raw[];
    LAS unsigned char* lds = (LAS unsigned char*)lds_raw;
    volatile LAS unsigned* MISC = (volatile LAS unsigned*)(lds + MISC_OFF);
    const int G = gridDim.x, bx = blockIdx.x, vcu = (G % 8 == 0) ? (bx % 8) * (G / 8) + bx / 8 : bx;
    unsigned char* ws = args.ws; float* out = args.out;
    gu32* ctl = (gu32*)(ws + WS_CTL);
    for (int u = t_id(); u < 128; u += NWAVES * 64) ((LAS unsigned*)(lds + MISC_OFF))[u] = 0u;
    __syncthreads();
    XcdBarrier bar; bar.bar = (unsigned*)(ctl + CW_BAR); bar.x = 0; bar.st = nullptr;
    if (MK_N_LAUNCHES == 1) bar = xcd_barrier_post((unsigned*)(ctl + CW_BAR), MISC + 8);
    const int lo = args.ph_lo, hi = args.ph_hi;
#ifndef PH_MASK
#define PH_MASK 0x3ff
#endif
#define IN(k) (((PH_MASK >> (k)) & 1) && lo <= (k) && (k) < hi)
#define SEAM(k) do { if (IN(k) && IN((k) + 1)) xcd_barrier(bar); } while (0)
    bf16* XB = (bf16*)(ws + WS_XB); const float* RSX = (const float*)(ws + WS_RSTDX);

    if (IN(0)) { p0_prologue(args, lds, vcu, G); }
    SEAM(0);
    if (IN(1)) {
        { pg8::Gemm g{XB, (const bf16*)(ws + WS_WIN), M, N1, D, D, D}; pg8::StaticOrder S; S.init(M, N1, G, bx);
          ep::EpiG1 E{(bf16*)(ws + WS_QKV), (bf16*)out  , (bf16*)out + (size_t)M * D, (bf16*)(ws + WS_QMEM), (bf16*)(ws + WS_HALO), out + O_CSP, out + O_CSS, RSX};
          pg8::gemm_phase<ep::EpiG1, pg8::StaticOrder, true, true>(lds, g, S, E); }
        { pg8::Gemm g{(const bf16*)(ws + WS_MB), (const bf16*)(ws + WS_WKV), NB * MEMT, D, D, D, D}; pg8::StaticOrder S; S.init(NB * MEMT, D, G, (bx + G - (1496 % G)) % G);
          ep::EpiKV E{out + O_MK, out + O_MV, (const float*)(ws + WS_RSTDM)};
          pg8::gemm_phase<ep::EpiKV, pg8::StaticOrder, true, true>(lds, g, S, E); }
    }
    SEAM(1);
    DnPtrs DP{(const bf16*)(ws + WS_QKV), (const bf16*)(ws + WS_HALO), (const float*)(ws + WS_BA), args.in[I_CONVW], args.in[I_ALOG], args.in[I_DTB], args.in[I_DNN],
              (bf16*)(ws + WS_WB), (bf16*)(ws + WS_QD), (bf16*)(ws + WS_KDT), (unsigned*)(ws + WS_UB), (bf16*)(ws + WS_AB), (float*)(ws + WS_DL),
              (const bf16*)out, (bf16*)(ws + WS_OCAT), out + O_DSP, args.in[I_SD], args.in[I_SC], out + O_DSS};
    if (IN(2)) {
        for (int i = vcu; i < NB * H * NCH; i += G) dn::prep_item(lds, DP, i >> 8, (i >> 5) & 7, i & 31);
        __syncthreads();
    }
    SEAM(2);
    if (IN(3)) {
#ifndef IT_MASK
#define IT_MASK 0x3f
#endif
        if (IT_MASK & 1) { if (bx < NB * H && G >= NB * H) dn::scan_item(lds, DP, bx >> 3, bx & 7);
        else if (G < NB * H) { for (int i = bx; i < NB * H; i += G) dn::scan_item(lds, DP, i >> 3, i & 7); } }
        SgPtrs SP{(const bf16*)out + (size_t)M * D, (const bf16*)(ws + WS_SGW), args.in[I_SGW], args.in[I_SGB], args.in[I_SGN], (bf16*)(ws + WS_OCAT), out + O_SGV};
        const bf16* QM = (const bf16*)(ws + WS_QMEM); bf16* OC = (bf16*)(ws + WS_OCAT);
        constexpr int Q0 = DB * H, Q1 = Q0 + DB * MEMH, Q2 = Q1 + NB * MEMH * 8, Q3 = Q2 + NB * 16 * SGG, Q4 = Q3 + DB;
#define Q_FETCH() do { __syncthreads(); if (t_id() == 0) MISC[16] = __hip_atomic_fetch_add(ctl + 2048, 1u, __ATOMIC_RELAXED, __HIP_MEMORY_SCOPE_AGENT); __syncthreads(); q = (int)MISC[16]; } while (0)
        int q; Q_FETCH();
        while (q < Q0) { if (IT_MASK & 2) dn::sample_item(lds, DP, q >> 3, q & 7); Q_FETCH(); }
        while (q < Q2) {
            const bf16* Qp; const float* Kp; const float* Vp; bf16* Op; int nq;
            if (q < Q1) { const int r = q - Q0, b = r >> 2, hd = r & 3; nq = 8;
                Qp = QM + (size_t)(MP + 8 * b) * MEMW + hd * 128; Kp = args.in[I_CK] + (size_t)b * MEMT * MEMW + hd * 128; Vp = args.in[I_CV] + (size_t)b * MEMT * MEMW + hd * 128; Op = OC + (size_t)(MP + 8 * b) * 2048 + 1536 + hd * 128; }
            else { const int r = q - Q1, b = r >> 5, hd = (r >> 3) & 3, qb = r & 7; const size_t row = (size_t)b * SEQ + 256 * qb; nq = 256;
                Qp = QM + row * MEMW + hd * 128; Kp = out + O_MK + (size_t)b * MEMT * MEMW + hd * 128; Vp = out + O_MV + (size_t)b * MEMT * MEMW + hd * 128; Op = OC + row * 2048 + 1536 + hd * 128; }
            if (IT_MASK & 4) at::attn_item(lds, Qp, nq, Kp, Vp, Op);
            Q_FETCH();
        }
        while (q < Q3) { const int r = q - Q2; if (IT_MASK & 8) sg::sgu_item(lds, SP, r >> 6, (r >> 2) & 15, r & 3); Q_FETCH(); }
        while (q < Q4) { if (IT_MASK & 16) sg::sgu_sample_item(lds, SP, q - Q3); Q_FETCH(); }
#undef Q_FETCH
        __syncthreads();
    }
    SEAM(3);
    if (IN(4)) {
        pg8::Gemm g{XB, (const bf16*)(ws + WS_WIN) + (size_t)N1 * D, M, NGATE, D, D, D}; pg8::StaticOrder S; S.init(M, NGATE, G, bx);
        ep::EpiGate E{(bf16*)(ws + WS_GATES), RSX};
        pg8::gemm_phase<ep::EpiGate, pg8::StaticOrder, true, true>(lds, g, S, E);
    }
    SEAM(4);
    if (IN(5)) {
        const bf16* OC = (const bf16*)(ws + WS_OCAT); const bf16* WBR = (const bf16*)(ws + WS_WBR);
        const int koff[3] = {0, 1024, 1536}, klen[3] = {1024, 512, 512};
#pragma unroll
        for (int b = 0; b < 3; ++b) {
            pg8::Gemm g{OC + koff[b], WBR + koff[b], M, D, klen[b], 2048, 2048}; pg8::StaticOrder S; S.init(M, D, G, bx);
            ep::EpiBr E{(const bf16*)(ws + WS_GATES), (bf16*)(ws + WS_MERGED), b};
            pg8::gemm_phase<ep::EpiBr, pg8::StaticOrder, true, true>(lds, g, S, E);
        }
    }
    SEAM(5);
    if (IN(6)) {
        pg8::Gemm g{(const bf16*)(ws + WS_MERGED), (const bf16*)(ws + WS_WO), M, D, D, D, D}; pg8::StaticOrder S; S.init(M, D, G, bx);
        ep::EpiRes E{args.in[I_XP], args.in[I_XS], out + O_Y, (bf16*)(ws + WS_X1B), (float*)(ws + WS_SS1)};
        pg8::gemm_phase<ep::EpiRes, pg8::StaticOrder, true, true>(lds, g, S, E);
    }
    SEAM(6);
    if (IN(7)) {
        pg8::Gemm g{(const bf16*)(ws + WS_X1B), (const bf16*)(ws + WS_WGU), M, 2 * FF, D, D, D}; pg8::StaticOrder S; S.init(M, 2 * FF, G, bx);
        ep::EpiGU E{(const float*)(ws + WS_SS1), (bf16*)(ws + WS_HB)};
        pg8::gemm_phase<ep::EpiGU, pg8::StaticOrder, true, true>(lds, g, S, E);
    }
    SEAM(7);
    if (IN(8)) {
        pg8::Gemm g{(const bf16*)(ws + WS_HB), (const bf16*)(ws + WS_WDN), M, D, FF, FF, FF}; pg8::StaticOrder S; S.init(M, D, G, bx);
        ep::EpiRes E{out + O_Y, out + O_Y + (size_t)MP * D, out + O_Y, nullptr, (float*)(ws + WS_SS2)};
        pg8::gemm_phase<ep::EpiRes, pg8::StaticOrder, true, true>(lds, g, S, E);
    }
    SEAM(8);
    if (IN(9)) {
        const float* SS = (const float*)(ws + WS_SS2); const float* gain = args.in[I_NFIN];
        const int tid = t_id(), lane = tid & 63, wave = __builtin_amdgcn_readfirstlane(tid >> 6);
        const GAS f32x4* gp = (const GAS f32x4*)gain + lane;
        f32x4 gv[4];
#pragma unroll
        for (int j = 0; j < 4; ++j) gv[j] = gp[64 * j];
        for (int m = vcu * NWAVES + wave; m < M; m += G * NWAVES) {
            const float rs = ep::rstd_from_ss(SS, m);
            GAS f32x4* yr = (GAS f32x4*)(out + O_Y + (size_t)m * D) + lane;
#pragma unroll
            for (int j = 0; j < 4; ++j) yr[64 * j] = yr[64 * j] * rs * gv[j];
        }
    }
#undef IN
#undef SEAM
}

extern "C" void kernel_launch(void* const* d_in, const int* in_sizes, int n_in, void* d_out, int out_size, void* d_ws, size_t ws_size, hipStream_t stream) {
    static int grid = 0;
    if (grid == 0) {
        if (n_in != 26 || in_sizes[0] != MP * D || (size_t)out_size != O_END || ws_size < WS_END) { fprintf(stderr, "kernel_launch: unexpected shapes (n_in %d, in0 %d, out %d, ws %zu < %zu); nothing launched\n", n_in, n_in > 0 ? in_sizes[0] : -1, out_size, ws_size, (size_t)WS_END); grid = -1; return; }
        int dev = 0, cus = 0, per_cu = 0;
        if (hipGetDevice(&dev) != hipSuccess || hipDeviceGetAttribute(&cus, hipDeviceAttributeMultiprocessorCount, dev) != hipSuccess) { grid = -1; return; }
        if (hipFuncSetAttribute((const void*)hyb_fwd, hipFuncAttributeMaxDynamicSharedMemorySize, LDS_BYTES) != hipSuccess) { fprintf(stderr, "kernel_launch: hipFuncSetAttribute failed\n"); grid = -1; return; }
        if (hipOccupancyMaxActiveBlocksPerMultiprocessor(&per_cu, (const void*)hyb_fwd, NWAVES * 64, LDS_BYTES) != hipSuccess || per_cu < 1) fprintf(stderr, "kernel_launch: occupancy query reports %d blocks per CU\n", per_cu);
        (void)hipGetLastError();
        grid = cus;
    }
    if (grid < 0) return;
    if (hipMemsetAsync((char*)d_ws + WS_CTL, 0, CTL_ZERO_BYTES, stream) != hipSuccess) return;
    Args a{};
    for (int i = 0; i < 26; ++i) a.in[i] = (const float*)d_in[i];
    a.out = (float*)d_out; a.ws = (unsigned char*)d_ws;
#if MK_N_LAUNCHES == 1
    a.ph_lo = 0; a.ph_hi = N_PHASES;
    hipLaunchKernelGGL(hyb_fwd, dim3(grid), dim3(NWAVES * 64), LDS_BYTES, stream, a);
#else
    for (int p = 0; p < N_PHASES; ++p) { a.ph_lo = p; a.ph_hi = p + 1; hipLaunchKernelGGL(hyb_fwd, dim3(grid), dim3(NWAVES * 64), LDS_BYTES, stream, a); }
#endif
}
#endif
```

```cpp
#ifndef HOST_EMU
#include <hip/hip_runtime.h>
#include <cstdio>
#include <cstdint>
#endif

namespace cfg {
constexpr int D = 1024, NB = 8, SEQ = 2048, DB = 128, DT = 8;
constexpr int MP = NB * SEQ, MS = DB * DT, M = MP + MS;
constexpr int H = 8, DK = 128, DV = 128, QKVW = 3072, CH = 64, NCH = SEQ / CH;
constexpr int SGW = 512, SGG = 4, SGC = 128;
constexpr int MEMT = 256, MEMH = 4, MEMD = 128, MEMW = 512;
constexpr int FF = 2816, DIN = 8720, N1 = 5632, NGATE = 3072, NIN = N1 + NGATE;
constexpr float RMS_EPS = 1e-6f, L2_EPS = 1e-6f;
constexpr float LOG2E = 1.4426950408889634f;
constexpr float QSCALE_MEM = 0.08838834764831845f * 1.4426950408889634f;
constexpr float QSCALE_DN = 0.08838834764831845f;
constexpr size_t O_Y = 0, O_DSP = 17825792, O_CSP = 18874368, O_MK = 18948096, O_MV = 19996672, O_DSS = 21045248, O_CSS = 37822464, O_SGV = 39002112, O_END = 39526400;
constexpr size_t MiB = 1u << 20;
constexpr size_t WS_CTL = 0, CTL_ZERO_BYTES = 128 * 1024;
constexpr size_t WS_RSTDX = 1 * MiB, WS_RSTDM = WS_RSTDX + 128 * 1024, WS_DL = WS_RSTDM + 64 * 1024, WS_BA = 1 * MiB + 256 * 1024;
constexpr size_t WS_SS1 = 5 * MiB / 2, WS_SS2 = 15 * MiB / 4;
constexpr size_t WS_WIN = 5 * MiB, WS_WBR = 22 * MiB, WS_WO = 26 * MiB, WS_WKV = 28 * MiB, WS_WGU = 30 * MiB, WS_WDN = 41 * MiB, WS_SGW = 93 * MiB / 2;
constexpr size_t WS_XB = 47 * MiB;
constexpr size_t WS_MB = 81 * MiB;
constexpr size_t WS_QMEM = 85 * MiB;
constexpr size_t WS_HALO = 102 * MiB;
constexpr size_t WS_QKV = 107 * MiB;
constexpr size_t WS_OCAT = WS_QKV, WS_X1B = WS_QKV + 68 * MiB;
constexpr size_t WS_INTER = 209 * MiB;
constexpr size_t WS_WB = WS_INTER, WS_QD = WS_INTER + 32 * MiB, WS_KDT = WS_INTER + 64 * MiB, WS_UB = WS_INTER + 96 * MiB, WS_AB = WS_INTER + 128 * MiB;
constexpr size_t WS_GATES = WS_INTER, WS_HB = WS_INTER, WS_MERGED = WS_XB;
constexpr size_t WS_GATES_S = WS_QKV + 69 * MiB;
constexpr size_t WS_END = 353 * MiB;
static_assert(WS_BA + (size_t)M * 16 * 4 <= WS_SS1 && WS_SS1 + (size_t)M * 64 <= WS_SS2 && WS_SS2 + (size_t)M * 64 <= WS_WIN, "small buffers");
static_assert(WS_WIN + (size_t)NIN * D * 2 <= WS_WBR && WS_WGU + (size_t)2 * FF * D * 2 <= WS_WDN && WS_WDN + (size_t)D * FF * 2 <= WS_SGW && WS_SGW + 4 * 128 * 128 * 2 <= WS_XB, "weights");
static_assert(WS_XB + (size_t)M * D * 2 <= WS_MB && WS_MB + 2048 * 1024 * 2 <= WS_QMEM && WS_QMEM + (size_t)M * 512 * 2 <= WS_HALO && WS_HALO + 272 * 3 * 3072 * 2 <= WS_QKV, "acts");
static_assert(WS_QKV + (size_t)M * 3072 * 2 <= WS_INTER && WS_X1B + (size_t)M * D * 2 <= WS_INTER && WS_OCAT + (size_t)M * 2048 * 2 <= WS_X1B, "qkv region");
static_assert(WS_GATES_S >= WS_OCAT + (size_t)M * 2048 * 2 && WS_GATES_S + (size_t)MS * 3072 * 2 <= WS_QKV + (size_t)MP * 3072 * 2, "sample gates");
static_assert(WS_AB + (size_t)2048 * 8192 <= WS_END && WS_GATES + (size_t)M * 3072 * 2 <= WS_END && WS_HB + (size_t)M * FF * 2 <= WS_END, "inter region");
constexpr int CW_TMO = 0, CW_CODE = 1, CW_BAR = 4096, CW_FIN = 16384, CW_FIN2 = 20480;
constexpr int RING_BYTES = 131072, LDS_BYTES = 163840, MISC_OFF = LDS_BYTES - 512;
constexpr int P2_LDS = MISC_OFF;
}

typedef unsigned short bf16;
typedef short bf16x8 __attribute__((ext_vector_type(8)));
typedef float f32x4 __attribute__((ext_vector_type(4)));
typedef float f32x16 __attribute__((ext_vector_type(16)));
typedef unsigned u32x4 __attribute__((ext_vector_type(4)));
typedef unsigned u32x2 __attribute__((ext_vector_type(2)));

#ifndef HOST_EMU
#define DI __device__ __forceinline__
#define LP(T) __attribute__((address_space(3))) T*
DI int t_id() { int t = (int)threadIdx.x; asm volatile("" : "+v"(t)); return t; }
DI void wg_sync() { __syncthreads(); }
DI void wg_sync_lds() { asm volatile("s_waitcnt lgkmcnt(0)" ::: "memory"); __builtin_amdgcn_s_barrier(); asm volatile("" ::: "memory"); }
DI void wave_sync() { __builtin_amdgcn_wave_barrier(); }
DI f32x4 mfma16(bf16x8 a, bf16x8 b, f32x4 c) { return __builtin_amdgcn_mfma_f32_16x16x32_bf16(a, b, c, 0, 0, 0); }
DI f32x16 mfma32(bf16x8 a, bf16x8 b, f32x16 c) { return __builtin_amdgcn_mfma_f32_32x32x16_bf16(a, b, c, 0, 0, 0); }
DI f32x4 mfma16f(float a, float b, f32x4 c) { return __builtin_amdgcn_mfma_f32_16x16x4f32(a, b, c, 0, 0, 0); }
DI float shfl_xor_f(float v, int m) { return __shfl_xor(v, m); }
DI float shfl_f(float v, int src) { return __shfl(v, src); }
DI float fexp2(float x) { return __builtin_amdgcn_exp2f(x); }
DI float frcp(float x) { return __builtin_amdgcn_rcpf(x); }
DI float frsq(float x) { return __builtin_amdgcn_rsqf(x); }
DI float lane_bcast(float v, int src) { return __builtin_bit_cast(float, __builtin_amdgcn_readlane(__builtin_bit_cast(int, v), __builtin_amdgcn_readfirstlane(src))); }
template <int CTRL> DI float dpp_f(float v) { return __builtin_bit_cast(float, __builtin_amdgcn_update_dpp(0, __builtin_bit_cast(int, v), CTRL, 0xf, 0xf, true)); }
DI float row_sum16(float v) { v += dpp_f<0x128>(v); v += dpp_f<0x124>(v); v += dpp_f<0x4E>(v); v += dpp_f<0xB1>(v); return v; }
DI float row_sum8(float v) { v += dpp_f<0xB1>(v); v += dpp_f<0x4E>(v); v += dpp_f<0x141>(v); return v; }
DI float wave_sum(float v) { v = row_sum16(v);
    v += __builtin_bit_cast(float, __builtin_amdgcn_update_dpp(0, __builtin_bit_cast(int, v), 0x142, 0xa, 0xf, false));
    v += __builtin_bit_cast(float, __builtin_amdgcn_update_dpp(0, __builtin_bit_cast(int, v), 0x143, 0xc, 0xf, false));
    return __builtin_bit_cast(float, __builtin_amdgcn_readlane(__builtin_bit_cast(int, v), 63)); }
DI int wave_id() { return __builtin_amdgcn_readfirstlane((int)threadIdx.x >> 6); }
#endif

#ifndef HOST_EMU
typedef float f32x2_t __attribute__((ext_vector_type(2)));
typedef __bf16 bf16x2_t __attribute__((ext_vector_type(2)));
DI unsigned pk2(float lo, float hi) { const f32x2_t v = {lo, hi}; const bf16x2_t b = __builtin_convertvector(v, bf16x2_t); return __builtin_bit_cast(unsigned, b); }
DI unsigned f2bf(float f) { return (unsigned)__builtin_bit_cast(unsigned short, (__bf16)f); }
#else
DI unsigned f2bf(float f) { unsigned u = __builtin_bit_cast(unsigned, f); return (u + 0x7fffu + ((u >> 16) & 1u)) >> 16; }
DI unsigned pk2(float lo, float hi) { return f2bf(lo) | (f2bf(hi) << 16); }
#endif
DI float bf_lo(unsigned w) { return __builtin_bit_cast(float, w << 16); }
DI float bf_hi(unsigned w) { return __builtin_bit_cast(float, w & 0xffff0000u); }
DI float bf2f(bf16 b) { return __builtin_bit_cast(float, ((unsigned)b) << 16); }
DI float sigmoid_f(float x) { return frcp(1.0f + fexp2(-cfg::LOG2E * x)); }
DI float silu_f(float x) { return x * sigmoid_f(x); }
DI float gelu_tanh_f(float x) { return x * frcp(1.0f + fexp2(-2.302208198f * (x + 0.044715f * x * x * x))); }
#ifdef HOST_EMU
DI int wave_id() { return t_id() >> 6; }
DI float lane_bcast(float v, int src) { return shfl_f(v, src); }
DI float row_sum16(float v) { v += shfl_xor_f(v, 8); v += shfl_xor_f(v, 4); v += shfl_xor_f(v, 2); v += shfl_xor_f(v, 1); return v; }
DI float row_sum8(float v) { v += shfl_xor_f(v, 1); v += shfl_xor_f(v, 2); v += shfl_xor_f(v, 4); return v; }
DI float wave_sum(float v) { v = row_sum16(v); return (shfl_f(v, 48) + shfl_f(v, 32)) + (shfl_f(v, 16) + shfl_f(v, 0)); }
#endif
DI int perm32k(int k) { const int kk = k & 31; return (k & ~31) + 8 * ((kk & 15) >> 2) + 4 * (kk >> 4) + (kk & 3); }
DI int iperm32k(int p) { const int pp = p & 31; return (p & ~31) + 16 * ((pp >> 2) & 1) + 4 * (pp >> 3) + (pp & 3); }
DI int perm16k(int k) { const int kk = k & 15; return (k & ~15) + 8 * ((kk >> 2) & 1) + 4 * (kk >> 3) + (kk & 3); }
#ifndef HOST_EMU
namespace pg8 {
#define PG8_LAS __attribute__((address_space(3)))
typedef unsigned short bf16_t;
typedef unsigned u32x4 __attribute__((ext_vector_type(4)));
constexpr int BM = 256, BK = 64, HALF = 128, HTB = HALF * BK * 2  , STAGE_BYTES = 8 * HTB, NXCD = 8, WGM = 8;

__host__ __device__ __forceinline__ int lds_byte(int r, int c) { const int st = (r >> 4) * 2 + (c >> 5), rr = r & 15, cc = c & 31, ob = rr * 64 + cc * 2; return st * 1024 + (ob ^ (((ob >> 9) & 1) << 5)); }
__host__ __device__ __forceinline__ void stage_rc(int b, int& R, int& C) { const int st = b / 1024, sb = b % 1024, swz = sb ^ (((sb >> 9) & 1) << 5); R = (st >> 1) * 16 + swz / 64; C = (st & 1) * 32 + (swz % 64) / 2; }
__host__ __device__ __forceinline__ int perm32(int rho) { const int n = rho >> 4, i = rho & 15; return 8 * (i >> 2) + 4 * n + (i & 3); }

struct Unit { int pm, pn; };
struct Gemm { const bf16_t* A; const bf16_t* Bt; int M, N, K, lda, ldb; };

struct StaticOrder {
    int nM, nN, nwg, G, c;
    __host__ __device__ void init(int M, int N, int G_, int c_) { nM = M / BM; nN = N / BM; nwg = nM * nN; G = G_; c = c_; }
    __host__ __device__ bool next(int i, Unit& u) const {
        const long L = (long)i * G + c; if (L >= nwg) return false;
        int wgid = (int)L; { const int q = nwg / NXCD, r = nwg % NXCD, xcd = wgid % NXCD, off = wgid / NXCD; wgid = (xcd < r ? xcd * (q + 1) : r * (q + 1) + (xcd - r) * q) + off; }
        const int nig = WGM * nN, gid = wgid / nig, fm = gid * WGM, gsz = (nM - fm) < WGM ? (nM - fm) : WGM;
        u.pm = fm + ((wgid % nig) % gsz); u.pn = (wgid % nig) / gsz; return true;
    }
    __device__ __forceinline__ void a_ready(const Unit&) const {}
    __device__ __forceinline__ void done(const Unit&) const {}
};

struct OneUnit {
    int pm, pn;
    __host__ __device__ bool next(int i, Unit& u) const { if (i) return false; u.pm = pm; u.pn = pn; return true; }
    __device__ __forceinline__ void a_ready(const Unit&) const {}
    __device__ __forceinline__ void done(const Unit&) const {}
};

struct ListG1 {
    int c, n;
    static constexpr int NU = 64 * 6 + 4 * 22;
    __host__ __device__ bool next(int i, Unit& u) const {
        const int U = i * n + c; if (U >= NU) return false;
        if (U < 384) { u.pm = U / 6; u.pn = 16 + U % 6; } else { const int s = U - 384; u.pm = 64 + s / 22; u.pn = s % 22; }
        return true;
    }
    __device__ __forceinline__ void a_ready(const Unit&) const {}
    __device__ __forceinline__ void done(const Unit&) const {}
};

__device__ __forceinline__ unsigned cvt_pk_bf16(float lo, float hi) { return pk2(lo, hi); }
template <class Epi, class Sched, bool ALIGN_EPI = false, bool SP2 = false>
__device__ __forceinline__ void gemm_phase(PG8_LAS unsigned char* lds, const Gemm g, const Sched& S, const Epi& E) {
    const int tid = t_id(), wid = __builtin_amdgcn_readfirstlane(tid >> 6), lane = tid & 63, wr = wid >> 2, wc = wid & 3, fr = lane & 15, fq = lane >> 4;
    const int K = g.K, nt = K / BK;
    unsigned voffA[2], voffB[2];
#pragma unroll
    for (int i = 0; i < 2; ++i) { int R, C; stage_rc(tid * 16 + i * 8192, R, C); const int Rb = Epi::PERM ? ((R & ~31) + perm32(R & 31)) : R;
        voffA[i] = (unsigned)(R * g.lda + C) * 2u; voffB[i] = (unsigned)(Rb * g.ldb + C) * 2u; }
    const size_t kstep = (size_t)(BK * 2);
    const size_t hstepA = (size_t)HALF * g.lda * 2, hstepB = (size_t)HALF * g.ldb * 2;
    const size_t tstepA = 2 * hstepA, tstepB = 2 * hstepB;
    const unsigned ldsw = (unsigned)wid * 1024u;
    const int aoff = lds_byte(wr * 64 + fr, fq * 8), boff = lds_byte(wc * 32 + fr, fq * 8);
#define PG8_SA(b, h) (((b) * 2 + (h)) * HTB)
#define PG8_SB(b, h) ((4 + (b) * 2 + (h)) * HTB)
#define PG8_STAGE(bufoff, gbase, voff) do { _Pragma("unroll") for (int _i = 0; _i < 2; ++_i) \
        __builtin_amdgcn_global_load_lds((const unsigned*)((const char*)(gbase) + (voff)[_i]), (PG8_LAS unsigned*)(lds + (bufoff) + ldsw + _i * 8192), 16, 0, 0); } while (0)
#define PG8_LDA(dst, b, h) do { _Pragma("unroll") for (int m = 0; m < 4; ++m) _Pragma("unroll") for (int k = 0; k < 2; ++k) dst[m][k] = *(const PG8_LAS bf16x8*)(lds + PG8_SA(b, h) + aoff + m * 2048 + k * 1024); } while (0)
#define PG8_LDB(dst, b, h) do { _Pragma("unroll") for (int n = 0; n < 2; ++n) _Pragma("unroll") for (int k = 0; k < 2; ++k) dst[n][k] = *(const PG8_LAS bf16x8*)(lds + PG8_SB(b, h) + boff + n * 2048 + k * 1024); } while (0)
#define PG8_MMA(ai, bj, At, Bt) do { __builtin_amdgcn_s_setprio(1); _Pragma("unroll") for (int m = 0; m < 4; ++m) _Pragma("unroll") for (int n = 0; n < 2; ++n) _Pragma("unroll") for (int k = 0; k < 2; ++k) \
        acc[ai][bj][m][n] = __builtin_amdgcn_mfma_f32_16x16x32_bf16(Bt[n][k], At[m][k], acc[ai][bj][m][n], 0, 0, 0); __builtin_amdgcn_s_setprio(0); } while (0)
#define PG8_WAIT_V(n) asm volatile("s_waitcnt vmcnt(" #n ")" ::: "memory")
#define PG8_WAIT_L(n) asm volatile("s_waitcnt lgkmcnt(" #n ")" ::: "memory")
#define PG8_BAR __builtin_amdgcn_s_barrier()
#define PG8_SCHED __builtin_amdgcn_sched_barrier(0)
    Unit cur, nxt; int ui = 0;
    if (!S.next(0, cur)) return;
    f32x4 acc[2][2][4][2];
#pragma unroll
    for (int a = 0; a < 2; ++a)
#pragma unroll
        for (int b = 0; b < 2; ++b)
#pragma unroll
            for (int m = 0; m < 4; ++m)
#pragma unroll
                for (int n = 0; n < 2; ++n) acc[a][b][m][n] = (f32x4){0.f, 0.f, 0.f, 0.f};
    bf16x8 At[4][2], B0[2][2], B1[2][2];
    const char* cA = (const char*)g.A + (size_t)cur.pm * tstepA; const char* cB = (const char*)g.Bt + (size_t)cur.pn * tstepB;
    S.a_ready(cur);
    if constexpr (SP2) {
        PG8_STAGE(PG8_SB(0, 0), cB, voffB); PG8_STAGE(PG8_SB(0, 1), cB + hstepB, voffB); PG8_STAGE(PG8_SA(0, 0), cA, voffA); PG8_STAGE(PG8_SA(0, 1), cA + hstepA, voffA);
        if (wr == 1) PG8_BAR;
        PG8_WAIT_V(2); PG8_BAR;
        PG8_STAGE(PG8_SB(1, 0), cB + kstep, voffB); PG8_STAGE(PG8_SA(1, 0), cA + kstep, voffA); PG8_STAGE(PG8_SB(1, 1), cB + hstepB + kstep, voffB);
        PG8_WAIT_V(6); PG8_BAR;
    } else {
        PG8_STAGE(PG8_SB(0, 0), cB, voffB); PG8_STAGE(PG8_SA(0, 0), cA, voffA); PG8_STAGE(PG8_SB(0, 1), cB + hstepB, voffB); PG8_STAGE(PG8_SA(0, 1), cA + hstepA, voffA);
        if (wr == 1) PG8_BAR;
        PG8_WAIT_V(4); PG8_BAR;
        PG8_STAGE(PG8_SB(1, 0), cB + kstep, voffB); PG8_STAGE(PG8_SA(1, 0), cA + kstep, voffA); PG8_STAGE(PG8_SB(1, 1), cB + hstepB + kstep, voffB);
        PG8_WAIT_V(6); PG8_BAR;
    }
    for (;;) {
        const bool has_next = S.next(ui + 1, nxt);
        const char* nA = has_next ? (const char*)g.A + (size_t)nxt.pm * tstepA : cA; const char* nB = has_next ? (const char*)g.Bt + (size_t)nxt.pn * tstepB : cB;
        for (int t = 0; t < nt; t += 2) {
            const bool last = (t == nt - 2);
            const char* a1 = cA + (size_t)(t + 1) * kstep;
            const char* a2 = last ? nA : cA + (size_t)(t + 2) * kstep; const char* b2 = last ? nB : cB + (size_t)(t + 2) * kstep;
            const char* a3 = a2 + kstep; const char* b3 = b2 + kstep;
            if (last && has_next) S.a_ready(nxt);
            if constexpr (SP2) {
            PG8_LDB(B0, 0, 0); PG8_LDB(B1, 0, 1); PG8_SCHED; PG8_LDA(At, 0, 0); PG8_STAGE(PG8_SA(1, 1), a1 + hstepA, voffA);
            PG8_WAIT_V(8); PG8_WAIT_L(0); PG8_BAR; PG8_MMA(0, 0, At, B0); PG8_MMA(0, 1, At, B1); PG8_BAR; PG8_SCHED;
            PG8_LDA(At, 0, 1); PG8_STAGE(PG8_SB(0, 0), b2, voffB); PG8_STAGE(PG8_SB(0, 1), b2 + hstepB, voffB); PG8_STAGE(PG8_SA(0, 0), a2, voffA);
            PG8_WAIT_V(8); PG8_WAIT_L(0); PG8_BAR; PG8_MMA(1, 0, At, B0); PG8_MMA(1, 1, At, B1); PG8_BAR; PG8_SCHED;
            PG8_LDB(B0, 1, 0); PG8_LDB(B1, 1, 1); PG8_SCHED; PG8_LDA(At, 1, 0); PG8_STAGE(PG8_SA(0, 1), a2 + hstepA, voffA);
            PG8_WAIT_V(8); PG8_WAIT_L(0); PG8_BAR; PG8_MMA(0, 0, At, B0); PG8_MMA(0, 1, At, B1); PG8_BAR; PG8_SCHED;
            PG8_LDA(At, 1, 1); PG8_STAGE(PG8_SB(1, 0), b3, voffB); PG8_STAGE(PG8_SB(1, 1), b3 + hstepB, voffB); PG8_STAGE(PG8_SA(1, 0), a3, voffA);
            PG8_WAIT_V(8); PG8_WAIT_L(0); PG8_BAR; PG8_MMA(1, 0, At, B0); PG8_MMA(1, 1, At, B1); PG8_BAR; PG8_SCHED;
            } else {
            PG8_LDB(B0, 0, 0); PG8_SCHED; PG8_LDA(At, 0, 0); PG8_STAGE(PG8_SA(1, 1), a1 + hstepA, voffA);
            PG8_WAIT_L(8); PG8_BAR; PG8_WAIT_L(0); PG8_MMA(0, 0, At, B0); PG8_BAR; PG8_SCHED;
            PG8_LDB(B1, 0, 1); PG8_STAGE(PG8_SB(0, 0), b2, voffB);
            PG8_BAR; PG8_WAIT_L(0); PG8_MMA(0, 1, At, B1); PG8_BAR;
            PG8_LDA(At, 0, 1); PG8_STAGE(PG8_SA(0, 0), a2, voffA);
            PG8_BAR; PG8_WAIT_L(0); PG8_MMA(1, 0, At, B0); PG8_BAR; PG8_SCHED;
            PG8_STAGE(PG8_SB(0, 1), b2 + hstepB, voffB);
            PG8_WAIT_V(6); PG8_BAR; PG8_MMA(1, 1, At, B1); PG8_BAR;
            PG8_LDB(B0, 1, 0); PG8_SCHED; PG8_LDA(At, 1, 0); PG8_STAGE(PG8_SA(0, 1), a2 + hstepA, voffA);
            PG8_WAIT_L(8); PG8_BAR; PG8_WAIT_L(0); PG8_MMA(0, 0, At, B0); PG8_BAR; PG8_SCHED;
            PG8_LDB(B1, 1, 1); PG8_STAGE(PG8_SB(1, 0), b3, voffB);
            PG8_BAR; PG8_WAIT_L(0); PG8_MMA(0, 1, At, B1); PG8_BAR;
            PG8_LDA(At, 1, 1); PG8_STAGE(PG8_SA(1, 0), a3, voffA);
            PG8_BAR; PG8_WAIT_L(0); PG8_MMA(1, 0, At, B0); PG8_BAR; PG8_SCHED;
            PG8_STAGE(PG8_SB(1, 1), b3 + hstepB, voffB);
            PG8_WAIT_V(6); PG8_BAR; PG8_MMA(1, 1, At, B1); PG8_BAR;
            }
        }
        if constexpr (ALIGN_EPI) { if (wr == 0) PG8_BAR; }
        if constexpr (!Epi::AFTER_DRAIN) { E(acc, cur, wr, wc, fr, fq); S.done(cur); }
        if (!has_next) break;
#pragma unroll
        for (int a = 0; a < 2; ++a)
#pragma unroll
            for (int b = 0; b < 2; ++b)
#pragma unroll
                for (int m = 0; m < 4; ++m)
#pragma unroll
                    for (int n = 0; n < 2; ++n) acc[a][b][m][n] = (f32x4){0.f, 0.f, 0.f, 0.f};
        cur = nxt; cA = nA; cB = nB; ++ui;
        if constexpr (ALIGN_EPI) { if (wr == 1) PG8_BAR; }
    }
    PG8_WAIT_V(0);
    if constexpr (!ALIGN_EPI) { if (wr == 0) PG8_BAR; }
    PG8_BAR;
    if constexpr (Epi::AFTER_DRAIN) { E.fused(acc, cur, wr, wc, fr, fq, lds, wid, lane); S.done(cur); }
#undef PG8_SA
#undef PG8_SB
#undef PG8_STAGE
#undef PG8_LDA
#undef PG8_LDB
#undef PG8_MMA
#undef PG8_WAIT_V
#undef PG8_WAIT_L
#undef PG8_BAR
#undef PG8_SCHED
}
}
#define GAS __attribute__((address_space(1)))
#define LAS __attribute__((address_space(3)))
typedef unsigned short bf16;
typedef unsigned v4u __attribute__((ext_vector_type(4)));
typedef float f32x4 __attribute__((ext_vector_type(4)));
typedef short bf16x8 __attribute__((ext_vector_type(8)));
typedef GAS unsigned gu32;
typedef GAS unsigned long long gu64;
#define RLX_AGENT __ATOMIC_RELAXED, __HIP_MEMORY_SCOPE_AGENT
#define LDS_WAIT() asm volatile("s_waitcnt lgkmcnt(0)" ::: "memory")
#define VM_WAIT() asm volatile("s_waitcnt vmcnt(0)" ::: "memory")
__device__ __forceinline__ unsigned long long rt() { return __builtin_amdgcn_s_memrealtime(); }

#define XB_TMO      128
#define XB_XCNT(j)  (256  + 64 * (j))
#define XB_XSUB(j)  (1280 + 64 * (j))
#define XB_XGEN(j)  (2304 + 64 * (j))
#define XB_TOP      3328
#define XB_TOPGEN   3392
#define XCD_BAR_WORDS 3456
#define XB_SPIN_CAP (1u << 18)

__device__ __forceinline__ unsigned xb_ld(unsigned* p)              { return __hip_atomic_load(p, __ATOMIC_RELAXED, __HIP_MEMORY_SCOPE_AGENT); }
__device__ __forceinline__ unsigned xb_add(unsigned* p, unsigned v) { return __hip_atomic_fetch_add(p, v, __ATOMIC_RELAXED, __HIP_MEMORY_SCOPE_AGENT); }
__device__ __forceinline__ unsigned xb_xcc_id() { return (unsigned)__builtin_amdgcn_s_getreg((3 << 11) | 20) & 0xFu; }
#define XB_SPIN(cond, bar) do { unsigned _sp = 0; while (cond) { __builtin_amdgcn_s_sleep(1); \
    if ((++_sp & 255u) == 0u) { if (xb_ld(&(bar)[XB_TMO])) break; if (_sp > XB_SPIN_CAP) { atomicAdd(&(bar)[XB_TMO], 1u); break; } } } } while (0)

struct XcdBarrier {
    unsigned* bar; unsigned x;
    volatile LAS unsigned* st;
};

__device__ __forceinline__ XcdBarrier xcd_barrier_post(unsigned* bar, volatile LAS unsigned* st) {
    XcdBarrier b; b.bar = bar; b.x = xb_xcc_id(); b.st = st;
    if (threadIdx.x == 0) (void)xb_add(&bar[XB_XCNT(b.x)], 1u);
    return b;
}
__device__ __forceinline__ void xcd_barrier_complete(unsigned* bar, unsigned x, unsigned& nloc, unsigned& nx) {
    const unsigned G = gridDim.x * gridDim.y * gridDim.z;
    unsigned sum, cnt, mine, sp = 0u;
    for (;;) {
        sum = 0u; cnt = 0u; mine = 0u;
#pragma unroll
        for (unsigned j = 0; j < 16; ++j) { const unsigned c = xb_ld(&bar[XB_XCNT(j)]); sum += c; cnt += (c > 0u) ? 1u : 0u; mine = (j == x) ? c : mine; }
        if (sum == G) break;
        __builtin_amdgcn_s_sleep(1);
        if ((++sp & 255u) == 0u) { if (xb_ld(&bar[XB_TMO])) break; if (sp > XB_SPIN_CAP) { atomicAdd(&bar[XB_TMO], 1u); break; } }
    }
    nloc = mine > 0u ? mine : 1u; nx = cnt > 0u ? cnt : 1u;
}

__device__ __forceinline__ void xcd_barrier(const XcdBarrier& b) {
    asm volatile("s_waitcnt vmcnt(0)" ::: "memory");
    __syncthreads();
    if (threadIdx.x == 0) {
        unsigned* bar = b.bar;
        __builtin_amdgcn_s_waitcnt(0);
        unsigned nloc = b.st[0], nx = b.st[1];
        if (nloc == 0u) { xcd_barrier_complete(bar, b.x, nloc, nx); b.st[0] = nloc; b.st[1] = nx; }
        const unsigned old = xb_add(&bar[XB_XSUB(b.x)], 1u);
        const unsigned gen = old / nloc;
        if (old + 1u == (gen + 1u) * nloc) {
            __builtin_amdgcn_fence(__ATOMIC_RELEASE, "agent");
            asm volatile("s_waitcnt vmcnt(0)" ::: "memory");
            const unsigned og = xb_add(&bar[XB_TOP], 1u);
            const unsigned tg = og / nx;
            if (og + 1u == (tg + 1u) * nx) xb_add(&bar[XB_TOPGEN], 1u);
            else XB_SPIN(xb_ld(&bar[XB_TOPGEN]) == tg, bar);
            __builtin_amdgcn_fence(__ATOMIC_ACQUIRE, "agent");
            xb_add(&bar[XB_XGEN(b.x)], 1u);
            asm volatile("s_waitcnt vmcnt(0)" ::: "memory");
        } else {
            XB_SPIN(xb_ld(&bar[XB_XGEN(b.x)]) == gen, bar);
            __builtin_amdgcn_fence(__ATOMIC_ACQUIRE, "agent");
            asm volatile("s_waitcnt vmcnt(0)" ::: "memory");
        }
    }
    __syncthreads();
}
#endif
struct DnPtrs {
    const bf16* QKV; const bf16* HALO; const float* BA; const float* conv_w; const float* a_log; const float* dt_bias; const float* dn_norm;
    bf16* WB; bf16* QD; bf16* KDT; unsigned* UB; bf16* AB; float* DL;
    const bf16* Z; bf16* OCAT; float* DSP;
    const float* state_delta; const float* state_conv; float* DSS;
};
namespace dn {
using namespace cfg;
constexpr int QN_LD = 136, TB_LD = 72, LM_LD = 68;
constexpr int L_QN = 0, L_KN = L_QN + 64 * QN_LD * 2, L_VBT = L_KN + 64 * QN_LD * 2, L_KBGT = L_VBT + 128 * TB_LD * 2, L_KDT = L_KBGT + 128 * TB_LD * 2,
              L_LM = L_KDT + 128 * 64 * 2, L_TM = L_LM + 64 * LM_LD * 4, L_TB = L_TM + 64 * LM_LD * 4, L_GC = L_TB + 64 * TB_LD * 2, L_BETA = L_GC + 256, L_PREP_END = L_BETA + 256;
static_assert(L_PREP_END <= P2_LDS, "prep LDS");

DI float softplus_f(float x) { return (x > 0.f ? x : 0.f) + log1pf(expf(-fabsf(x))); }

struct PrepRaw { unsigned q[11], k[11], v[11]; float ba0, ba1; };
DI void prep_fetch(const DnPtrs& P, PrepRaw& R, int b, int h, int n) {
    const int tid = t_id(), w = wave_id(), l = tid & 63;
    const int row0 = b * SEQ + n * CH, gch = row0 >> 6, c0 = iperm32k(2 * l);
    const float* ba = P.BA + (size_t)(row0 + l) * 16;
    R.ba0 = ba[h]; R.ba1 = ba[8 + h];
#pragma unroll
    for (int i = 0; i < 11; ++i) {
        const int rt = 8 * w - 3 + i;
        unsigned uq = 0, uk = 0, uv = 0;
        if (rt >= 0) { const bf16* p = P.QKV + (size_t)(row0 + rt) * QKVW + h * 128 + c0; uq = *(const unsigned*)p; uk = *(const unsigned*)(p + 1024); uv = *(const unsigned*)(p + 2048); }
        else if (n > 0) { const bf16* p = P.HALO + ((size_t)(gch - 1) * 3 + (rt + 3)) * QKVW + h * 128 + c0; uq = *(const unsigned*)p; uk = *(const unsigned*)(p + 1024); uv = *(const unsigned*)(p + 2048); }
        R.q[i] = uq; R.k[i] = uk; R.v[i] = uv;
    }
}
DI void prep_item(LP(unsigned char) lds, const DnPtrs& P, int b, int h, int n, PrepRaw& R, bool more, int bn, int hn, int nn) {
    const int tid = t_id(), w = wave_id(), l = tid & 63, fr = l & 15, fq = l >> 4;
    const int row0 = b * SEQ + n * CH, it = (b * H + h) * NCH + n, gch = row0 >> 6;
    LP(bf16) QN = (LP(bf16))(lds + L_QN); LP(bf16) KN = (LP(bf16))(lds + L_KN); LP(bf16) VBT = (LP(bf16))(lds + L_VBT); LP(bf16) KBGT = (LP(bf16))(lds + L_KBGT);
    LP(bf16) KDTl = (LP(bf16))(lds + L_KDT); LP(float) LM = (LP(float))(lds + L_LM); LP(float) TM = (LP(float))(lds + L_TM); LP(bf16) TB = (LP(bf16))(lds + L_TB);
    LP(float) GC = (LP(float))(lds + L_GC); LP(float) BETA = (LP(float))(lds + L_BETA);
    wg_sync();
#ifndef DUPP
#define DUPP 0
#endif
    float beta_t, gc_t;
    {
        beta_t = 1.0f / (1.0f + expf(-R.ba0));
        const float g = -expf(P.a_log[h]) * softplus_f(R.ba1 + P.dt_bias[h]);
        gc_t = g;
#pragma unroll
        for (int o = 1; o < 64; o <<= 1) { const float up = shfl_f(gc_t, (l - o) & 63); if (l >= o) gc_t += up; }
        if (w == 0) { GC[l] = gc_t; BETA[l] = beta_t; }
    }
    const float gc_last = lane_bcast(gc_t, 63);
    {
        const int c0 = iperm32k(2 * l);
        float wq[4][2], wk[4][2], wv[4][2];
#pragma unroll
        for (int i = 0; i < 4; ++i)
#pragma unroll
            for (int e = 0; e < 2; ++e) { wq[i][e] = P.conv_w[i * QKVW + h * 128 + c0 + e]; wk[i][e] = P.conv_w[i * QKVW + 1024 + h * 128 + c0 + e]; wv[i][e] = P.conv_w[i * QKVW + 2048 + h * 128 + c0 + e]; }
        float xq[11][2], xk[11][2], xv[11][2];
#pragma unroll
        for (int i = 0; i < 11; ++i) { xq[i][0] = bf_lo(R.q[i]); xq[i][1] = bf_hi(R.q[i]); xk[i][0] = bf_lo(R.k[i]); xk[i][1] = bf_hi(R.k[i]); xv[i][0] = bf_lo(R.v[i]); xv[i][1] = bf_hi(R.v[i]); }
        if (more) prep_fetch(P, R, bn, hn, nn);
        float kbg_prev[2] = {0.f, 0.f}, kd_prev[2] = {0.f, 0.f}, vb_prev[2] = {0.f, 0.f};
#pragma unroll
        for (int j = 0; j < 8; ++j) {
            const int t = 8 * w + j;
            float q[2], k[2], v[2];
#pragma unroll
            for (int e = 0; e < 2; ++e) {
                q[e] = silu_f(xq[j][e] * wq[0][e] + xq[j + 1][e] * wq[1][e] + xq[j + 2][e] * wq[2][e] + xq[j + 3][e] * wq[3][e]);
                k[e] = silu_f(xk[j][e] * wk[0][e] + xk[j + 1][e] * wk[1][e] + xk[j + 2][e] * wk[2][e] + xk[j + 3][e] * wk[3][e]);
                v[e] = silu_f(xv[j][e] * wv[0][e] + xv[j + 1][e] * wv[1][e] + xv[j + 2][e] * wv[2][e] + xv[j + 3][e] * wv[3][e]);
            }
            const float sq = wave_sum(q[0] * q[0] + q[1] * q[1]), sk = wave_sum(k[0] * k[0] + k[1] * k[1]);
            const float rq = frsq(sq + L2_EPS), rk = frsq(sk + L2_EPS);
            const float bt = lane_bcast(beta_t, t), gt = lane_bcast(gc_t, t);
            const float eg = fexp2(LOG2E * gt), egl = fexp2(LOG2E * (gc_last - gt));
            q[0] *= rq; q[1] *= rq; k[0] *= rk; k[1] *= rk;
            *(LP(unsigned))(QN + t * QN_LD + 2 * l) = pk2(q[0], q[1]);
            *(LP(unsigned))(KN + t * QN_LD + 2 * l) = pk2(k[0], k[1]);
            *(unsigned*)(P.QD + (size_t)(row0 + t) * D + h * 128 + 2 * l) = pk2(q[0] * eg * QSCALE_DN, q[1] * eg * QSCALE_DN);
            const float kbg[2] = {k[0] * bt * eg, k[1] * bt * eg}, kd[2] = {k[0] * egl, k[1] * egl}, vb[2] = {v[0] * bt, v[1] * bt};
            if (j & 1) {
#pragma unroll
                for (int e = 0; e < 2; ++e) {
                    *(LP(unsigned))(KBGT + (c0 + e) * TB_LD + (t - 1)) = pk2(kbg_prev[e], kbg[e]);
                    *(LP(unsigned))(VBT + (c0 + e) * TB_LD + (t - 1)) = pk2(vb_prev[e], vb[e]);
                    *(LP(unsigned))(KDTl + (c0 + e) * 64 + perm32k(t - 1)) = pk2(kd_prev[e], kd[e]);
                }
            }
            kbg_prev[0] = kbg[0]; kbg_prev[1] = kbg[1]; kd_prev[0] = kd[0]; kd_prev[1] = kd[1]; vb_prev[0] = vb[0]; vb_prev[1] = vb[1];
        }
    }
    wg_sync_lds();
    {
        const int s = w >> 2;
        {
            const int in = w & 3;
            f32x4 acc[2] = {{0.f, 0.f, 0.f, 0.f}, {0.f, 0.f, 0.f, 0.f}};
            bf16x8 qf[4], kf[2][4];
#pragma unroll
            for (int ks = 0; ks < 4; ++ks) qf[ks] = *(LP(bf16x8))(QN + (16 * in + fr) * QN_LD + 32 * ks + 8 * fq);
#pragma unroll
            for (int mm = 0; mm < 2; ++mm) if (in >= 2 * s + mm) {
#pragma unroll
                for (int ks = 0; ks < 4; ++ks) kf[mm][ks] = *(LP(bf16x8))(KN + (16 * (2 * s + mm) + fr) * QN_LD + 32 * ks + 8 * fq); }
#pragma unroll
            for (int mm = 0; mm < 2; ++mm) if (in >= 2 * s + mm) {
#pragma unroll
                for (int ks = 0; ks < 4; ++ks) acc[mm] = mfma16(kf[mm][ks], qf[ks], acc[mm]); }
            const int ti = 16 * in + fr; const float gi = GC[ti];
            float o[8];
#pragma unroll
            for (int mm = 0; mm < 2; ++mm)
#pragma unroll
                for (int r = 0; r < 4; ++r) { const int tj = 32 * s + 16 * mm + 4 * fq + r; o[4 * mm + r] = (ti >= tj) ? acc[mm][r] * fexp2(LOG2E * (gi - GC[tj])) * QSCALE_DN : 0.f; }
            u32x4 pk; pk.x = pk2(o[0], o[1]); pk.y = pk2(o[2], o[3]); pk.z = pk2(o[4], o[5]); pk.w = pk2(o[6], o[7]);
            *(u32x4*)(P.AB + (size_t)it * 4096 + ti * 64 + 32 * s + 8 * fq) = pk;
        }
        const int im = w >> 1;
        bf16x8 ka[4], kb[2][4];
#pragma unroll
        for (int ks = 0; ks < 4; ++ks) ka[ks] = *(LP(bf16x8))(KN + (16 * im + fr) * QN_LD + 32 * ks + 8 * fq);
#pragma unroll
        for (int jj = 0; jj < 2; ++jj) if (2 * (w & 1) + jj <= im) {
#pragma unroll
            for (int ks = 0; ks < 4; ++ks) kb[jj][ks] = *(LP(bf16x8))(KN + (16 * (2 * (w & 1) + jj) + fr) * QN_LD + 32 * ks + 8 * fq); }
#pragma unroll
        for (int jj = 0; jj < 2; ++jj) {
            const int jn = 2 * (w & 1) + jj;
            if (jn <= im) {
                f32x4 acc = {0.f, 0.f, 0.f, 0.f};
#pragma unroll
                for (int ks = 0; ks < 4; ++ks) acc = mfma16(ka[ks], kb[jj][ks], acc);
                const int tj = 16 * jn + fr; const float gj = GC[tj];
#pragma unroll
                for (int r = 0; r < 4; ++r) { const int ti = 16 * im + 4 * fq + r; LM[ti * LM_LD + tj] = (ti > tj) ? BETA[ti] * acc[r] * fexp2(LOG2E * (GC[ti] - gj)) : 0.f; }
            }
        }
    }
    wg_sync_lds();
    {
    if (w == 0) {
        const int I = fq, c = fr;
        f32x4 Lr[16][4];
#pragma unroll
        for (int r = 1; r < 16; ++r)
#pragma unroll
            for (int ch = 0; ch < 4; ++ch) if (4 * ch < r) Lr[r][ch] = *(LP(f32x4))(LM + (16 * I + r) * LM_LD + 16 * I + 4 * ch);
        float X[16];
#pragma unroll
        for (int r = 0; r < 16; ++r) {
            float a = (c == r) ? 1.f : 0.f;
#pragma unroll
            for (int j = 0; j < r; ++j) a -= Lr[r][j >> 2][j & 3] * X[j];
            X[r] = a;
        }
#pragma unroll
        for (int r = 0; r < 16; ++r) TM[(16 * I + r) * LM_LD + 16 * I + c] = X[r];
    }
    wg_sync_lds();
#pragma unroll
    for (int lev = 1; lev <= 3; ++lev) {
        if (w < 4 - lev) {
            const int J = w, I = w + lev;
            f32x4 la[3], tb[3], dd;
#pragma unroll
            for (int kk = 0; kk < 3; ++kk) if (kk < lev) { const int K = J + kk;
                la[kk] = *(LP(f32x4))(LM + (16 * I + fr) * LM_LD + 16 * K + 4 * fq);
#pragma unroll
                for (int s = 0; s < 4; ++s) tb[kk][s] = TM[(16 * K + 4 * fq + s) * LM_LD + 16 * J + fr]; }
            dd = *(LP(f32x4))(TM + (16 * I + fr) * LM_LD + 16 * I + 4 * fq);
            f32x4 y = {0.f, 0.f, 0.f, 0.f};
#pragma unroll
            for (int kk = 0; kk < 3; ++kk) if (kk < lev) {
#pragma unroll
                for (int s = 0; s < 4; ++s) y = mfma16f(la[kk][s], tb[kk][s], y); }
            f32x4 x = {0.f, 0.f, 0.f, 0.f};
#pragma unroll
            for (int s = 0; s < 4; ++s) x = mfma16f(dd[s], y[s], x);
#pragma unroll
            for (int r = 0; r < 4; ++r) TM[(16 * I + 4 * fq + r) * LM_LD + 16 * J + fr] = -x[r];
        }
        wg_sync_lds();
    }
    }
    {
        const int i = tid >> 3, j0 = (tid & 7) * 8;
        float v[8];
#pragma unroll
        for (int e = 0; e < 8; ++e) v[e] = ((j0 >> 4) <= (i >> 4)) ? TM[i * LM_LD + j0 + e] : 0.f;
        u32x4 pk; pk.x = pk2(v[0], v[1]); pk.y = pk2(v[2], v[3]); pk.z = pk2(v[4], v[5]); pk.w = pk2(v[6], v[7]);
        *(LP(u32x4))(TB + i * TB_LD + j0) = pk;
    }
    wg_sync_lds();
    {
        f32x4 u[4];
        bf16x8 tf[4][2], vf[2], kbf[2][2], tbf[2][2];
        const int s = w >> 1;
#pragma unroll
        for (int ks = 0; ks < 2; ++ks) { vf[ks] = *(LP(bf16x8))(VBT + (16 * w + fr) * TB_LD + 32 * ks + 8 * fq);
#pragma unroll
            for (int i = 0; i < 4; ++i) if (ks == 0 || i >= 2) tf[i][ks] = *(LP(bf16x8))(TB + (16 * i + fr) * TB_LD + 32 * ks + 8 * fq);
#pragma unroll
            for (int mm = 0; mm < 2; ++mm) kbf[mm][ks] = *(LP(bf16x8))(KBGT + (32 * s + 16 * mm + fr) * TB_LD + 32 * ks + 8 * fq);
#pragma unroll
            for (int nn = 0; nn < 2; ++nn) tbf[nn][ks] = *(LP(bf16x8))(TB + (16 * (2 * (w & 1) + nn) + fr) * TB_LD + 32 * ks + 8 * fq); }
#pragma unroll
        for (int i = 0; i < 4; ++i) {
            u[i] = (f32x4){0.f, 0.f, 0.f, 0.f};
#pragma unroll
            for (int ks = 0; ks < 2; ++ks) if (ks == 0 || i >= 2) u[i] = mfma16(tf[i][ks], vf[ks], u[i]);
            unsigned* ub = P.UB + (size_t)it * 4096 + ((w * 4 + i) * 2) * 64 + l;
            ub[0] = pk2(u[i][0], u[i][1]); ub[64] = pk2(u[i][2], u[i][3]);
        }
#pragma unroll
        for (int nn = 0; nn < 2; ++nn) {
            const int nt = 2 * (w & 1) + nn;
            f32x4 acc[2] = {{0.f, 0.f, 0.f, 0.f}, {0.f, 0.f, 0.f, 0.f}};
#pragma unroll
            for (int mm = 0; mm < 2; ++mm)
#pragma unroll
                for (int ks = 0; ks < 2; ++ks) if (ks == 0 || nt >= 2) acc[mm] = mfma16(kbf[mm][ks], tbf[nn][ks], acc[mm]);
            u32x4 pk; pk.x = pk2(acc[0][0], acc[0][1]); pk.y = pk2(acc[0][2], acc[0][3]); pk.z = pk2(acc[1][0], acc[1][1]); pk.w = pk2(acc[1][2], acc[1][3]);
            *(u32x4*)(P.WB + (size_t)(row0 + 16 * nt + fr) * D + h * 128 + 32 * s + 8 * fq) = pk;
        }
#pragma unroll
        for (int e = 0; e < 2; ++e) { const int o = (tid + 512 * e) * 8; *(u32x4*)(P.KDT + (size_t)it * 8192 + o) = *(LP(u32x4))(KDTl + o); }
        if (tid == 0) P.DL[it] = expf(gc_last);
    }
}

constexpr int W_LD = 136, A_LD = 72;
constexpr int SB_W = 0, SB_Q = SB_W + 64 * W_LD * 2, SB_A = SB_Q + 64 * W_LD * 2, SB_KD = SB_A + 64 * A_LD * 2, SB_SIZE = SB_KD + 128 * A_LD * 2;
constexpr int L_PL = 2 * SB_SIZE, L_RL = L_PL + 8 * 64 * 4, L_OL = L_RL + 64 * 4, L_SCAN_END = L_OL + 64 * W_LD * 2;
static_assert(L_SCAN_END <= P2_LDS, "scan LDS");
DI bf16x8 pack8(const f32x4& a, const f32x4& b) { u32x4 p; p.x = pk2(a[0], a[1]); p.y = pk2(a[2], a[3]); p.z = pk2(b[0], b[1]); p.w = pk2(b[2], b[3]); return __builtin_bit_cast(bf16x8, p); }

DI void scan_item(LP(unsigned char) lds, const DnPtrs& P, int b, int h) {
    const int tid = t_id(), w = wave_id(), l = tid & 63, fr = l & 15, fq = l >> 4;
    const int it0 = (b * H + h) * NCH;
    LP(float) PL = (LP(float))(lds + L_PL); LP(float) RL = (LP(float))(lds + L_RL); LP(bf16) OL = (LP(bf16))(lds + L_OL);
    f32x4 S[8];
#pragma unroll
    for (int m = 0; m < 8; ++m) S[m] = (f32x4){0.f, 0.f, 0.f, 0.f};
    u32x4 pw[2], pq[2], pa, pkd[2], pz[2], zcur[2]; unsigned pu[8], ucur[8]; float pdl, dlcur;
    const float dnn = P.dn_norm[16 * w + fr];
#define DN_LOAD(n_) do { const int it_ = it0 + (n_); const size_t r0_ = (size_t)(b * SEQ + (n_) * CH); \
        _Pragma("unroll") for (int e = 0; e < 2; ++e) { const int p_ = tid + 512 * e; \
            pw[e] = *(const u32x4*)(P.WB + (r0_ + (p_ >> 4)) * D + h * 128 + (p_ & 15) * 8); pq[e] = *(const u32x4*)(P.QD + (r0_ + (p_ >> 4)) * D + h * 128 + (p_ & 15) * 8); \
            pkd[e] = *(const u32x4*)(P.KDT + (size_t)it_ * 8192 + (p_ >> 3) * 64 + (p_ & 7) * 8); \
            pz[e] = *(const u32x4*)(P.Z + (r0_ + (p_ >> 4)) * D + h * 128 + (p_ & 15) * 8); } \
        pa = *(const u32x4*)(P.AB + (size_t)it_ * 4096 + (tid >> 3) * 64 + (tid & 7) * 8); \
        _Pragma("unroll") for (int e = 0; e < 8; ++e) pu[e] = P.UB[(size_t)it_ * 4096 + (w * 8 + e) * 64 + l]; \
        pdl = P.DL[it_]; } while (0)
#define DN_STORE(buf_) do { LP(unsigned char) sb_ = lds + (buf_) * SB_SIZE; \
        _Pragma("unroll") for (int e = 0; e < 2; ++e) { const int p_ = tid + 512 * e; \
            *(LP(u32x4))(sb_ + SB_W + ((p_ >> 4) * W_LD + (p_ & 15) * 8) * 2) = pw[e]; *(LP(u32x4))(sb_ + SB_Q + ((p_ >> 4) * W_LD + (p_ & 15) * 8) * 2) = pq[e]; \
            *(LP(u32x4))(sb_ + SB_KD + ((p_ >> 3) * A_LD + (p_ & 7) * 8) * 2) = pkd[e]; } \
        *(LP(u32x4))(sb_ + SB_A + ((tid >> 3) * A_LD + (tid & 7) * 8) * 2) = pa; } while (0)
    wg_sync();
    DN_LOAD(0); DN_STORE(0);
#pragma unroll
    for (int e = 0; e < 8; ++e) ucur[e] = pu[e];
    zcur[0] = pz[0]; zcur[1] = pz[1]; dlcur = pdl;
    wg_sync();
    DN_LOAD(1);
    for (int n = 0; n < NCH; ++n) {
        const size_t row0 = (size_t)(b * SEQ + n * CH);
        LP(unsigned char) sb = lds + (n & 1) * SB_SIZE;
        LP(bf16) Wl = (LP(bf16))(sb + SB_W); LP(bf16) Ql = (LP(bf16))(sb + SB_Q); LP(bf16) Al = (LP(bf16))(sb + SB_A); LP(bf16) KDl = (LP(bf16))(sb + SB_KD);
        const float dl = dlcur;
        bf16x8 Bs[4];
#pragma unroll
        for (int ks = 0; ks < 4; ++ks) Bs[ks] = pack8(S[2 * ks], S[2 * ks + 1]);
        bf16x8 fa[8], fb[8];
#define FR128(dst, base, ld, t0) do { _Pragma("unroll") for (int ii = 0; ii < 2; ++ii) _Pragma("unroll") for (int ks = 0; ks < 4; ++ks) \
            dst[4 * ii + ks] = *(LP(bf16x8))((base) + (16 * ((t0) + ii) + fr) * (ld) + 32 * ks + 8 * fq); } while (0)
#define FR64(dst, base, ld, t0) do { _Pragma("unroll") for (int ii = 0; ii < 4; ++ii) _Pragma("unroll") for (int s2 = 0; s2 < 2; ++s2) \
            dst[2 * ii + s2] = *(LP(bf16x8))((base) + (16 * ((t0) + ii) + fr) * (ld) + 32 * s2 + 8 * fq); } while (0)
        FR128(fa, Wl, W_LD, 0); FR128(fb, Wl, W_LD, 2);
        f32x4 vn[4], o[4];
#pragma unroll
        for (int ii = 0; ii < 2; ++ii) { f32x4 acc = {0.f, 0.f, 0.f, 0.f};
#pragma unroll
            for (int ks = 0; ks < 4; ++ks) acc = mfma16(fa[4 * ii + ks], Bs[ks], acc);
            vn[ii] = acc; }
        FR128(fa, Ql, W_LD, 0);
#pragma unroll
        for (int ii = 0; ii < 2; ++ii) { f32x4 acc = {0.f, 0.f, 0.f, 0.f};
#pragma unroll
            for (int ks = 0; ks < 4; ++ks) acc = mfma16(fb[4 * ii + ks], Bs[ks], acc);
            vn[2 + ii] = acc; }
        FR128(fb, Ql, W_LD, 2);
#pragma unroll
        for (int i = 0; i < 4; ++i) { vn[i][0] = bf_lo(ucur[2 * i]) - vn[i][0]; vn[i][1] = bf_hi(ucur[2 * i]) - vn[i][1]; vn[i][2] = bf_lo(ucur[2 * i + 1]) - vn[i][2]; vn[i][3] = bf_hi(ucur[2 * i + 1]) - vn[i][3]; }
        bf16x8 Bv[2];
        Bv[0] = pack8(vn[0], vn[1]); Bv[1] = pack8(vn[2], vn[3]);
#pragma unroll
        for (int ii = 0; ii < 2; ++ii) { f32x4 acc = {0.f, 0.f, 0.f, 0.f};
#pragma unroll
            for (int ks = 0; ks < 4; ++ks) acc = mfma16(fa[4 * ii + ks], Bs[ks], acc);
            o[ii] = acc; }
        FR64(fa, Al, A_LD, 0);
#pragma unroll
        for (int ii = 0; ii < 2; ++ii) { f32x4 acc = {0.f, 0.f, 0.f, 0.f};
#pragma unroll
            for (int ks = 0; ks < 4; ++ks) acc = mfma16(fb[4 * ii + ks], Bs[ks], acc);
            o[2 + ii] = acc; }
        FR64(fb, KDl, A_LD, 0);
#pragma unroll
        for (int i = 0; i < 4; ++i)
#pragma unroll
            for (int s2 = 0; s2 < 2; ++s2) if (s2 == 0 || i >= 2) o[i] = mfma16(fa[2 * i + s2], Bv[s2], o[i]);
        FR64(fa, KDl, A_LD, 4);
#pragma unroll
        for (int m = 0; m < 4; ++m) { f32x4 acc = S[m] * dl;
#pragma unroll
            for (int s2 = 0; s2 < 2; ++s2) acc = mfma16(fb[2 * m + s2], Bv[s2], acc);
            S[m] = acc; }
#pragma unroll
        for (int m = 0; m < 4; ++m) { f32x4 acc = S[4 + m] * dl;
#pragma unroll
            for (int s2 = 0; s2 < 2; ++s2) acc = mfma16(fa[2 * m + s2], Bv[s2], acc);
            S[4 + m] = acc; }
#undef FR128
#undef FR64
#ifdef PROBE_XBAR
        wg_sync_lds();
#endif
#pragma unroll
        for (int i = 0; i < 4; ++i)
#pragma unroll
            for (int r = 0; r < 4; ++r) { const float s = row_sum16(o[i][r] * o[i][r]); if (fr == 0) PL[w * 64 + 16 * i + 4 * fq + r] = s; }
        wg_sync_lds();
        {
            const int tok = 8 * w + (l >> 3);
            const float s = row_sum8(PL[(l & 7) * 64 + tok]);
            if ((l & 7) == 0) RL[tok] = 1.0f / sqrtf(s * (1.0f / 128.0f) + RMS_EPS);
        }
        if (n + 1 < NCH) DN_STORE((n + 1) & 1);
        wg_sync_lds();
#pragma unroll
        for (int i = 0; i < 4; ++i)
#pragma unroll
            for (int r = 0; r < 4; ++r) { const int tok = 16 * i + 4 * fq + r; OL[tok * W_LD + 16 * w + fr] = (bf16)f2bf(o[i][r] * RL[tok] * dnn); }
        wg_sync_lds();
#pragma unroll
        for (int e = 0; e < 2; ++e) {
            const int p = tid + 512 * e, row = p >> 4, c8 = (p & 15) * 8;
            const u32x4 ov = *(LP(u32x4))(OL + row * W_LD + c8);
            const u32x4 zv = zcur[e];
            u32x4 r;
            r.x = pk2(bf_lo(ov.x) * bf_lo(zv.x), bf_hi(ov.x) * bf_hi(zv.x)); r.y = pk2(bf_lo(ov.y) * bf_lo(zv.y), bf_hi(ov.y) * bf_hi(zv.y));
            r.z = pk2(bf_lo(ov.z) * bf_lo(zv.z), bf_hi(ov.z) * bf_hi(zv.z)); r.w = pk2(bf_lo(ov.w) * bf_lo(zv.w), bf_hi(ov.w) * bf_hi(zv.w));
            *(u32x4*)(P.OCAT + (row0 + row) * 2048 + h * 128 + c8) = r;
        }
#pragma unroll
        for (int e = 0; e < 8; ++e) ucur[e] = pu[e];
        zcur[0] = pz[0]; zcur[1] = pz[1]; dlcur = pdl;
        if (n + 2 < NCH) DN_LOAD(n + 2);
    }
#undef DN_LOAD
#undef DN_STORE
#pragma unroll
    for (int m = 0; m < 8; ++m)
#pragma unroll
        for (int r = 0; r < 4; ++r) P.DSP[((size_t)(b * H + h) * 128 + 16 * m + 4 * fq + r) * 128 + 16 * w + fr] = S[m][r];
}

constexpr int L_CV = 0, L_QS = L_CV + 8 * 384 * 4, L_KS = L_QS + 8 * 128 * 4, L_VS = L_KS + 8 * 128 * 4, L_BG = L_VS + 8 * 128 * 4, L_RED = L_BG + 256, L_OS = L_RED + 2 * 4 * 128 * 4, L_SAMP_END = L_OS + 8 * 128 * 4;
DI void sample_item(LP(unsigned char) lds, const DnPtrs& P, int b, int h) {
    const int tid = t_id(), w = wave_id(), l = tid & 63, dv = tid & 127, dkb = tid >> 7;
    LP(float) CV = (LP(float))(lds + L_CV); LP(float) QS = (LP(float))(lds + L_QS); LP(float) KS = (LP(float))(lds + L_KS); LP(float) VS = (LP(float))(lds + L_VS);
    LP(float) BG = (LP(float))(lds + L_BG); LP(float) RED = (LP(float))(lds + L_RED); LP(float) OS = (LP(float))(lds + L_OS);
    const size_t sbase = ((size_t)(b * H + h) * 128 + 32 * dkb) * 128 + dv;
    const int rowb = MP + 8 * b;
    wg_sync();
    float S[32];
#pragma unroll
    for (int i = 0; i < 32; ++i) S[i] = P.state_delta[sbase + (size_t)i * 128];
    if (tid < 384) {
        const int col = (tid >> 7) * 1024 + h * 128 + (tid & 127);
        float x[11], cw[4];
#pragma unroll
        for (int i = 0; i < 4; ++i) cw[i] = P.conv_w[i * QKVW + col];
#pragma unroll
        for (int i = 0; i < 3; ++i) x[i] = P.state_conv[((size_t)b * 3 + i) * QKVW + col];
#pragma unroll
        for (int t = 0; t < 8; ++t) x[3 + t] = bf2f(P.QKV[(size_t)(rowb + t) * QKVW + col]);
#pragma unroll
        for (int t = 0; t < 8; ++t) CV[t * 384 + tid] = silu_f(x[t] * cw[0] + x[t + 1] * cw[1] + x[t + 2] * cw[2] + x[t + 3] * cw[3]);
    }
    wg_sync();
    {
        const int t = w;
        const float q0 = CV[t * 384 + 2 * l], q1 = CV[t * 384 + 2 * l + 1], k0 = CV[t * 384 + 128 + 2 * l], k1 = CV[t * 384 + 128 + 2 * l + 1];
        const float rq = 1.0f / sqrtf(wave_sum(q0 * q0 + q1 * q1) + L2_EPS) * QSCALE_DN, rk = 1.0f / sqrtf(wave_sum(k0 * k0 + k1 * k1) + L2_EPS);
        QS[t * 128 + 2 * l] = q0 * rq; QS[t * 128 + 2 * l + 1] = q1 * rq; KS[t * 128 + 2 * l] = k0 * rk; KS[t * 128 + 2 * l + 1] = k1 * rk;
        VS[t * 128 + 2 * l] = CV[t * 384 + 256 + 2 * l]; VS[t * 128 + 2 * l + 1] = CV[t * 384 + 256 + 2 * l + 1];
        if (l == 0) { const float* ba = P.BA + (size_t)(rowb + t) * 16; BG[2 * t] = 1.0f / (1.0f + expf(-ba[h])); BG[2 * t + 1] = expf(-expf(P.a_log[h]) * softplus_f(ba[8 + h] + P.dt_bias[h])); }
    }
    wg_sync();
    for (int t = 0; t < 8; ++t) {
        const float beta = BG[2 * t], eg = BG[2 * t + 1];
        float p = 0.f;
#pragma unroll
        for (int i = 0; i < 32; ++i) p += KS[t * 128 + 32 * dkb + i] * S[i];
        RED[dkb * 128 + dv] = p;
        wg_sync();
        const float kS = (RED[dv] + RED[128 + dv]) + (RED[256 + dv] + RED[384 + dv]);
        const float d = beta * (VS[t * 128 + dv] - eg * kS);
        float po = 0.f;
#pragma unroll
        for (int i = 0; i < 32; ++i) { S[i] = eg * S[i] + KS[t * 128 + 32 * dkb + i] * d; po += QS[t * 128 + 32 * dkb + i] * S[i]; }
        RED[512 + dkb * 128 + dv] = po;
        wg_sync();
        if (dkb == 0) OS[t * 128 + dv] = (RED[512 + dv] + RED[640 + dv]) + (RED[768 + dv] + RED[896 + dv]);
    }
    wg_sync();
    {
        const int t = w, row = rowb + t;
        const float o0 = OS[t * 128 + 2 * l], o1 = OS[t * 128 + 2 * l + 1];
        const float rs = 1.0f / sqrtf(wave_sum(o0 * o0 + o1 * o1) * (1.0f / 128.0f) + RMS_EPS);
        const unsigned zz = *(const unsigned*)(P.Z + (size_t)row * D + h * 128 + 2 * l);
        *(unsigned*)(P.OCAT + (size_t)row * 2048 + h * 128 + 2 * l) = pk2(o0 * rs * P.dn_norm[2 * l] * bf_lo(zz), o1 * rs * P.dn_norm[2 * l + 1] * bf_hi(zz));
    }
#pragma unroll
    for (int i = 0; i < 32; ++i) P.DSS[sbase + (size_t)i * 128] = S[i];
}

constexpr int SB_WAVE = 8 * 256 * 4 + 8 * 64 * 4 + 64, L_SB_SS = 8 * SB_WAVE, L_SB_END = L_SB_SS + 4 * 2 * 8 * 4;
static_assert(L_SB_END <= P2_LDS, "sample batch LDS");
DI void sample_batch(LP(unsigned char) lds, const DnPtrs& P, int q4) {
    const int tid = t_id(), w = wave_id(), l = tid & 63, c = l & 15, q = l >> 4;
    const int b = q4 >> 1, h = 4 * (q4 & 1) + (w >> 1), half = w & 1, rowb = MP + 8 * b;
    LP(float) KQ = (LP(float))(lds + w * SB_WAVE);
    LP(float) VV = KQ + 8 * 256;
    LP(float) BG = VV + 8 * 64;
    LP(float) SSQ = (LP(float))(lds + L_SB_SS);
    wg_sync();
    const size_t sbase = ((size_t)(b * H + h) * 128 + q) * 128 + 64 * half + 4 * c;
    {
        float xq[11][2], xk[11][2], xv[11];
        const int cq = h * 128 + 2 * l, cv = 2048 + h * 128 + 64 * half + l;
#pragma unroll
        for (int i = 0; i < 3; ++i) { const float* sc = P.state_conv + ((size_t)b * 3 + i) * QKVW; xq[i][0] = sc[cq]; xq[i][1] = sc[cq + 1]; xk[i][0] = sc[1024 + cq]; xk[i][1] = sc[1024 + cq + 1]; xv[i] = sc[cv]; }
#pragma unroll
        for (int t = 0; t < 8; ++t) { const bf16* r = P.QKV + (size_t)(rowb + t) * QKVW; const unsigned uq = *(const unsigned*)(r + cq), uk = *(const unsigned*)(r + 1024 + cq);
            xq[3 + t][0] = bf_lo(uq); xq[3 + t][1] = bf_hi(uq); xk[3 + t][0] = bf_lo(uk); xk[3 + t][1] = bf_hi(uk); xv[3 + t] = bf2f(r[cv]); }
        float wq[4][2], wk[4][2], wv[4];
#pragma unroll
        for (int i = 0; i < 4; ++i) { wq[i][0] = P.conv_w[i * QKVW + cq]; wq[i][1] = P.conv_w[i * QKVW + cq + 1]; wk[i][0] = P.conv_w[i * QKVW + 1024 + cq]; wk[i][1] = P.conv_w[i * QKVW + 1024 + cq + 1]; wv[i] = P.conv_w[i * QKVW + cv]; }
#pragma unroll
        for (int t = 0; t < 8; ++t) {
            float qq[2], kk[2];
#pragma unroll
            for (int e = 0; e < 2; ++e) { qq[e] = silu_f(xq[t][e] * wq[0][e] + xq[t + 1][e] * wq[1][e] + xq[t + 2][e] * wq[2][e] + xq[t + 3][e] * wq[3][e]);
                                          kk[e] = silu_f(xk[t][e] * wk[0][e] + xk[t + 1][e] * wk[1][e] + xk[t + 2][e] * wk[2][e] + xk[t + 3][e] * wk[3][e]); }
            const float vv = silu_f(xv[t] * wv[0] + xv[t + 1] * wv[1] + xv[t + 2] * wv[2] + xv[t + 3] * wv[3]);
            const float rq = frsq(wave_sum(qq[0] * qq[0] + qq[1] * qq[1]) + L2_EPS) * QSCALE_DN, rk = frsq(wave_sum(kk[0] * kk[0] + kk[1] * kk[1]) + L2_EPS);
#pragma unroll
            for (int e = 0; e < 2; ++e) { const int dk = 2 * l + e, pos = (dk & 3) * 32 + (dk >> 2); KQ[t * 256 + pos] = kk[e] * rk; KQ[t * 256 + 128 + pos] = qq[e] * rq; }
            VV[t * 64 + l] = vv;
            if (l == 0) { const float* ba = P.BA + (size_t)(rowb + t) * 16; BG[2 * t] = 1.0f / (1.0f + expf(-ba[h])); BG[2 * t + 1] = expf(-expf(P.a_log[h]) * softplus_f(ba[8 + h] + P.dt_bias[h])); }
        }
    }
    wave_sync();
    f32x4 S[32];
#pragma unroll
    for (int i = 0; i < 32; ++i) S[i] = *(const f32x4*)(P.state_delta + sbase + (size_t)(4 * i) * 128);
    LP(float) OSW = VV;
#pragma unroll 1
    for (int t = 0; t < 8; ++t) {
        const float beta = BG[2 * t], eg = BG[2 * t + 1];
        f32x4 kS = {0.f, 0.f, 0.f, 0.f};
#pragma unroll
        for (int j = 0; j < 8; ++j) { const f32x4 kv = *(LP(f32x4))(KQ + t * 256 + q * 32 + 4 * j);
#pragma unroll
            for (int e = 0; e < 4; ++e) kS += S[4 * j + e] * kv[e]; }
#pragma unroll
        for (int e = 0; e < 4; ++e) { kS[e] += shfl_xor_f(kS[e], 16); kS[e] += shfl_xor_f(kS[e], 32); }
        const f32x4 vv = *(LP(f32x4))(VV + t * 64 + 4 * c);
        const f32x4 dd = (vv - kS * eg) * beta;
        f32x4 o = {0.f, 0.f, 0.f, 0.f};
#pragma unroll
        for (int j = 0; j < 8; ++j) { const f32x4 kv = *(LP(f32x4))(KQ + t * 256 + q * 32 + 4 * j), qv = *(LP(f32x4))(KQ + t * 256 + 128 + q * 32 + 4 * j);
#pragma unroll
            for (int e = 0; e < 4; ++e) { S[4 * j + e] = S[4 * j + e] * eg + dd * kv[e]; o += S[4 * j + e] * qv[e]; } }
#pragma unroll
        for (int e = 0; e < 4; ++e) { o[e] += shfl_xor_f(o[e], 16); o[e] += shfl_xor_f(o[e], 32); }
        const float ss = row_sum16((o[0] * o[0] + o[1] * o[1]) + (o[2] * o[2] + o[3] * o[3]));
        if (l == 0) SSQ[((w >> 1) * 2 + half) * 8 + t] = ss;
        wave_sync();
        if (q == 0) *(LP(f32x4))(OSW + t * 64 + 4 * c) = o;
    }
#pragma unroll
    for (int i = 0; i < 32; ++i) *(f32x4*)(P.DSS + sbase + (size_t)(4 * i) * 128) = S[i];
    wg_sync();
    if (q == 0) {
        const f32x4 dn4 = *(const f32x4*)(P.dn_norm + 64 * half + 4 * c);
#pragma unroll
        for (int t = 0; t < 8; ++t) {
            const float rs = 1.0f / sqrtf((SSQ[((w >> 1) * 2) * 8 + t] + SSQ[((w >> 1) * 2 + 1) * 8 + t]) * (1.0f / 128.0f) + RMS_EPS);
            const size_t row = (size_t)(rowb + t);
            const u32x2 zz = *(const u32x2*)(P.Z + row * D + h * 128 + 64 * half + 4 * c);
            const f32x4 ot = *(LP(f32x4))(OSW + t * 64 + 4 * c);
            u32x2 ov; ov.x = pk2(ot[0] * rs * dn4[0] * bf_lo(zz.x), ot[1] * rs * dn4[1] * bf_hi(zz.x)); ov.y = pk2(ot[2] * rs * dn4[2] * bf_lo(zz.y), ot[3] * rs * dn4[3] * bf_hi(zz.y));
            *(u32x2*)(P.OCAT + row * 2048 + h * 128 + 64 * half + 4 * c) = ov;
        }
    }
}
}
struct SgPtrs { const bf16* UV; const bf16* SGWT; const float* sgu_w; const float* sgu_b; const float* sgu_norm; bf16* OCAT; float* SGV; };
namespace sg {
using namespace cfg;
constexpr int VT_LD = 136, L_VT = 0, L_R = 4 * 128 * VT_LD * 2, L_SG_END = L_R + 512;
static_assert(L_SG_END <= P2_LDS, "sgu LDS");
DI void sgu_item(LP(unsigned char) lds, const SgPtrs& P, int b, int c) {
    const int tid = t_id(), w = wave_id(), l = tid & 63, fr = l & 15, fq = l >> 4;
    const size_t row0 = (size_t)b * SEQ + 128 * c;
    LP(bf16) VT = (LP(bf16))(lds + L_VT);
    wg_sync();
    u32x2 uu[4][8];
    {
        u32x4 v[16];
#pragma unroll
        for (int j = 0; j < 16; ++j) v[j] = *(const u32x4*)(P.UV + (row0 + 16 * w + j) * D + 512 + 8 * l);
#pragma unroll
        for (int g = 0; g < 4; ++g)
#pragma unroll
            for (int m = 0; m < 8; ++m) uu[g][m] = *(const u32x2*)(P.UV + (row0 + 16 * w + fr) * D + g * 128 + 16 * m + 4 * fq);
        float gn[8];
        { const f32x4 g0 = *(const f32x4*)(P.sgu_norm + 8 * l), g1 = *(const f32x4*)(P.sgu_norm + 8 * l + 4); gn[0] = g0[0]; gn[1] = g0[1]; gn[2] = g0[2]; gn[3] = g0[3]; gn[4] = g1[0]; gn[5] = g1[1]; gn[6] = g1[2]; gn[7] = g1[3]; }
        LP(bf16) vt = VT + (size_t)(l >> 4) * 128 * VT_LD;
        const int cc0 = 8 * (l & 15), swz = (l & 15);
#pragma unroll
        for (int jp = 0; jp < 8; ++jp) {
            float x0[8], x1[8];
            { const u32x4 a = v[2 * jp], bq = v[2 * jp + 1];
              x0[0] = bf_lo(a.x); x0[1] = bf_hi(a.x); x0[2] = bf_lo(a.y); x0[3] = bf_hi(a.y); x0[4] = bf_lo(a.z); x0[5] = bf_hi(a.z); x0[6] = bf_lo(a.w); x0[7] = bf_hi(a.w);
              x1[0] = bf_lo(bq.x); x1[1] = bf_hi(bq.x); x1[2] = bf_lo(bq.y); x1[3] = bf_hi(bq.y); x1[4] = bf_lo(bq.z); x1[5] = bf_hi(bq.z); x1[6] = bf_lo(bq.w); x1[7] = bf_hi(bq.w); }
            float s0 = 0.f, s1 = 0.f;
#pragma unroll
            for (int e = 0; e < 8; ++e) { s0 += x0[e] * x0[e]; s1 += x1[e] * x1[e]; }
            const float r0 = 1.0f / sqrtf(wave_sum(s0) * (1.0f / 512.0f) + RMS_EPS), r1 = 1.0f / sqrtf(wave_sum(s1) * (1.0f / 512.0f) + RMS_EPS);
            const int s = 16 * w + 2 * jp;
            const int pos = (((s >> 3) ^ swz) << 3) + (s & 7);
#pragma unroll
            for (int e = 0; e < 8; ++e) *(LP(unsigned))(vt + (cc0 + e) * VT_LD + pos) = pk2(x0[e] * r0 * gn[e], x1[e] * r1 * gn[e]);
        }
    }
    wg_sync();
    {
        const int t = 16 * w + fr, kmax = (16 * w + 15) >> 5;
#pragma unroll
        for (int g = 0; g < 4; ++g) {
            LP(bf16) vt = VT + (size_t)g * 128 * VT_LD;
            f32x4 acc[8];
#pragma unroll
            for (int m = 0; m < 8; ++m) acc[m] = (f32x4){0.f, 0.f, 0.f, 0.f};
            bf16x8 wf[4];
#pragma unroll
            for (int ks = 0; ks < 4; ++ks) wf[ks] = *(const bf16x8*)(P.SGWT + ((size_t)g * 128 + t) * 128 + 32 * ks + 8 * fq);
            const float bias = P.sgu_b[g * 128 + t];
#pragma unroll
            for (int ks = 0; ks < 4; ++ks) if (ks <= kmax) {
#pragma unroll
                for (int m = 0; m < 8; ++m) acc[m] = mfma16(*(LP(bf16x8))(vt + (16 * m + fr) * VT_LD + (((4 * ks + fq) ^ (2 * m + (fr >> 3))) << 3)), wf[ks], acc[m]);
            }
#pragma unroll
            for (int m = 0; m < 8; ++m) {
                u32x2 o; o.x = pk2(bf_lo(uu[g][m].x) * (acc[m][0] + bias), bf_hi(uu[g][m].x) * (acc[m][1] + bias)); o.y = pk2(bf_lo(uu[g][m].y) * (acc[m][2] + bias), bf_hi(uu[g][m].y) * (acc[m][3] + bias));
                *(u32x2*)(P.OCAT + (row0 + t) * 2048 + 1024 + g * 128 + 16 * m + 4 * fq) = o;
            }
        }
    }
}
DI void sgu_sample_item(LP(unsigned char) lds, const SgPtrs& P, int b) {
    const int tid = t_id(), w = wave_id(), l = tid & 63, g = tid >> 7;
    LP(float) RED = (LP(float))(lds);
    const size_t rowb = (size_t)MP + 8 * b;
    float v[8], u[8];
    wg_sync();
#pragma unroll
    for (int t = 0; t < 8; ++t) { v[t] = bf2f(P.UV[(rowb + t) * D + 512 + tid]); u[t] = bf2f(P.UV[(rowb + t) * D + tid]); const float s = wave_sum(v[t] * v[t]); if (l == 0) RED[t * 8 + w] = s; }
    wg_sync();
    const float gain = P.sgu_norm[tid];
#pragma unroll
    for (int t = 0; t < 8; ++t) {
        float s = 0.f;
#pragma unroll
        for (int j = 0; j < 8; ++j) s += RED[t * 8 + j];
        v[t] = v[t] * (1.0f / sqrtf(s * (1.0f / 512.0f) + RMS_EPS)) * gain;
        P.SGV[((size_t)b * 8 + t) * 512 + tid] = v[t];
    }
#pragma unroll
    for (int t = 0; t < 8; ++t) {
        float mx = P.sgu_b[g * 128 + t];
#pragma unroll
        for (int s = 0; s <= t; ++s) mx += P.sgu_w[((size_t)g * 128 + t) * 128 + s] * v[s];
        P.OCAT[(rowb + t) * 2048 + 1024 + tid] = (bf16)f2bf(u[t] * mx);
    }
}
}

namespace at {
using namespace cfg;
constexpr int K_LD = 136, V_LD = 264, L_K = 0, L_V = 256 * K_LD * 2, L_AT_END = L_V + 128 * V_LD * 2, OS_LD = 72;
static_assert(L_AT_END <= P2_LDS && 8 * 32 * OS_LD * 2 <= L_V, "attention LDS");
DI int crow(int i, int h) { return (i & 3) + 8 * (i >> 2) + 4 * h; }
DI void attn_item(LP(unsigned char) lds, const bf16* Q, int nq, const float* K, const float* V, bf16* O) {
    const int tid = t_id(), w = wave_id(), l = tid & 63, r32 = l & 31, hh = l >> 5;
    LP(bf16) KL = (LP(bf16))(lds + L_K); LP(bf16) VT = (LP(bf16))(lds + L_V);
    wg_sync();
    const int q0 = 32 * w;
    const bool active = q0 < nq;
    bf16x8 Bq[8];
    {
        f32x4 kv[16], v0[8], v1[8];
#pragma unroll
        for (int e = 0; e < 16; ++e) { const int p = tid + 512 * e; kv[e] = *(const f32x4*)(K + (size_t)(p >> 5) * 512 + (p & 31) * 4); }
#pragma unroll
        for (int e = 0; e < 8; ++e) { const int u = tid + 512 * e, d4 = (u & 31) * 4, key = 2 * (u >> 5); v0[e] = *(const f32x4*)(V + (size_t)key * 512 + d4); v1[e] = *(const f32x4*)(V + (size_t)(key + 1) * 512 + d4); }
        {
            const bool qok = active && (q0 + r32) < nq;
#pragma unroll
            for (int ks = 0; ks < 8; ++ks) { Bq[ks] = (bf16x8){0, 0, 0, 0, 0, 0, 0, 0}; if (qok) Bq[ks] = *(const bf16x8*)(Q + (size_t)(q0 + r32) * 512 + 16 * ks + 8 * hh); }
        }
#ifndef HOST_EMU
        __builtin_amdgcn_sched_barrier(0);
#endif
#pragma unroll
        for (int e = 0; e < 16; ++e) { const int p = tid + 512 * e; u32x2 pk; pk.x = pk2(kv[e][0], kv[e][1]); pk.y = pk2(kv[e][2], kv[e][3]); *(LP(u32x2))(KL + (p >> 5) * K_LD + (p & 31) * 4) = pk; }
#pragma unroll
        for (int e = 0; e < 8; ++e) {
            const int u = tid + 512 * e, d4 = (u & 31) * 4, kp = perm16k(2 * (u >> 5));
            const int pos = (((kp >> 3) ^ (u & 31)) << 3) + (kp & 7);
#pragma unroll
            for (int i = 0; i < 4; ++i) *(LP(unsigned))(VT + (d4 + i) * V_LD + pos) = pk2(v0[e][i], v1[e][i]);
        }
    }
    wg_sync();
    bf16x8 Pf[8][2];
    float inv = 0.f;
    if (active) {
        f32x16 acc[8];
#pragma unroll
        for (int kt = 0; kt < 8; ++kt) {
#pragma unroll
            for (int i = 0; i < 16; ++i) acc[kt][i] = 0.f;
#pragma unroll
            for (int ks = 0; ks < 8; ++ks) acc[kt] = mfma32(*(LP(bf16x8))(KL + (32 * kt + r32) * K_LD + 16 * ks + 8 * hh), Bq[ks], acc[kt]);
#ifndef HOST_EMU
            asm volatile("" ::: "memory");
#endif
        }
        float mx = -3.0e38f;
#pragma unroll
        for (int kt = 0; kt < 8; ++kt)
#pragma unroll
            for (int i = 0; i < 16; ++i) mx = fmaxf(mx, acc[kt][i]);
        mx = fmaxf(mx, shfl_xor_f(mx, 32));
        float sum = 0.f;
#pragma unroll
        for (int kt = 0; kt < 8; ++kt) {
#pragma unroll
            for (int i = 0; i < 16; ++i) { const float p = fexp2(acc[kt][i] - mx); acc[kt][i] = p; sum += p; }
#pragma unroll
            for (int s = 0; s < 2; ++s) {
                u32x4 pa; pa.x = pk2(acc[kt][8 * s], acc[kt][8 * s + 1]); pa.y = pk2(acc[kt][8 * s + 2], acc[kt][8 * s + 3]); pa.z = pk2(acc[kt][8 * s + 4], acc[kt][8 * s + 5]); pa.w = pk2(acc[kt][8 * s + 6], acc[kt][8 * s + 7]);
                Pf[kt][s] = __builtin_bit_cast(bf16x8, pa);
            }
        }
        sum += shfl_xor_f(sum, 32);
        inv = 1.0f / sum;
    }
    wg_sync();
    if (active) {
        LP(bf16) OS = (LP(bf16))(lds + L_K) + (size_t)w * 32 * OS_LD;
        float invq[16];
#pragma unroll
        for (int i = 0; i < 16; ++i) invq[i] = shfl_f(inv, crow(i, hh));
#pragma unroll
        for (int dh = 0; dh < 2; ++dh) {
            f32x16 o[2];
#pragma unroll
            for (int dt = 0; dt < 2; ++dt)
#pragma unroll
                for (int i = 0; i < 16; ++i) o[dt][i] = 0.f;
#pragma unroll
            for (int kt = 0; kt < 8; ++kt) {
#pragma unroll
                for (int s = 0; s < 2; ++s) {
#pragma unroll
                    for (int dt = 0; dt < 2; ++dt) { const int d = 64 * dh + 32 * dt + r32;
                        o[dt] = mfma32(Pf[kt][s], *(LP(bf16x8))(VT + d * V_LD + (((4 * kt + 2 * s + hh) ^ ((d >> 2) & 31)) << 3)), o[dt]); }
                }
#ifndef HOST_EMU
                asm volatile("" ::: "memory");
#endif
            }
#pragma unroll
            for (int i = 0; i < 16; ++i)
#pragma unroll
                for (int dt = 0; dt < 2; ++dt) OS[crow(i, hh) * OS_LD + 32 * dt + r32] = (bf16)f2bf(o[dt][i] * invq[i]);
            wave_sync();
#pragma unroll
            for (int j = 0; j < 4; ++j) {
                const int ch = l + 64 * j, q = ch >> 3, c8 = (ch & 7) * 8;
                const u32x4 ov = *(LP(u32x4))(OS + q * OS_LD + c8);
                if (q0 + q < nq) *(u32x4*)(O + (size_t)(q0 + q) * 2048 + 64 * dh + c8) = ov;
            }
            wave_sync();
        }
    }
}
}
namespace mini {
using namespace cfg;
constexpr int ML_LD = 264, ML_STAGE = 2 * 64 * ML_LD * 2, L_MINI_RED = 2 * ML_STAGE;
static_assert(L_MINI_RED + 512 <= P2_LDS, "mini LDS");
DI void mm_tile(LP(unsigned char) lds, const bf16* A, int lda, const bf16* Bt, int ldb, int K, int row0, int col0, f32x4 (&acc)[2]) {
    const int tid = t_id(), w = wave_id(), l = tid & 63, fr = l & 15, fq = l >> 4;
    u32x4 ra[4], rb[4];
#define MM_FETCH(k0) do { _Pragma("unroll") for (int e = 0; e < 4; ++e) { const int c_ = tid + 512 * e; \
        ra[e] = *(const u32x4*)(A + (size_t)(row0 + (c_ >> 5)) * lda + (k0) + 8 * (c_ & 31)); rb[e] = *(const u32x4*)(Bt + (size_t)(col0 + (c_ >> 5)) * ldb + (k0) + 8 * (c_ & 31)); } } while (0)
#define MM_PUT(st) do { LP(bf16) as_ = (LP(bf16))(lds + (st) * ML_STAGE); LP(bf16) bs_ = as_ + 64 * ML_LD; _Pragma("unroll") for (int e = 0; e < 4; ++e) { const int c_ = tid + 512 * e; \
        *(LP(u32x4))(as_ + (c_ >> 5) * ML_LD + 8 * (c_ & 31)) = ra[e]; *(LP(u32x4))(bs_ + (c_ >> 5) * ML_LD + 8 * (c_ & 31)) = rb[e]; } } while (0)
    wg_sync();
    MM_FETCH(0); MM_PUT(0);
    wg_sync_lds();
    const int ns = K >> 8;
#pragma unroll 1
    for (int s = 0; s < ns; ++s) {
        if (s + 1 < ns) MM_FETCH((s + 1) << 8);
        LP(bf16) as = (LP(bf16))(lds + (s & 1) * ML_STAGE) + (16 * (w & 3) + fr) * ML_LD + 8 * fq;
        LP(bf16) bs = (LP(bf16))(lds + (s & 1) * ML_STAGE) + (64 + 32 * (w >> 2) + fr) * ML_LD + 8 * fq;
        bf16x8 fa[8], f0[8], f1[8];
#pragma unroll
        for (int j = 0; j < 8; ++j) { fa[j] = *(LP(bf16x8))(as + 32 * j); f0[j] = *(LP(bf16x8))(bs + 32 * j); f1[j] = *(LP(bf16x8))(bs + 16 * ML_LD + 32 * j); }
#pragma unroll
        for (int j = 0; j < 8; ++j) { acc[0] = mfma16(f0[j], fa[j], acc[0]); acc[1] = mfma16(f1[j], fa[j], acc[1]); }
        if (s + 1 < ns) MM_PUT((s + 1) & 1);
        wg_sync_lds();
    }
#undef MM_FETCH
#undef MM_PUT
}
DI int tile_of(int i) { return i; }
struct MiniPtrs { const bf16* OCAT; const bf16* WBR; const bf16* GATES; bf16* MERGED; const bf16* WO; const float* xs; float* Y; bf16* X1B; float* SS1; const bf16* HB; const bf16* WDN; float* SS2; };
DI void br_tile(LP(unsigned char) lds, const MiniPtrs& P, int t) {
    const int tid = t_id(), w = wave_id(), l = tid & 63, fr = l & 15, fq = l >> 4;
    const int row0 = MP + 64 * (t >> 4), col0 = 64 * (t & 15), row = row0 + 16 * (w & 3) + fr;
    const int koff[3] = {0, 1024, 1536}, klen[3] = {1024, 512, 512};
    f32x4 m[2] = {{0.f, 0.f, 0.f, 0.f}, {0.f, 0.f, 0.f, 0.f}};
#pragma unroll
    for (int b = 0; b < 3; ++b) {
        f32x4 acc[2] = {{0.f, 0.f, 0.f, 0.f}, {0.f, 0.f, 0.f, 0.f}};
        mm_tile(lds, P.OCAT + koff[b], 2048, P.WBR + koff[b], 2048, klen[b], row0, col0, acc);
#pragma unroll
        for (int n = 0; n < 2; ++n) {
            const u32x2 g = *(const u32x2*)(P.GATES + (size_t)row * NGATE + b * D + col0 + 32 * (w >> 2) + 16 * n + 4 * fq);
            m[n][0] += bf_lo(g.x) * acc[n][0]; m[n][1] += bf_hi(g.x) * acc[n][1]; m[n][2] += bf_lo(g.y) * acc[n][2]; m[n][3] += bf_hi(g.y) * acc[n][3];
        }
    }
#pragma unroll
    for (int n = 0; n < 2; ++n) { u32x2 o; o.x = pk2(m[n][0], m[n][1]); o.y = pk2(m[n][2], m[n][3]); *(u32x2*)(P.MERGED + (size_t)row * D + col0 + 32 * (w >> 2) + 16 * n + 4 * fq) = o; }
}
DI void gate_tile(LP(unsigned char) lds, const bf16* XB, const bf16* WG, const float* rstd, bf16* GATES, int t) {
    const int tid = t_id(), w = wave_id(), l = tid & 63, fr = l & 15, fq = l >> 4;
    const int row0 = MP + 64 * (t / 48), col0 = 64 * (t % 48), row = row0 + 16 * (w & 3) + fr;
    f32x4 acc[2] = {{0.f, 0.f, 0.f, 0.f}, {0.f, 0.f, 0.f, 0.f}};
    const float rs = rstd[row];
    mm_tile(lds, XB, D, WG, D, D, row0, col0, acc);
#pragma unroll
    for (int n = 0; n < 2; ++n) { u32x2 o; o.x = pk2(sigmoid_f(acc[n][0] * rs), sigmoid_f(acc[n][1] * rs)); o.y = pk2(sigmoid_f(acc[n][2] * rs), sigmoid_f(acc[n][3] * rs));
        *(u32x2*)(GATES + (size_t)row * NGATE + col0 + 32 * (w >> 2) + 16 * n + 4 * fq) = o; }
}
DI void res_tile(LP(unsigned char) lds, const bf16* A, int lda, const bf16* Bt, int ldb, int K, const float* xin, int xin_row0, const bf16* xin_b, float* Y, bf16* XB, float* SS, int t) {
    const int tid = t_id(), w = wave_id(), l = tid & 63, fr = l & 15, fq = l >> 4;
    const int row0 = MP + 64 * (t >> 4), col0 = 64 * (t & 15), row = row0 + 16 * (w & 3) + fr;
    LP(float) RED = (LP(float))(lds + L_MINI_RED);
    f32x4 acc[2] = {{0.f, 0.f, 0.f, 0.f}, {0.f, 0.f, 0.f, 0.f}};
    mm_tile(lds, A, lda, Bt, ldb, K, row0, col0, acc);
    float ss = 0.f;
#pragma unroll
    for (int n = 0; n < 2; ++n) {
        const int c = col0 + 32 * (w >> 2) + 16 * n + 4 * fq;
        f32x4 xi;
        if (xin_b) { const u32x2 xb = *(const u32x2*)(xin_b + (size_t)row * D + c); xi = (f32x4){bf_lo(xb.x), bf_hi(xb.x), bf_lo(xb.y), bf_hi(xb.y)}; }
        else xi = *(const f32x4*)(xin + (size_t)(row - xin_row0) * D + c);
        const f32x4 x = xi + acc[n];
        if (Y) *(f32x4*)(Y + (size_t)row * D + c) = x;
        if (XB) { u32x2 o; o.x = pk2(x[0], x[1]); o.y = pk2(x[2], x[3]); *(u32x2*)(XB + (size_t)row * D + c) = o; }
        ss += (x[0] * x[0] + x[1] * x[1]) + (x[2] * x[2] + x[3] * x[3]);
    }
    ss += shfl_xor_f(ss, 16); ss += shfl_xor_f(ss, 32);
    wg_sync();
    if (w >= 4 && fq == 0) RED[16 * (w & 3) + fr] = ss;
    wg_sync();
    if (w < 4 && fq == 0) SS[(size_t)row * 16 + (t & 15)] = ss + RED[16 * w + fr];
}
#ifndef HOST_EMU
DI void fin_tile(LP(unsigned char) lds, const bf16* A, int lda, const bf16* Bt, int ldb, int K, const bf16* xin_b, const float* gain, float* Y, float* SS, unsigned* cnt, unsigned* tmo, int t) {
    const int tid = t_id(), w = wave_id(), l = tid & 63, fr = l & 15, fq = l >> 4;
    const int row0 = MP + 64 * (t >> 4), col0 = 64 * (t & 15), row = row0 + 16 * (w & 3) + fr;
    LP(float) RED = (LP(float))(lds + L_MINI_RED);
    f32x4 acc[2] = {{0.f, 0.f, 0.f, 0.f}, {0.f, 0.f, 0.f, 0.f}};
    mm_tile(lds, A, lda, Bt, ldb, K, row0, col0, acc);
    float ss = 0.f;
#pragma unroll
    for (int n = 0; n < 2; ++n) {
        const int c = col0 + 32 * (w >> 2) + 16 * n + 4 * fq;
        const u32x2 xb = *(const u32x2*)(xin_b + (size_t)row * D + c);
        acc[n] = acc[n] + (f32x4){bf_lo(xb.x), bf_hi(xb.x), bf_lo(xb.y), bf_hi(xb.y)};
        ss += (acc[n][0] * acc[n][0] + acc[n][1] * acc[n][1]) + (acc[n][2] * acc[n][2] + acc[n][3] * acc[n][3]);
    }
    ss += shfl_xor_f(ss, 16); ss += shfl_xor_f(ss, 32);
    wg_sync();
    if (w >= 4 && fq == 0) RED[16 * (w & 3) + fr] = ss;
    wg_sync();
    if (w < 4) {
        if (fq == 0) __hip_atomic_store((unsigned*)(SS + (size_t)row * 16 + (t & 15)), __float_as_uint(ss + RED[16 * w + fr]), __ATOMIC_RELAXED, __HIP_MEMORY_SCOPE_AGENT);
        asm volatile("s_waitcnt vmcnt(0)" ::: "memory");
        if (l == 0) __hip_atomic_fetch_add(cnt + 64 * (t >> 4), 1u, __ATOMIC_RELAXED, __HIP_MEMORY_SCOPE_AGENT);
    }
    if (w == 0) {
        unsigned spins = 0;
        while ((unsigned)__builtin_amdgcn_readfirstlane(__hip_atomic_load(cnt + 64 * (t >> 4), __ATOMIC_RELAXED, __HIP_MEMORY_SCOPE_AGENT)) < 64u) {
            __builtin_amdgcn_s_sleep(2);
            if (++spins > (1u << 22)) { if (l == 0) __hip_atomic_store(tmo, 1u, __ATOMIC_RELAXED, __HIP_MEMORY_SCOPE_AGENT); break; }
        }
        __builtin_amdgcn_fence(__ATOMIC_ACQUIRE, "agent");
    }
    asm volatile("s_waitcnt vmcnt(0) lgkmcnt(0)" ::: "memory"); __builtin_amdgcn_s_barrier(); asm volatile("" ::: "memory");
    if (w < 4 && fq == 0) {
        const unsigned* sl = (const unsigned*)(SS + (size_t)row * 16);
        float s = 0.f;
#pragma unroll
        for (int j = 0; j < 16; ++j) s += __uint_as_float(__hip_atomic_load(sl + j, __ATOMIC_RELAXED, __HIP_MEMORY_SCOPE_AGENT));
        RED[64 + 16 * w + fr] = 1.0f / sqrtf(s * (1.0f / D) + RMS_EPS);
    }
    wg_sync();
    const float rs = RED[64 + 16 * (w & 3) + fr];
#pragma unroll
    for (int n = 0; n < 2; ++n) { const int c = col0 + 32 * (w >> 2) + 16 * n + 4 * fq; *(f32x4*)(Y + (size_t)row * D + c) = acc[n] * rs * *(const f32x4*)(gain + c); }
}
#endif
}
#ifndef HOST_EMU
namespace ep {
using namespace cfg;
using pg8::Unit; using pg8::HALF; using pg8::BM;
DI u32x4 pack8f(const f32x4& a, const f32x4& b) { u32x4 w; w.x = pg8::cvt_pk_bf16(a[0], a[1]); w.y = pg8::cvt_pk_bf16(a[2], a[3]); w.z = pg8::cvt_pk_bf16(b[0], b[1]); w.w = pg8::cvt_pk_bf16(b[2], b[3]); return w; }
DI void unpack8(const u32x4& w, f32x4& a, f32x4& b) { a[0] = bf_lo(w.x); a[1] = bf_hi(w.x); a[2] = bf_lo(w.y); a[3] = bf_hi(w.y); b[0] = bf_lo(w.z); b[1] = bf_hi(w.z); b[2] = bf_lo(w.w); b[3] = bf_hi(w.w); }

struct EpiG1 {
    static constexpr bool PERM = true, AFTER_DRAIN = false;
    bf16 *QKV, *Z, *UV, *QMEM, *HALO; float *CSP, *CSS; const float* rstd;
    DI void operator()(const f32x4 (&acc)[2][2][4][2], const Unit& u, int wr, int wc, int fr, int fq) const {
        const int row0 = u.pm * BM + wr * 64 + fr, pn = u.pn;
        bf16* base; int ld, colt, mode;
        if (pn < 12) { base = QKV; ld = QKVW; colt = pn * 256; mode = 0; }
        else if (pn < 16) { base = Z; ld = D; colt = (pn - 12) * 256; mode = 1; }
        else if (pn < 20) { base = UV; ld = D; colt = (pn - 16) * 256; mode = 2; }
        else { base = QMEM; ld = MEMW; colt = (pn - 20) * 256; mode = 3; }
        const int col0 = colt + wc * 32 + 8 * fq;
        float rsv[2][4];
#pragma unroll
        for (int ai = 0; ai < 2; ++ai)
#pragma unroll
            for (int m = 0; m < 4; ++m) rsv[ai][m] = rstd[row0 + ai * HALF + m * 16];
#pragma unroll
        for (int ai = 0; ai < 2; ++ai)
#pragma unroll
            for (int m = 0; m < 4; ++m) {
                const int r = row0 + ai * HALF + m * 16; const float rs = rsv[ai][m];
#pragma unroll
                for (int bj = 0; bj < 2; ++bj) {
                    f32x4 v0 = acc[ai][bj][m][0] * rs, v1 = acc[ai][bj][m][1] * rs;
                    if (mode == 1) {
#pragma unroll
                        for (int j = 0; j < 4; ++j) { v0[j] = silu_f(v0[j]); v1[j] = silu_f(v1[j]); } }
                    else if (mode == 2) {
#pragma unroll
                        for (int j = 0; j < 4; ++j) { v0[j] = gelu_tanh_f(v0[j]); v1[j] = gelu_tanh_f(v1[j]); } }
                    else if (mode == 3) { v0 = v0 * QSCALE_MEM; v1 = v1 * QSCALE_MEM; }
                    const u32x4 w = pack8f(v0, v1);
                    *(u32x4*)(base + (size_t)r * ld + col0 + bj * HALF) = w;
                    if (mode == 0) {
                        const int c = col0 + bj * HALF;
                        if (m == 3 && fr >= 13) {
                            *(u32x4*)(HALO + ((size_t)(r >> 6) * 3 + ((r & 63) - 61)) * QKVW + c) = w;
                            if (r < MP && (r & 2047) >= 2045) { float* d = CSP + ((size_t)(r >> 11) * 3 + ((r & 2047) - 2045)) * QKVW + c; *(f32x4*)d = v0; *(f32x4*)(d + 4) = v1; }
                        }
                        if (r >= MP && (r & 7) >= 5) { float* d = CSS + ((size_t)((r - MP) >> 3) * 3 + ((r & 7) - 5)) * QKVW + c; *(f32x4*)d = v0; *(f32x4*)(d + 4) = v1; }
                    }
                }
            }
    }
};
struct EpiKV {
    static constexpr bool PERM = false, AFTER_DRAIN = false;
    float *MK, *MV; const float* rstd;
    DI void operator()(const f32x4 (&acc)[2][2][4][2], const Unit& u, int wr, int wc, int fr, int fq) const {
        const int row0 = u.pm * BM + wr * 64 + fr, col0 = u.pn * BM + wc * 32 + 4 * fq;
        float rsv[2][4];
#pragma unroll
        for (int ai = 0; ai < 2; ++ai)
#pragma unroll
            for (int m = 0; m < 4; ++m) rsv[ai][m] = rstd[row0 + ai * HALF + m * 16];
#pragma unroll
        for (int ai = 0; ai < 2; ++ai)
#pragma unroll
            for (int m = 0; m < 4; ++m) {
                const int r = row0 + ai * HALF + m * 16; const float rs = rsv[ai][m];
#pragma unroll
                for (int bj = 0; bj < 2; ++bj)
#pragma unroll
                    for (int n = 0; n < 2; ++n) { const int c = col0 + bj * HALF + n * 16; float* d = (c < MEMW) ? MK + (size_t)r * MEMW + c : MV + (size_t)r * MEMW + (c - MEMW); *(f32x4*)d = acc[ai][bj][m][n] * rs; }
            }
    }
};
struct EpiGate {
    static constexpr bool PERM = true, AFTER_DRAIN = false;
    bf16* G; const float* rstd; int skip;
    DI void operator()(const f32x4 (&acc)[2][2][4][2], const Unit& u, int wr, int wc, int fr, int fq) const {
        if (skip) { asm volatile("" :: "v"(acc[0][0][0][0][0]), "v"(acc[1][1][3][1][3])); return; }
        const int row0 = u.pm * BM + wr * 64 + fr, col0 = u.pn * BM + wc * 32 + 8 * fq;
        float rsv[2][4];
#pragma unroll
        for (int ai = 0; ai < 2; ++ai)
#pragma unroll
            for (int m = 0; m < 4; ++m) rsv[ai][m] = rstd[row0 + ai * HALF + m * 16];
#pragma unroll
        for (int ai = 0; ai < 2; ++ai)
#pragma unroll
            for (int m = 0; m < 4; ++m) {
                const int r = row0 + ai * HALF + m * 16; const float rs = rsv[ai][m];
#pragma unroll
                for (int bj = 0; bj < 2; ++bj) {
                    f32x4 v0 = acc[ai][bj][m][0] * rs, v1 = acc[ai][bj][m][1] * rs;
#pragma unroll
                    for (int j = 0; j < 4; ++j) { v0[j] = sigmoid_f(v0[j]); v1[j] = sigmoid_f(v1[j]); }
                    *(u32x4*)(G + (size_t)r * NGATE + col0 + bj * HALF) = pack8f(v0, v1);
                }
            }
    }
};
struct EpiBr {
    static constexpr bool PERM = true, AFTER_DRAIN = false;
    const bf16* G; bf16* MG; int b;
    DI void operator()(const f32x4 (&acc)[2][2][4][2], const Unit& u, int wr, int wc, int fr, int fq) const {
        const int row0 = u.pm * BM + wr * 64 + fr, col0 = u.pn * BM + wc * 32 + 8 * fq;
#pragma unroll
        for (int ai = 0; ai < 2; ++ai) {
            u32x4 gv[4][2], ov[4][2];
#pragma unroll
            for (int m = 0; m < 4; ++m)
#pragma unroll
                for (int bj = 0; bj < 2; ++bj) {
                    const size_t r = (size_t)(row0 + ai * HALF + m * 16); const int c = col0 + bj * HALF;
                    gv[m][bj] = *(const u32x4*)(G + r * NGATE + b * D + c);
                    ov[m][bj] = (b > 0) ? *(const u32x4*)(MG + r * D + c) : (u32x4){0u, 0u, 0u, 0u};
                }
#pragma unroll
            for (int m = 0; m < 4; ++m)
#pragma unroll
                for (int bj = 0; bj < 2; ++bj) {
                    const size_t r = (size_t)(row0 + ai * HALF + m * 16); const int c = col0 + bj * HALF;
                    f32x4 g0, g1, o0, o1; unpack8(gv[m][bj], g0, g1); unpack8(ov[m][bj], o0, o1);
                    const f32x4 v0 = acc[ai][bj][m][0] * g0 + o0, v1 = acc[ai][bj][m][1] * g1 + o1;
                    *(u32x4*)(MG + r * D + c) = pack8f(v0, v1);
                }
            asm volatile("" ::: "memory");
        }
    }
};
struct EpiRes {
    static constexpr bool PERM = false, AFTER_DRAIN = false;
    const float* xin_p; const float* xin_s; const bf16* xin_b; float* Y; bf16* XB; float* SS;
    DI void operator()(const f32x4 (&acc)[2][2][4][2], const Unit& u, int wr, int wc, int fr, int fq) const {
        const int row0 = u.pm * BM + wr * 64 + fr, col0 = u.pn * BM + wc * 32 + 4 * fq;
#pragma unroll
        for (int ai = 0; ai < 2; ++ai) {
            f32x4 xv[4][2][2];
            if (xin_b) {
                u32x2 xb[4][2][2];
#pragma unroll
                for (int m = 0; m < 4; ++m)
#pragma unroll
                    for (int bj = 0; bj < 2; ++bj)
#pragma unroll
                        for (int n = 0; n < 2; ++n) xb[m][bj][n] = *(const u32x2*)(xin_b + (size_t)(row0 + ai * HALF + m * 16) * D + col0 + bj * HALF + n * 16);
#pragma unroll
                for (int m = 0; m < 4; ++m)
#pragma unroll
                    for (int bj = 0; bj < 2; ++bj)
#pragma unroll
                        for (int n = 0; n < 2; ++n) xv[m][bj][n] = (f32x4){bf_lo(xb[m][bj][n].x), bf_hi(xb[m][bj][n].x), bf_lo(xb[m][bj][n].y), bf_hi(xb[m][bj][n].y)};
            } else {
#pragma unroll
                for (int m = 0; m < 4; ++m) {
                    const int r = row0 + ai * HALF + m * 16;
                    const float* xin = (r < MP) ? xin_p + (size_t)r * D : xin_s + (size_t)(r - MP) * D;
#pragma unroll
                    for (int bj = 0; bj < 2; ++bj)
#pragma unroll
                        for (int n = 0; n < 2; ++n) xv[m][bj][n] = *(const f32x4*)(xin + col0 + bj * HALF + n * 16);
                }
            }
#pragma unroll
            for (int m = 0; m < 4; ++m) {
                const int r = row0 + ai * HALF + m * 16;
                float ss = 0.f;
#pragma unroll
                for (int bj = 0; bj < 2; ++bj)
#pragma unroll
                    for (int n = 0; n < 2; ++n) {
                        const int c = col0 + bj * HALF + n * 16;
                        const f32x4 x = xv[m][bj][n] + acc[ai][bj][m][n];
                        if (Y) *(f32x4*)(Y + (size_t)r * D + c) = x;
                        if (XB) { u32x2 w; w.x = pg8::cvt_pk_bf16(x[0], x[1]); w.y = pg8::cvt_pk_bf16(x[2], x[3]); *(u32x2*)(XB + (size_t)r * D + c) = w; }
                        ss += (x[0] * x[0] + x[1] * x[1]) + (x[2] * x[2] + x[3] * x[3]);
                    }
                ss += __shfl_xor(ss, 16); ss += __shfl_xor(ss, 32);
                if (fq == 0) SS[(size_t)r * 16 + u.pn * 4 + wc] = ss;
            }
            asm volatile("" ::: "memory");
        }
    }
};
DI float rstd_from_ss(const float* SS, int r) {
    const f32x4 a = *(const f32x4*)(SS + (size_t)r * 16), b = *(const f32x4*)(SS + (size_t)r * 16 + 4), c = *(const f32x4*)(SS + (size_t)r * 16 + 8), d = *(const f32x4*)(SS + (size_t)r * 16 + 12);
    const float s = (((a[0] + a[1]) + (a[2] + a[3])) + ((b[0] + b[1]) + (b[2] + b[3]))) + (((c[0] + c[1]) + (c[2] + c[3])) + ((d[0] + d[1]) + (d[2] + d[3])));
    return 1.0f / sqrtf(s * (1.0f / D) + RMS_EPS);
}
struct EpiGU {
    static constexpr bool PERM = true, AFTER_DRAIN = false;
    const float* SS; bf16* HB;
    DI void operator()(const f32x4 (&acc)[2][2][4][2], const Unit& u, int wr, int wc, int fr, int fq) const {
        const int row0 = u.pm * BM + wr * 64 + fr, col0 = u.pn * HALF + wc * 32 + 8 * fq;
#pragma unroll
        for (int ai = 0; ai < 2; ++ai) {
            f32x4 sv[4][4];
#pragma unroll
            for (int m = 0; m < 4; ++m)
#pragma unroll
                for (int j = 0; j < 4; ++j) sv[m][j] = *(const f32x4*)(SS + (size_t)(row0 + ai * HALF + m * 16) * 16 + 4 * j);
#pragma unroll
            for (int m = 0; m < 4; ++m) {
                const int r = row0 + ai * HALF + m * 16;
                const f32x4 a4 = sv[m][0], b4 = sv[m][1], c4 = sv[m][2], d4 = sv[m][3];
                const float ssum = (((a4[0] + a4[1]) + (a4[2] + a4[3])) + ((b4[0] + b4[1]) + (b4[2] + b4[3]))) + (((c4[0] + c4[1]) + (c4[2] + c4[3])) + ((d4[0] + d4[1]) + (d4[2] + d4[3])));
                const float rs = 1.0f / sqrtf(ssum * (1.0f / D) + RMS_EPS);
                f32x4 h0, h1;
#pragma unroll
                for (int j = 0; j < 4; ++j) { h0[j] = silu_f(acc[ai][0][m][0][j] * rs) * (acc[ai][1][m][0][j] * rs); h1[j] = silu_f(acc[ai][0][m][1][j] * rs) * (acc[ai][1][m][1][j] * rs); }
                *(u32x4*)(HB + (size_t)r * FF + col0) = pack8f(h0, h1);
            }
            asm volatile("" ::: "memory");
        }
    }
};
struct EpiFinal {
    static constexpr bool PERM = false, AFTER_DRAIN = true;
    const bf16* xin_b; const float* gain; float* Y; float* SS; unsigned* cnt; unsigned* tmo;
    DI void fused(f32x4 (&acc)[2][2][4][2], const Unit& u, int wr, int wc, int fr, int fq, PG8_LAS unsigned char* lds, int wid, int lane) const {
        PG8_LAS float* P = (PG8_LAS float*)lds;
        PG8_LAS float* R = (PG8_LAS float*)(lds + 8192);
        const int row0 = u.pm * BM + wr * 64 + fr, col0 = u.pn * BM + wc * 32 + 4 * fq;
#pragma unroll
        for (int ai = 0; ai < 2; ++ai) {
            u32x2 xb[4][2][2];
#pragma unroll
            for (int m = 0; m < 4; ++m)
#pragma unroll
                for (int bj = 0; bj < 2; ++bj)
#pragma unroll
                    for (int n = 0; n < 2; ++n) xb[m][bj][n] = *(const u32x2*)(xin_b + (size_t)(row0 + ai * HALF + m * 16) * D + col0 + bj * HALF + n * 16);
#pragma unroll
            for (int m = 0; m < 4; ++m) {
                float ss = 0.f;
#pragma unroll
                for (int bj = 0; bj < 2; ++bj)
#pragma unroll
                    for (int n = 0; n < 2; ++n) {
                        const f32x4 x = (f32x4){bf_lo(xb[m][bj][n].x), bf_hi(xb[m][bj][n].x), bf_lo(xb[m][bj][n].y), bf_hi(xb[m][bj][n].y)} + acc[ai][bj][m][n];
                        acc[ai][bj][m][n] = x; ss += (x[0] * x[0] + x[1] * x[1]) + (x[2] * x[2] + x[3] * x[3]);
                    }
                ss += __shfl_xor(ss, 16); ss += __shfl_xor(ss, 32);
                if (fq == 0) P[(ai * HALF + wr * 64 + m * 16 + fr) * 4 + wc] = ss;
            }
            asm volatile("" ::: "memory");
        }
        asm volatile("s_waitcnt lgkmcnt(0)" ::: "memory"); __builtin_amdgcn_s_barrier(); asm volatile("" ::: "memory");
        const int row = wid * 32 + (lane & 31);
        if (lane < 32) {
            const float t = (P[row * 4 + 0] + P[row * 4 + 1]) + (P[row * 4 + 2] + P[row * 4 + 3]);
            __hip_atomic_store((unsigned*)(SS + (size_t)(u.pm * BM + row) * 16 + u.pn), __float_as_uint(t), __ATOMIC_RELAXED, __HIP_MEMORY_SCOPE_AGENT);
        }
        asm volatile("s_waitcnt vmcnt(0)" ::: "memory");
        if (lane == 0) __hip_atomic_fetch_add(cnt + 64 * u.pm, 1u, __ATOMIC_RELAXED, __HIP_MEMORY_SCOPE_AGENT);
        if (wid == 0) {
            unsigned spins = 0;
            while ((unsigned)__builtin_amdgcn_readfirstlane(__hip_atomic_load(cnt + 64 * u.pm, __ATOMIC_RELAXED, __HIP_MEMORY_SCOPE_AGENT)) < 32u) {
                __builtin_amdgcn_s_sleep(2);
                if (++spins > (1u << 22)) { if (lane == 0) __hip_atomic_store(tmo, 1u, __ATOMIC_RELAXED, __HIP_MEMORY_SCOPE_AGENT); break; }
            }
            __builtin_amdgcn_fence(__ATOMIC_ACQUIRE, "agent");
        }
        asm volatile("s_waitcnt vmcnt(0) lgkmcnt(0)" ::: "memory"); __builtin_amdgcn_s_barrier(); asm volatile("" ::: "memory");
        if (lane < 32) {
            const unsigned* sl = (const unsigned*)(SS + (size_t)(u.pm * BM + row) * 16);
            const float s = (__uint_as_float(__hip_atomic_load(sl + 0, __ATOMIC_RELAXED, __HIP_MEMORY_SCOPE_AGENT)) + __uint_as_float(__hip_atomic_load(sl + 1, __ATOMIC_RELAXED, __HIP_MEMORY_SCOPE_AGENT)))
                          + (__uint_as_float(__hip_atomic_load(sl + 2, __ATOMIC_RELAXED, __HIP_MEMORY_SCOPE_AGENT)) + __uint_as_float(__hip_atomic_load(sl + 3, __ATOMIC_RELAXED, __HIP_MEMORY_SCOPE_AGENT)));
            R[row] = 1.0f / sqrtf(s * (1.0f / D) + RMS_EPS);
        }
        asm volatile("s_waitcnt lgkmcnt(0)" ::: "memory"); __builtin_amdgcn_s_barrier(); asm volatile("" ::: "memory");
        f32x4 gv[2][2];
#pragma unroll
        for (int bj = 0; bj < 2; ++bj)
#pragma unroll
            for (int n = 0; n < 2; ++n) gv[bj][n] = *(const f32x4*)(gain + col0 + bj * HALF + n * 16);
#pragma unroll
        for (int ai = 0; ai < 2; ++ai)
#pragma unroll
            for (int m = 0; m < 4; ++m) {
                const int rl = ai * HALF + wr * 64 + m * 16 + fr; const float rs = R[rl];
#pragma unroll
                for (int bj = 0; bj < 2; ++bj)
#pragma unroll
                    for (int n = 0; n < 2; ++n) *(f32x4*)(Y + (size_t)(u.pm * BM + rl) * D + col0 + bj * HALF + n * 16) = acc[ai][bj][m][n] * rs * gv[bj][n];
            }
    }
};
}
using namespace cfg;
constexpr int NWAVES = 8;
#ifndef MK_N_LAUNCHES
#define MK_N_LAUNCHES 1
#endif
constexpr int N_PHASES = 9;
struct Args { const float* in[26]; float* out; unsigned char* ws; int ph_lo, ph_hi, li, pad; };
static_assert(sizeof(Args) == 26 * 8 + 8 + 8 + 16, "no padding bytes in the kernel argument");
enum { I_XP = 0, I_XS, I_SD, I_SC, I_CK, I_CV, I_MEM, I_NMIX, I_WIN, I_CONVW, I_ALOG, I_DTB, I_DNN, I_SGN, I_SGW, I_SGB, I_WBD, I_WBS, I_WBM, I_WO, I_MNORM, I_WKV, I_NFFN, I_WGU, I_WDN, I_NFIN };

DI void p0_transpose_item(const float* W, int ld_src, int n0, int k0, const float* gain, bf16* WT, int ld_dst, int drow0, int koff, LAS float* scr, int lane) {
    float wv[32], gv[32];
#pragma unroll
    for (int i = 0; i < 32; ++i) { const int kk = 2 * i + (lane >> 5); wv[i] = W[(size_t)(k0 + kk) * ld_src + n0 + (lane & 31)]; gv[i] = gain ? gain[k0 + kk] : 1.0f; }
#pragma unroll
    for (int i = 0; i < 32; ++i) { const int kk = 2 * i + (lane >> 5); scr[kk * 33 + (lane & 31)] = wv[i] * gv[i]; }
    LDS_WAIT(); asm volatile("" ::: "memory");
    const int c = lane & 7;
#pragma unroll
    for (int j = 0; j < 4; ++j) { const int n = (lane >> 3) + 8 * j; const LAS float* s = scr + (8 * c) * 33 + n;
        v4u o; o.x = pk2(s[0 * 33], s[1 * 33]); o.y = pk2(s[2 * 33], s[3 * 33]); o.z = pk2(s[4 * 33], s[5 * 33]); o.w = pk2(s[6 * 33], s[7 * 33]);
        *(GAS v4u*)(WT + (size_t)(drow0 + n) * ld_dst + koff + k0 + 8 * c) = o; }
    LDS_WAIT(); asm volatile("" ::: "memory");
}

DI void p0_prologue(const Args& a, LAS unsigned char* lds, int vcu, int G) {
    const int tid = t_id(), lane = tid & 63, wave = __builtin_amdgcn_readfirstlane(tid >> 6);
    unsigned char* ws = a.ws;
    LAS float* scr = (LAS float*)(lds + wave * 16384);
    const int gw = vcu * NWAVES + wave, NGW = G * NWAVES;
    constexpr int I0 = 16 * 272, I1 = I0 + 16 * 32, I2 = I1 + 8 * 32, I3 = I2 + 8 * 32, I4 = I3 + 16 * 32, I5 = I4 + 16 * 32, I6 = I5 + 16 * 176, I7 = I6 + 44 * 32;
#ifndef DUP0
#define DUP0 0
#endif
    for (int rep0 = 0; rep0 < ((DUP0 & 1) ? 2 : 1); ++rep0)
    for (int it = gw; it < I7; it += NGW) {
        if (it < I0) { const int kb = it / 272, nb = it % 272, dr = 32 * nb; p0_transpose_item(a.in[I_WIN], DIN, dr < 4096 ? dr : dr + 16, 64 * kb, a.in[I_NMIX], (bf16*)(ws + WS_WIN), D, dr, 0, scr, lane); }
        else if (it < I1) { const int r = it - I0, kb = r / 32, nb = r % 32; p0_transpose_item(a.in[I_WBD], D, 32 * nb, 64 * kb, nullptr, (bf16*)(ws + WS_WBR), 2048, 32 * nb, 0, scr, lane); }
        else if (it < I2) { const int r = it - I1, kb = r / 32, nb = r % 32; p0_transpose_item(a.in[I_WBS], D, 32 * nb, 64 * kb, nullptr, (bf16*)(ws + WS_WBR), 2048, 32 * nb, 1024, scr, lane); }
        else if (it < I3) { const int r = it - I2, kb = r / 32, nb = r % 32; p0_transpose_item(a.in[I_WBM], D, 32 * nb, 64 * kb, nullptr, (bf16*)(ws + WS_WBR), 2048, 32 * nb, 1536, scr, lane); }
        else if (it < I4) { const int r = it - I3, kb = r / 32, nb = r % 32; p0_transpose_item(a.in[I_WO], D, 32 * nb, 64 * kb, nullptr, (bf16*)(ws + WS_WO), D, 32 * nb, 0, scr, lane); }
        else if (it < I5) { const int r = it - I4, kb = r / 32, nb = r % 32; p0_transpose_item(a.in[I_WKV], D, 32 * nb, 64 * kb, a.in[I_MNORM], (bf16*)(ws + WS_WKV), D, 32 * nb, 0, scr, lane); }
        else if (it < I6) { const int r = it - I5, kb = r / 176, nb = r % 176, n0 = 32 * nb, up = n0 >= FF, f0 = n0 - up * FF;
            p0_transpose_item(a.in[I_WGU], 2 * FF, n0, 64 * kb, a.in[I_NFFN], (bf16*)(ws + WS_WGU), D, 256 * (f0 / 128) + 128 * up + (f0 % 128), 0, scr, lane); }
        else { const int r = it - I6, kb = r / 32, nb = r % 32; p0_transpose_item(a.in[I_WDN], D, 32 * nb, 64 * kb, nullptr, (bf16*)(ws + WS_WDN), FF, 32 * nb, 0, scr, lane); }
    }
    { bf16* sw = (bf16*)(ws + WS_SGW); const float* w = a.in[I_SGW];
      for (int i = (vcu * NWAVES * 64) + tid; i < 4 * 128 * 128; i += G * NWAVES * 64) { const int t = (i >> 7) & 127, s = i & 127; sw[i] = (bf16)f2bf(s <= t ? w[i] : 0.f); } }
    __syncthreads();
    LAS float* img = (LAS float*)lds;
    for (int i = tid; i < 16 * 1024; i += NWAVES * 64) { const int k = i >> 4, c = i & 15; img[c * 1024 + k] = a.in[I_WIN][(size_t)k * DIN + 4096 + c] * a.in[I_NMIX][k]; }
    __syncthreads();
    bf16* XB = (bf16*)(ws + WS_XB); float* RS = (float*)(ws + WS_RSTDX); float* BA = (float*)(ws + WS_BA);
    f32x4 vnx[4];
    { const int m = gw; if (m < M) { const float* xrow = (m < MP) ? a.in[I_XP] + (size_t)m * D : a.in[I_XS] + (size_t)(m - MP) * D; const GAS f32x4* xr = (const GAS f32x4*)xrow + lane;
#pragma unroll
        for (int j = 0; j < 4; ++j) vnx[j] = xr[64 * j]; } }
    for (int m = gw; m < M; m += NGW) {
        f32x4 v[4]; float s = 0.f;
#pragma unroll
        for (int j = 0; j < 4; ++j) v[j] = vnx[j];
        { const int mn = m + NGW; if (mn < M) { const float* xrow = (mn < MP) ? a.in[I_XP] + (size_t)mn * D : a.in[I_XS] + (size_t)(mn - MP) * D; const GAS f32x4* xr = (const GAS f32x4*)xrow + lane;
#pragma unroll
            for (int j = 0; j < 4; ++j) vnx[j] = xr[64 * j]; } }
#pragma unroll
        for (int j = 0; j < 4; ++j) s += (v[j].x * v[j].x + v[j].y * v[j].y) + (v[j].z * v[j].z + v[j].w * v[j].w);
        const float rstd = 1.f / sqrtf(wave_sum(s) * (1.f / D) + RMS_EPS);
        GAS unsigned long long* o8 = (GAS unsigned long long*)(XB + (size_t)m * D) + lane;
#pragma unroll
        for (int j = 0; j < 4; ++j) o8[64 * j] = (unsigned long long)pk2(v[j].x, v[j].y) | ((unsigned long long)pk2(v[j].z, v[j].w) << 32);
        float mine = 0.f;
#pragma unroll 1
        for (int c = 0; c < 16; ++c) {
            float p = 0.f;
#pragma unroll
            for (int j = 0; j < 4; ++j) { const f32x4 wv = *(const LAS f32x4*)(img + c * 1024 + 256 * j + 4 * lane); p += (v[j].x * wv.x + v[j].y * wv.y) + (v[j].z * wv.z + v[j].w * wv.w); }
            p = wave_sum(p);
            if (lane == c) mine = p;
        }
        if (lane < 16) BA[(size_t)m * 16 + lane] = mine * rstd;
        if (lane == 0) RS[m] = rstd;
    }
    bf16* MB = (bf16*)(ws + WS_MB); float* RM = (float*)(ws + WS_RSTDM);
    for (int m = gw; m < NB * MEMT; m += NGW) {
        const GAS f32x4* xr = (const GAS f32x4*)(a.in[I_MEM] + (size_t)m * D) + lane;
        f32x4 v[4]; float s = 0.f;
#pragma unroll
        for (int j = 0; j < 4; ++j) { v[j] = xr[64 * j]; s += (v[j].x * v[j].x + v[j].y * v[j].y) + (v[j].z * v[j].z + v[j].w * v[j].w); }
        const float rstd = 1.f / sqrtf(wave_sum(s) * (1.f / D) + RMS_EPS);
        GAS unsigned long long* o8 = (GAS unsigned long long*)(MB + (size_t)m * D) + lane;
#pragma unroll
        for (int j = 0; j < 4; ++j) o8[64 * j] = (unsigned long long)pk2(v[j].x, v[j].y) | ((unsigned long long)pk2(v[j].z, v[j].w) << 32);
        if (lane == 0) RM[m] = rstd;
    }
}

DI void stagger_delay(unsigned ticks) { const unsigned long long t0 = __builtin_amdgcn_s_memrealtime(); while (__builtin_amdgcn_s_memrealtime() - t0 < ticks) __builtin_amdgcn_s_sleep(8); }
struct RotOrder : pg8::StaticOrder { };

__global__ void __launch_bounds__(NWAVES * 64, 2) hyb_fwd(Args args) {
    extern __shared__ __attribute__((aligned(16))) unsigned char lds_raw[];
    LAS unsigned char* lds = (LAS unsigned char*)lds_raw;
    volatile LAS unsigned* MISC = (volatile LAS unsigned*)(lds + MISC_OFF);
    const int G = gridDim.x, bx = blockIdx.x, vcu = (G % 8 == 0) ? (bx % 8) * (G / 8) + bx / 8 : bx;
    for (int u = t_id(); u < 128; u += NWAVES * 64) ((LAS unsigned*)(lds + MISC_OFF))[u] = 0u;
    unsigned char* const ws = args.ws; float* const out = args.out; gu32* const ctl = (gu32*)(ws + WS_CTL);
    __syncthreads();
    XcdBarrier bar; bar.bar = (unsigned*)(ctl + CW_BAR) + args.li * XCD_BAR_WORDS; bar.x = 0; bar.st = nullptr;
    if (MK_N_LAUNCHES <= 2) bar = xcd_barrier_post((unsigned*)(ctl + CW_BAR) + args.li * XCD_BAR_WORDS, MISC + 8);
    const int lo = args.ph_lo, hi = args.ph_hi, pass = args.li;
#ifndef PH_MASK
#define PH_MASK 0x3ff
#endif
#define IN(k) (((PH_MASK >> (k)) & 1) && lo <= (k) && (k) < hi)
#define SEAM(k) do { if (IN(k) && IN((k) + 1)) xcd_barrier(bar); } while (0)
    bf16* const XB = (bf16*)(ws + WS_XB); const float* const RSX = (const float*)(ws + WS_RSTDX);

    if (IN(0)) { p0_prologue(args, lds, vcu, G); }
    SEAM(0);
    if (IN(1)) {
#ifdef STAGGER
        if ((bx >> 3) & 1) stagger_delay(STAGGER);
#endif
        { pg8::Gemm g{XB, (const bf16*)(ws + WS_WIN), MP, 4096, D, D, D}; pg8::StaticOrder S; S.init(MP, 4096, G, bx);
          ep::EpiG1 E{(bf16*)(ws + WS_QKV), (bf16*)out  , (bf16*)out + (size_t)M * D, (bf16*)(ws + WS_QMEM), (bf16*)(ws + WS_HALO), out + O_CSP, out + O_CSS, RSX};
          pg8::gemm_phase<ep::EpiG1, pg8::StaticOrder, true, true>(lds, g, S, E); }
    }
    SEAM(1);
    DnPtrs DP{(const bf16*)(ws + WS_QKV), (const bf16*)(ws + WS_HALO), (const float*)(ws + WS_BA), args.in[I_CONVW], args.in[I_ALOG], args.in[I_DTB], args.in[I_DNN],
              (bf16*)(ws + WS_WB), (bf16*)(ws + WS_QD), (bf16*)(ws + WS_KDT), (unsigned*)(ws + WS_UB), (bf16*)(ws + WS_AB), (float*)(ws + WS_DL),
              (const bf16*)out, (bf16*)(ws + WS_OCAT), out + O_DSP, args.in[I_SD], args.in[I_SC], out + O_DSS};
    if (IN(2)) {
        dn::PrepRaw R;
        if (vcu < NB * H * NCH) dn::prep_fetch(DP, R, vcu >> 8, (vcu >> 5) & 7, vcu & 31);
        for (int i = vcu; i < NB * H * NCH; i += G) { const int in = i + G; dn::prep_item(lds, DP, i >> 8, (i >> 5) & 7, i & 31, R, in < NB * H * NCH, in >> 8, (in >> 5) & 7, in & 31); }
        __syncthreads();
    }
    SEAM(2);
    if (IN(3)) {
#ifndef IT_MASK
#define IT_MASK 0x3f
#endif
#ifndef DUPQ
#define DUPQ 0
#endif
        gu32* const sub = ctl + 3072 + 64 * pass;
        if (bx < NB * H) { for (int rep = 0; rep < ((DUPQ & 1) ? 2 : 1); ++rep) dn::scan_item(lds, DP, bx >> 3, bx & 7); }
        else {
            const int cr = bx - NB * H, nq_ = G - NB * H, c = (nq_ % 8 == 0) ? (cr % 8) * (nq_ / 8) + cr / 8 : cr;
            { pg8::Gemm g{XB, (const bf16*)(ws + WS_WIN), M, N1, D, D, D}; pg8::ListG1 S{c, nq_};
              ep::EpiG1 E{(bf16*)(ws + WS_QKV), (bf16*)out, (bf16*)out + (size_t)M * D, (bf16*)(ws + WS_QMEM), (bf16*)(ws + WS_HALO), out + O_CSP, out + O_CSS, RSX};
              pg8::gemm_phase<ep::EpiG1, pg8::ListG1, true, true>(lds, g, S, E); }
            const int e = c - (pg8::ListG1::NU - 2 * nq_);
            constexpr int NGU = (MS / 256) * (NGATE / 256), NKV = (NB * MEMT / 256) * (D / 256);
            if (e >= 0 && e < NGU) { pg8::Gemm g{XB, (const bf16*)(ws + WS_WIN) + (size_t)N1 * D, M, NGATE, D, D, D}; pg8::OneUnit S{MP / 256 + e / (NGATE / 256), e % (NGATE / 256)};
                ep::EpiGate E{(bf16*)(ws + WS_GATES_S) - (size_t)MP * NGATE, RSX, 0};
                pg8::gemm_phase<ep::EpiGate, pg8::OneUnit, true, true>(lds, g, S, E); }
            else if (e >= NGU && e < NGU + NKV) { const int k = e - NGU; pg8::Gemm g{(const bf16*)(ws + WS_MB), (const bf16*)(ws + WS_WKV), NB * MEMT, D, D, D, D}; pg8::OneUnit S{k / (D / 256), k % (D / 256)};
                ep::EpiKV E{out + O_MK, out + O_MV, (const float*)(ws + WS_RSTDM)};
                pg8::gemm_phase<ep::EpiKV, pg8::OneUnit, true, true>(lds, g, S, E); }
        }
        asm volatile("s_waitcnt vmcnt(0)" ::: "memory");
        __syncthreads();
        if (threadIdx.x == 0) {
            if (bx >= NB * H) { __builtin_amdgcn_fence(__ATOMIC_RELEASE, "agent"); asm volatile("s_waitcnt vmcnt(0)" ::: "memory"); (void)xb_add((unsigned*)sub, 1u); }
            XB_SPIN(xb_ld((unsigned*)sub) < (unsigned)(G - NB * H), (unsigned*)(ctl + CW_BAR) + args.li * XCD_BAR_WORDS);
            __builtin_amdgcn_fence(__ATOMIC_ACQUIRE, "agent"); asm volatile("s_waitcnt vmcnt(0)" ::: "memory");
        }
        __syncthreads();
        SgPtrs SP{(const bf16*)out + (size_t)M * D, (const bf16*)(ws + WS_SGW), args.in[I_SGW], args.in[I_SGB], args.in[I_SGN], (bf16*)(ws + WS_OCAT), out + O_SGV};
        const bf16* QM = (const bf16*)(ws + WS_QMEM); bf16* OC = (bf16*)(ws + WS_OCAT);
#ifndef SB_REP
#define SB_REP 1
#endif
#ifndef SG_REP
#define SG_REP 1
#endif
#ifndef PA_REP
#define PA_REP 1
#endif
#ifndef SA_REP
#define SA_REP 1
#endif
#ifndef SS_REP
#define SS_REP 1
#endif
        constexpr int QG = 0, Q0 = QG + SG_REP * (NB * 16), Q1 = Q0 + SB_REP * (DB * H / 4), Q2 = Q1 + PA_REP * (NB * MEMH * 8), Q3 = Q2 + SA_REP * (DB * MEMH), Q4 = Q3 + SS_REP * DB;
#define Q_FETCH() do { __syncthreads(); if (t_id() == 0) MISC[16] = __hip_atomic_fetch_add(ctl + 2048 + 64 * pass, 1u, __ATOMIC_RELAXED, __HIP_MEMORY_SCOPE_AGENT); __syncthreads(); q = (int)MISC[16]; } while (0)
        int q; Q_FETCH();
        while (q < Q0) { const int r = (q - QG) % (NB * 16); sg::sgu_item(lds, SP, r >> 4, r & 15); Q_FETCH(); }
        while (q < Q1) { dn::sample_batch(lds, DP, (q - Q0) % (DB * H / 4)); Q_FETCH(); }
        while (q < Q3) {
            const bf16* Qp; const float* Kp; const float* Vp; bf16* Op; int nq;
            if (q >= Q2) { const int r = (q - Q2) % (DB * MEMH), b = r >> 2, hd = r & 3; nq = 8;
                Qp = QM + (size_t)(MP + 8 * b) * MEMW + hd * 128; Kp = args.in[I_CK] + (size_t)b * MEMT * MEMW + hd * 128; Vp = args.in[I_CV] + (size_t)b * MEMT * MEMW + hd * 128; Op = OC + (size_t)(MP + 8 * b) * 2048 + 1536 + hd * 128; }
            else { const int r = (q - Q1) % (NB * MEMH * 8), b = r >> 5, hd = (r >> 3) & 3, qb = r & 7; const size_t row = (size_t)b * SEQ + 256 * qb; nq = 256;
                Qp = QM + row * MEMW + hd * 128; Kp = out + O_MK + (size_t)b * MEMT * MEMW + hd * 128; Vp = out + O_MV + (size_t)b * MEMT * MEMW + hd * 128; Op = OC + row * 2048 + 1536 + hd * 128; }
            at::attn_item(lds, Qp, nq, Kp, Vp, Op);
            Q_FETCH();
        }
        while (q < Q4) { sg::sgu_sample_item(lds, SP, (q - Q3) % DB); Q_FETCH(); }
#undef Q_FETCH
        __syncthreads();
    }
    SEAM(3);
#ifdef P3_FILL
    if (IN(4)) { u32x4* gp = (u32x4*)(ws + WS_GATES); const size_t n16 = (size_t)M * NGATE * 2 / 16;
        for (size_t i = (size_t)bx * 512 + t_id(); i < n16; i += (size_t)G * 512) { const unsigned w = 0x3f003e80u + (unsigned)(i & 63); gp[i] = (u32x4){w, w, w, w}; } }
    if (0) {
#else
    if (IN(4)) {
#endif
        pg8::Gemm g{XB, (const bf16*)(ws + WS_WIN) + (size_t)N1 * D, MP, NGATE, D, D, D}; pg8::StaticOrder S; S.init(MP, NGATE, G, bx);
#ifdef PROBE_SKIP_EPI
        ep::EpiGate E{(bf16*)(ws + WS_GATES), RSX, args.li};
#else
        ep::EpiGate E{(bf16*)(ws + WS_GATES), RSX, 0};
#endif
        pg8::gemm_phase<ep::EpiGate, pg8::StaticOrder, true, true>(lds, g, S, E);
    }
    SEAM(4);
    if (IN(5)) {
        const bf16* OC = (const bf16*)(ws + WS_OCAT); const bf16* WBR = (const bf16*)(ws + WS_WBR);
        const int koff[3] = {0, 1024, 1536}, klen[3] = {1024, 512, 512};
#pragma unroll
        for (int b = 0; b < 3; ++b) {
#ifdef P4_PASSES
            if (!((P4_PASSES >> b) & 1)) continue;
#endif
            pg8::Gemm g{OC + koff[b], WBR + koff[b], MP, D, klen[b], 2048, 2048}; pg8::StaticOrder S; S.init(MP, D, G, bx);
            ep::EpiBr E{(const bf16*)(ws + WS_GATES), (bf16*)(ws + WS_MERGED), b};
            pg8::gemm_phase<ep::EpiBr, pg8::StaticOrder, true, true>(lds, g, S, E);
        }
        { const mini::MiniPtrs MPp{OC, WBR, (const bf16*)(ws + WS_GATES_S) - (size_t)MP * NGATE, (bf16*)(ws + WS_MERGED), nullptr, nullptr, nullptr, nullptr, nullptr, nullptr, nullptr, nullptr};
#ifndef DUP_MINI
#define DUP_MINI 1
#endif
          for (int rep = 0; rep < DUP_MINI; ++rep) for (int t = bx; t < 256; t += G) mini::br_tile(lds, MPp, mini::tile_of(t)); }
    }
    SEAM(5);
    if (IN(6)) {
        pg8::Gemm g{(const bf16*)(ws + WS_MERGED), (const bf16*)(ws + WS_WO), MP, D, D, D, D}; pg8::StaticOrder S; S.init(MP, D, G, bx);
        ep::EpiRes E{args.in[I_XP], args.in[I_XS], nullptr, nullptr, (bf16*)(ws + WS_X1B), (float*)(ws + WS_SS1)};
        pg8::gemm_phase<ep::EpiRes, pg8::StaticOrder, true, true>(lds, g, S, E);
        for (int t = bx; t < 256; t += G) mini::res_tile(lds, (const bf16*)(ws + WS_MERGED), D, (const bf16*)(ws + WS_WO), D, D, args.in[I_XS], MP, nullptr, nullptr, (bf16*)(ws + WS_X1B), (float*)(ws + WS_SS1), mini::tile_of(t));
        __syncthreads();
    }
    SEAM(6);
    if (IN(7)) {
#ifdef STAGGER
        if ((bx >> 3) & 1) stagger_delay(STAGGER);
#endif
        pg8::Gemm g{(const bf16*)(ws + WS_X1B), (const bf16*)(ws + WS_WGU), M, 2 * FF, D, D, D}; pg8::StaticOrder S; S.init(M, 2 * FF, G, bx);
        ep::EpiGU E{(const float*)(ws + WS_SS1), (bf16*)(ws + WS_HB)};
        pg8::gemm_phase<ep::EpiGU, pg8::StaticOrder, true, true>(lds, g, S, E);
    }
    SEAM(7);
    if (IN(8)) {
        pg8::Gemm g{(const bf16*)(ws + WS_HB), (const bf16*)(ws + WS_WDN), MP, D, FF, FF, FF}; pg8::StaticOrder S; S.init(MP, D, G, bx);
        ep::EpiFinal E{(const bf16*)(ws + WS_X1B), args.in[I_NFIN], out + O_Y, (float*)(ws + WS_SS2), (unsigned*)(ctl + CW_FIN), (unsigned*)(ctl + CW_TMO)};
        pg8::gemm_phase<ep::EpiFinal, pg8::StaticOrder, false, true>(lds, g, S, E);
        for (int t = bx; t < 256; t += G) mini::fin_tile(lds, (const bf16*)(ws + WS_HB), FF, (const bf16*)(ws + WS_WDN), FF, FF, (const bf16*)(ws + WS_X1B), args.in[I_NFIN], out + O_Y, (float*)(ws + WS_SS2), (unsigned*)(ctl + CW_FIN2), (unsigned*)(ctl + CW_TMO), mini::tile_of(t));
    }
#undef IN
#undef SEAM
}

extern "C" void kernel_launch(void* const* d_in, const int* in_sizes, int n_in, void* d_out, int out_size, void* d_ws, size_t ws_size, hipStream_t stream) {
    static int grid = 0;
    if (grid == 0) {
        if (n_in != 26 || in_sizes[0] != MP * D || (size_t)out_size != O_END || ws_size < WS_END) { fprintf(stderr, "kernel_launch: unexpected shapes (n_in %d, in0 %d, out %d, ws %zu < %zu); nothing launched\n", n_in, n_in > 0 ? in_sizes[0] : -1, out_size, ws_size, (size_t)WS_END); grid = -1; return; }
        int dev = 0, cus = 0, per_cu = 0;
        if (hipGetDevice(&dev) != hipSuccess || hipDeviceGetAttribute(&cus, hipDeviceAttributeMultiprocessorCount, dev) != hipSuccess) { grid = -1; return; }
        if (hipFuncSetAttribute((const void*)hyb_fwd, hipFuncAttributeMaxDynamicSharedMemorySize, LDS_BYTES) != hipSuccess) { fprintf(stderr, "kernel_launch: hipFuncSetAttribute failed\n"); grid = -1; return; }
        if (hipOccupancyMaxActiveBlocksPerMultiprocessor(&per_cu, (const void*)hyb_fwd, NWAVES * 64, LDS_BYTES) != hipSuccess || per_cu < 1) fprintf(stderr, "kernel_launch: occupancy query reports %d blocks per CU\n", per_cu);
        (void)hipGetLastError();
        grid = cus;
        if (cus != 256) { fprintf(stderr, "kernel_launch: built for a 256-CU device (one 256x256 unit per CU in the N = 1024 projections, fused row-statistics exchanges); found %d CUs; nothing launched\n", cus); grid = -1; return; }
    }
    if (grid < 0) return;
    if (hipMemsetAsync((char*)d_ws + WS_CTL, 0, CTL_ZERO_BYTES, stream) != hipSuccess) return;
    Args a{};
    for (int i = 0; i < 26; ++i) a.in[i] = (const float*)d_in[i];
    a.out = (float*)d_out; a.ws = (unsigned char*)d_ws;
#if MK_N_LAUNCHES == 1
    a.ph_lo = 0; a.ph_hi = N_PHASES;
    hipLaunchKernelGGL(hyb_fwd, dim3(grid), dim3(NWAVES * 64), LDS_BYTES, stream, a);
#elif MK_N_LAUNCHES == 2
    a.ph_lo = 0; a.ph_hi = PROBE_HI + 1; a.li = 0; hipLaunchKernelGGL(hyb_fwd, dim3(grid), dim3(NWAVES * 64), LDS_BYTES, stream, a);
    a.ph_lo = PROBE_LO; a.ph_hi = N_PHASES; a.li = 1; hipLaunchKernelGGL(hyb_fwd, dim3(grid), dim3(NWAVES * 64), LDS_BYTES, stream, a);
#else
    for (int p = 0; p < N_PHASES; ++p) { a.ph_lo = p; a.ph_hi = p + 1; hipLaunchKernelGGL(hyb_fwd, dim3(grid), dim3(NWAVES * 64), LDS_BYTES, stream, a); }
#endif
}
#endif
```

```cpp
#ifndef HOST_EMU
#include <hip/hip_runtime.h>
#include <cstdio>
#include <cstdint>
#endif

namespace cfg {
constexpr int D = 1024, NB = 8, SEQ = 2048, DB = 128, DT = 8;
constexpr int MP = NB * SEQ, MS = DB * DT, M = MP + MS;
constexpr int H = 8, DK = 128, DV = 128, QKVW = 3072, CH = 64, NCH = SEQ / CH;
constexpr int SGW = 512, SGG = 4, SGC = 128;
constexpr int MEMT = 256, MEMH = 4, MEMD = 128, MEMW = 512;
constexpr int FF = 2816, DIN = 8720, N1 = 5632, NGATE = 3072, NIN = N1 + NGATE;
constexpr float RMS_EPS = 1e-6f, L2_EPS = 1e-6f;
constexpr float LOG2E = 1.4426950408889634f;
constexpr float QSCALE_MEM = 0.08838834764831845f * 1.4426950408889634f;
constexpr float QSCALE_DN = 0.08838834764831845f;
constexpr size_t O_Y = 0, O_DSP = 17825792, O_CSP = 18874368, O_MK = 18948096, O_MV = 19996672, O_DSS = 21045248, O_CSS = 37822464, O_SGV = 39002112, O_END = 39526400;
constexpr size_t MiB = 1u << 20;
constexpr size_t WS_CTL = 0, CTL_ZERO_BYTES = 128 * 1024;
constexpr size_t WS_RSTDX = 1 * MiB, WS_RSTDM = WS_RSTDX + 128 * 1024, WS_DL = WS_RSTDM + 64 * 1024, WS_BA = 1 * MiB + 256 * 1024;
constexpr size_t WS_SS1 = 5 * MiB / 2, WS_SS2 = 15 * MiB / 4;
constexpr size_t WS_WIN = 5 * MiB, WS_WBR = 22 * MiB, WS_WO = 26 * MiB, WS_WKV = 28 * MiB, WS_WGU = 30 * MiB, WS_WDN = 41 * MiB, WS_SGW = 93 * MiB / 2;
constexpr size_t WS_XB = 47 * MiB;
constexpr size_t WS_MB = 81 * MiB;
constexpr size_t WS_QMEM = 85 * MiB;
constexpr size_t WS_HALO = 102 * MiB;
constexpr size_t WS_QKV = 107 * MiB;
constexpr size_t WS_OCAT = WS_QKV, WS_X1B = WS_QKV + 68 * MiB;
constexpr size_t WS_INTER = 209 * MiB;
constexpr size_t WS_WB = WS_INTER, WS_QD = WS_INTER + 32 * MiB, WS_KDT = WS_INTER + 64 * MiB, WS_UB = WS_INTER + 96 * MiB, WS_AB = WS_INTER + 128 * MiB;
constexpr size_t WS_GATES = WS_INTER, WS_HB = WS_INTER, WS_MERGED = WS_XB;
constexpr size_t WS_GATES_S = WS_QKV + 69 * MiB;
constexpr size_t WS_END = 353 * MiB;
static_assert(WS_BA + (size_t)M * 16 * 4 <= WS_SS1 && WS_SS1 + (size_t)M * 64 <= WS_SS2 && WS_SS2 + (size_t)M * 64 <= WS_WIN, "small buffers");
static_assert(WS_WIN + (size_t)NIN * D * 2 <= WS_WBR && WS_WGU + (size_t)2 * FF * D * 2 <= WS_WDN && WS_WDN + (size_t)D * FF * 2 <= WS_SGW && WS_SGW + 4 * 128 * 128 * 2 <= WS_XB, "weights");
static_assert(WS_XB + (size_t)M * D * 2 <= WS_MB && WS_MB + 2048 * 1024 * 2 <= WS_QMEM && WS_QMEM + (size_t)M * 512 * 2 <= WS_HALO && WS_HALO + 272 * 3 * 3072 * 2 <= WS_QKV, "acts");
static_assert(WS_QKV + (size_t)M * 3072 * 2 <= WS_INTER && WS_X1B + (size_t)M * D * 2 <= WS_INTER && WS_OCAT + (size_t)M * 2048 * 2 <= WS_X1B, "qkv region");
static_assert(WS_GATES_S >= WS_OCAT + (size_t)M * 2048 * 2 && WS_GATES_S + (size_t)MS * 3072 * 2 <= WS_QKV + (size_t)MP * 3072 * 2, "sample gates");
static_assert(WS_AB + (size_t)2048 * 8192 <= WS_END && WS_GATES + (size_t)M * 3072 * 2 <= WS_END && WS_HB + (size_t)M * FF * 2 <= WS_END, "inter region");
constexpr int CW_TMO = 0, CW_CODE = 1, CW_BAR = 4096, CW_FIN = 16384, CW_FIN2 = 20480;
constexpr int RING_BYTES = 131072, LDS_BYTES = 163840, MISC_OFF = LDS_BYTES - 512;
constexpr int P2_LDS = MISC_OFF;
}

typedef unsigned short bf16;
typedef short bf16x8 __attribute__((ext_vector_type(8)));
typedef float f32x4 __attribute__((ext_vector_type(4)));
typedef float f32x16 __attribute__((ext_vector_type(16)));
typedef unsigned u32x4 __attribute__((ext_vector_type(4)));
typedef unsigned u32x2 __attribute__((ext_vector_type(2)));

#ifndef HOST_EMU
#define DI __device__ __forceinline__
#define LP(T) __attribute__((address_space(3))) T*
DI int t_id() { int t = (int)threadIdx.x; asm volatile("" : "+v"(t)); return t; }
DI void wg_sync() { __syncthreads(); }
DI void wg_sync_lds() { asm volatile("s_waitcnt lgkmcnt(0)" ::: "memory"); __builtin_amdgcn_s_barrier(); asm volatile("" ::: "memory"); }
DI void wave_sync() { __builtin_amdgcn_wave_barrier(); }
DI f32x4 mfma16(bf16x8 a, bf16x8 b, f32x4 c) { return __builtin_amdgcn_mfma_f32_16x16x32_bf16(a, b, c, 0, 0, 0); }
DI f32x16 mfma32(bf16x8 a, bf16x8 b, f32x16 c) { return __builtin_amdgcn_mfma_f32_32x32x16_bf16(a, b, c, 0, 0, 0); }
DI f32x4 mfma16f(float a, float b, f32x4 c) { return __builtin_amdgcn_mfma_f32_16x16x4f32(a, b, c, 0, 0, 0); }
DI float shfl_xor_f(float v, int m) { return __shfl_xor(v, m); }
DI float shfl_f(float v, int src) { return __shfl(v, src); }
DI float fexp2(float x) { return __builtin_amdgcn_exp2f(x); }
DI float frcp(float x) { return __builtin_amdgcn_rcpf(x); }
DI float frsq(float x) { return __builtin_amdgcn_rsqf(x); }
DI float lane_bcast(float v, int src) { return __builtin_bit_cast(float, __builtin_amdgcn_readlane(__builtin_bit_cast(int, v), __builtin_amdgcn_readfirstlane(src))); }
template <int CTRL> DI float dpp_f(float v) { return __builtin_bit_cast(float, __builtin_amdgcn_update_dpp(0, __builtin_bit_cast(int, v), CTRL, 0xf, 0xf, true)); }
DI float row_sum16(float v) { v += dpp_f<0x128>(v); v += dpp_f<0x124>(v); v += dpp_f<0x4E>(v); v += dpp_f<0xB1>(v); return v; }
DI float row_sum8(float v) { v += dpp_f<0xB1>(v); v += dpp_f<0x4E>(v); v += dpp_f<0x141>(v); return v; }
DI float wave_sum(float v) { v = row_sum16(v);
    v += __builtin_bit_cast(float, __builtin_amdgcn_update_dpp(0, __builtin_bit_cast(int, v), 0x142, 0xa, 0xf, false));
    v += __builtin_bit_cast(float, __builtin_amdgcn_update_dpp(0, __builtin_bit_cast(int, v), 0x143, 0xc, 0xf, false));
    return __builtin_bit_cast(float, __builtin_amdgcn_readlane(__builtin_bit_cast(int, v), 63)); }
DI int wave_id() { return __builtin_amdgcn_readfirstlane((int)threadIdx.x >> 6); }
#endif

#ifndef HOST_EMU
typedef float f32x2_t __attribute__((ext_vector_type(2)));
typedef __bf16 bf16x2_t __attribute__((ext_vector_type(2)));
DI unsigned pk2(float lo, float hi) { const f32x2_t v = {lo, hi}; const bf16x2_t b = __builtin_convertvector(v, bf16x2_t); return __builtin_bit_cast(unsigned, b); }
DI unsigned f2bf(float f) { return (unsigned)__builtin_bit_cast(unsigned short, (__bf16)f); }
#else
DI unsigned f2bf(float f) { unsigned u = __builtin_bit_cast(unsigned, f); return (u + 0x7fffu + ((u >> 16) & 1u)) >> 16; }
DI unsigned pk2(float lo, float hi) { return f2bf(lo) | (f2bf(hi) << 16); }
#endif
DI float bf_lo(unsigned w) { return __builtin_bit_cast(float, w << 16); }
DI float bf_hi(unsigned w) { return __builtin_bit_cast(float, w & 0xffff0000u); }
DI float bf2f(bf16 b) { return __builtin_bit_cast(float, ((unsigned)b) << 16); }
DI float sigmoid_f(float x) { return frcp(1.0f + fexp2(-cfg::LOG2E * x)); }
DI float silu_f(float x) { return x * sigmoid_f(x); }
DI float gelu_tanh_f(float x) { return x * frcp(1.0f + fexp2(-2.302208198f * (x + 0.044715f * x * x * x))); }
#ifdef HOST_EMU
DI int wave_id() { return t_id() >> 6; }
DI float lane_bcast(float v, int src) { return shfl_f(v, src); }
DI float row_sum16(float v) { v += shfl_xor_f(v, 8); v += shfl_xor_f(v, 4); v += shfl_xor_f(v, 2); v += shfl_xor_f(v, 1); return v; }
DI float row_sum8(float v) { v += shfl_xor_f(v, 1); v += shfl_xor_f(v, 2); v += shfl_xor_f(v, 4); return v; }
DI float wave_sum(float v) { v = row_sum16(v); return (shfl_f(v, 48) + shfl_f(v, 32)) + (shfl_f(v, 16) + shfl_f(v, 0)); }
#endif
DI int perm32k(int k) { const int kk = k & 31; return (k & ~31) + 8 * ((kk & 15) >> 2) + 4 * (kk >> 4) + (kk & 3); }
DI int iperm32k(int p) { const int pp = p & 31; return (p & ~31) + 16 * ((pp >> 2) & 1) + 4 * (pp >> 3) + (pp & 3); }
DI int perm16k(int k) { const int kk = k & 15; return (k & ~15) + 8 * ((kk >> 2) & 1) + 4 * (kk >> 3) + (kk & 3); }
#ifndef HOST_EMU
namespace pg8 {
#define PG8_LAS __attribute__((address_space(3)))
typedef unsigned short bf16_t;
typedef unsigned u32x4 __attribute__((ext_vector_type(4)));
constexpr int BM = 256, BK = 64, HALF = 128, HTB = HALF * BK * 2  , STAGE_BYTES = 8 * HTB, NXCD = 8, WGM = 8;

__host__ __device__ __forceinline__ int lds_byte(int r, int c) { const int st = (r >> 4) * 2 + (c >> 5), rr = r & 15, cc = c & 31, ob = rr * 64 + cc * 2; return st * 1024 + (ob ^ (((ob >> 9) & 1) << 5)); }
__host__ __device__ __forceinline__ void stage_rc(int b, int& R, int& C) { const int st = b / 1024, sb = b % 1024, swz = sb ^ (((sb >> 9) & 1) << 5); R = (st >> 1) * 16 + swz / 64; C = (st & 1) * 32 + (swz % 64) / 2; }
__host__ __device__ __forceinline__ int perm32(int rho) { const int n = rho >> 4, i = rho & 15; return 8 * (i >> 2) + 4 * n + (i & 3); }

struct Unit { int pm, pn; };
struct Gemm { const bf16_t* A; const bf16_t* Bt; int M, N, K, lda, ldb; };

struct StaticOrder {
    int nM, nN, nwg, G, c;
    __host__ __device__ void init(int M, int N, int G_, int c_) { nM = M / BM; nN = N / BM; nwg = nM * nN; G = G_; c = c_; }
    __host__ __device__ bool next(int i, Unit& u) const {
        const long L = (long)i * G + c; if (L >= nwg) return false;
        int wgid = (int)L; { const int q = nwg / NXCD, r = nwg % NXCD, xcd = wgid % NXCD, off = wgid / NXCD; wgid = (xcd < r ? xcd * (q + 1) : r * (q + 1) + (xcd - r) * q) + off; }
        const int nig = WGM * nN, gid = wgid / nig, fm = gid * WGM, gsz = (nM - fm) < WGM ? (nM - fm) : WGM;
        u.pm = fm + ((wgid % nig) % gsz); u.pn = (wgid % nig) / gsz; return true;
    }
    __device__ __forceinline__ void a_ready(const Unit&) const {}
    __device__ __forceinline__ void done(const Unit&) const {}
};

struct OneUnit {
    int pm, pn;
    __host__ __device__ bool next(int i, Unit& u) const { if (i) return false; u.pm = pm; u.pn = pn; return true; }
    __device__ __forceinline__ void a_ready(const Unit&) const {}
    __device__ __forceinline__ void done(const Unit&) const {}
};

struct ListG1 {
    int c, n;
    static constexpr int NU = 64 * 6 + 4 * 22;
    __host__ __device__ bool next(int i, Unit& u) const {
        const int U = i * n + c; if (U >= NU) return false;
        if (U < 384) { u.pm = U / 6; u.pn = 16 + U % 6; } else { const int s = U - 384; u.pm = 64 + s / 22; u.pn = s % 22; }
        return true;
    }
    __device__ __forceinline__ void a_ready(const Unit&) const {}
    __device__ __forceinline__ void done(const Unit&) const {}
};

__device__ __forceinline__ unsigned cvt_pk_bf16(float lo, float hi) { return pk2(lo, hi); }
template <class Epi, class Sched, bool ALIGN_EPI = false, bool SP2 = false>
__device__ __forceinline__ void gemm_phase(PG8_LAS unsigned char* lds, const Gemm g, const Sched& S, const Epi& E) {
    const int tid = t_id(), wid = __builtin_amdgcn_readfirstlane(tid >> 6), lane = tid & 63, wr = wid >> 2, wc = wid & 3, fr = lane & 15, fq = lane >> 4;
    const int K = g.K, nt = K / BK;
    unsigned voffA[2], voffB[2];
#pragma unroll
    for (int i = 0; i < 2; ++i) { int R, C; stage_rc(tid * 16 + i * 8192, R, C); const int Rb = Epi::PERM ? ((R & ~31) + perm32(R & 31)) : R;
        voffA[i] = (unsigned)(R * g.lda + C) * 2u; voffB[i] = (unsigned)(Rb * g.ldb + C) * 2u; }
    const size_t kstep = (size_t)(BK * 2);
    const size_t hstepA = (size_t)HALF * g.lda * 2, hstepB = (size_t)HALF * g.ldb * 2;
    const size_t tstepA = 2 * hstepA, tstepB = 2 * hstepB;
    const unsigned ldsw = (unsigned)wid * 1024u;
    const int aoff = lds_byte(wr * 64 + fr, fq * 8), boff = lds_byte(wc * 32 + fr, fq * 8);
#define PG8_SA(b, h) (((b) * 2 + (h)) * HTB)
#define PG8_SB(b, h) ((4 + (b) * 2 + (h)) * HTB)
#define PG8_STAGE(bufoff, gbase, voff) do { _Pragma("unroll") for (int _i = 0; _i < 2; ++_i) \
        __builtin_amdgcn_global_load_lds((const unsigned*)((const char*)(gbase) + (voff)[_i]), (PG8_LAS unsigned*)(lds + (bufoff) + ldsw + _i * 8192), 16, 0, 0); } while (0)
#define PG8_LDA(dst, b, h) do { _Pragma("unroll") for (int m = 0; m < 4; ++m) _Pragma("unroll") for (int k = 0; k < 2; ++k) dst[m][k] = *(const PG8_LAS bf16x8*)(lds + PG8_SA(b, h) + aoff + m * 2048 + k * 1024); } while (0)
#define PG8_LDB(dst, b, h) do { _Pragma("unroll") for (int n = 0; n < 2; ++n) _Pragma("unroll") for (int k = 0; k < 2; ++k) dst[n][k] = *(const PG8_LAS bf16x8*)(lds + PG8_SB(b, h) + boff + n * 2048 + k * 1024); } while (0)
#define PG8_MMA(ai, bj, At, Bt) do { __builtin_amdgcn_s_setprio(1); _Pragma("unroll") for (int m = 0; m < 4; ++m) _Pragma("unroll") for (int n = 0; n < 2; ++n) _Pragma("unroll") for (int k = 0; k < 2; ++k) \
        acc[ai][bj][m][n] = __builtin_amdgcn_mfma_f32_16x16x32_bf16(Bt[n][k], At[m][k], acc[ai][bj][m][n], 0, 0, 0); __builtin_amdgcn_s_setprio(0); } while (0)
#define PG8_WAIT_V(n) asm volatile("s_waitcnt vmcnt(" #n ")" ::: "memory")
#define PG8_WAIT_L(n) asm volatile("s_waitcnt lgkmcnt(" #n ")" ::: "memory")
#define PG8_BAR __builtin_amdgcn_s_barrier()
#define PG8_SCHED __builtin_amdgcn_sched_barrier(0)
    Unit cur, nxt; int ui = 0;
    if (!S.next(0, cur)) return;
    f32x4 acc[2][2][4][2];
#pragma unroll
    for (int a = 0; a < 2; ++a)
#pragma unroll
        for (int b = 0; b < 2; ++b)
#pragma unroll
            for (int m = 0; m < 4; ++m)
#pragma unroll
                for (int n = 0; n < 2; ++n) acc[a][b][m][n] = (f32x4){0.f, 0.f, 0.f, 0.f};
    bf16x8 At[4][2], B0[2][2], B1[2][2];
    const char* cA = (const char*)g.A + (size_t)cur.pm * tstepA; const char* cB = (const char*)g.Bt + (size_t)cur.pn * tstepB;
    S.a_ready(cur);
    if constexpr (SP2) {
        PG8_STAGE(PG8_SB(0, 0), cB, voffB); PG8_STAGE(PG8_SB(0, 1), cB + hstepB, voffB); PG8_STAGE(PG8_SA(0, 0), cA, voffA); PG8_STAGE(PG8_SA(0, 1), cA + hstepA, voffA);
        if (wr == 1) PG8_BAR;
        PG8_WAIT_V(2); PG8_BAR;
        PG8_STAGE(PG8_SB(1, 0), cB + kstep, voffB); PG8_STAGE(PG8_SA(1, 0), cA + kstep, voffA); PG8_STAGE(PG8_SB(1, 1), cB + hstepB + kstep, voffB);
        PG8_WAIT_V(6); PG8_BAR;
    } else {
        PG8_STAGE(PG8_SB(0, 0), cB, voffB); PG8_STAGE(PG8_SA(0, 0), cA, voffA); PG8_STAGE(PG8_SB(0, 1), cB + hstepB, voffB); PG8_STAGE(PG8_SA(0, 1), cA + hstepA, voffA);
        if (wr == 1) PG8_BAR;
        PG8_WAIT_V(4); PG8_BAR;
        PG8_STAGE(PG8_SB(1, 0), cB + kstep, voffB); PG8_STAGE(PG8_SA(1, 0), cA + kstep, voffA); PG8_STAGE(PG8_SB(1, 1), cB + hstepB + kstep, voffB);
        PG8_WAIT_V(6); PG8_BAR;
    }
    for (;;) {
        const bool has_next = S.next(ui + 1, nxt);
        const char* nA = has_next ? (const char*)g.A + (size_t)nxt.pm * tstepA : cA; const char* nB = has_next ? (const char*)g.Bt + (size_t)nxt.pn * tstepB : cB;
        for (int t = 0; t < nt; t += 2) {
            const bool last = (t == nt - 2);
            const char* a1 = cA + (size_t)(t + 1) * kstep;
            const char* a2 = last ? nA : cA + (size_t)(t + 2) * kstep; const char* b2 = last ? nB : cB + (size_t)(t + 2) * kstep;
            const char* a3 = a2 + kstep; const char* b3 = b2 + kstep;
            if (last && has_next) S.a_ready(nxt);
            if constexpr (SP2) {
            PG8_LDB(B0, 0, 0); PG8_LDB(B1, 0, 1); PG8_SCHED; PG8_LDA(At, 0, 0); PG8_STAGE(PG8_SA(1, 1), a1 + hstepA, voffA);
            PG8_WAIT_V(8); PG8_WAIT_L(0); PG8_BAR; PG8_MMA(0, 0, At, B0); PG8_MMA(0, 1, At, B1); PG8_BAR; PG8_SCHED;
            PG8_LDA(At, 0, 1); PG8_STAGE(PG8_SB(0, 0), b2, voffB); PG8_STAGE(PG8_SB(0, 1), b2 + hstepB, voffB); PG8_STAGE(PG8_SA(0, 0), a2, voffA);
            PG8_WAIT_V(8); PG8_WAIT_L(0); PG8_BAR; PG8_MMA(1, 0, At, B0); PG8_MMA(1, 1, At, B1); PG8_BAR; PG8_SCHED;
            PG8_LDB(B0, 1, 0); PG8_LDB(B1, 1, 1); PG8_SCHED; PG8_LDA(At, 1, 0); PG8_STAGE(PG8_SA(0, 1), a2 + hstepA, voffA);
            PG8_WAIT_V(8); PG8_WAIT_L(0); PG8_BAR; PG8_MMA(0, 0, At, B0); PG8_MMA(0, 1, At, B1); PG8_BAR; PG8_SCHED;
            PG8_LDA(At, 1, 1); PG8_STAGE(PG8_SB(1, 0), b3, voffB); PG8_STAGE(PG8_SB(1, 1), b3 + hstepB, voffB); PG8_STAGE(PG8_SA(1, 0), a3, voffA);
            PG8_WAIT_V(8); PG8_WAIT_L(0); PG8_BAR; PG8_MMA(1, 0, At, B0); PG8_MMA(1, 1, At, B1); PG8_BAR; PG8_SCHED;
            } else {
            PG8_LDB(B0, 0, 0); PG8_SCHED; PG8_LDA(At, 0, 0); PG8_STAGE(PG8_SA(1, 1), a1 + hstepA, voffA);
            PG8_WAIT_L(8); PG8_BAR; PG8_WAIT_L(0); PG8_MMA(0, 0, At, B0); PG8_BAR; PG8_SCHED;
            PG8_LDB(B1, 0, 1); PG8_STAGE(PG8_SB(0, 0), b2, voffB);
            PG8_BAR; PG8_WAIT_L(0); PG8_MMA(0, 1, At, B1); PG8_BAR;
            PG8_LDA(At, 0, 1); PG8_STAGE(PG8_SA(0, 0), a2, voffA);
            PG8_BAR; PG8_WAIT_L(0); PG8_MMA(1, 0, At, B0); PG8_BAR; PG8_SCHED;
            PG8_STAGE(PG8_SB(0, 1), b2 + hstepB, voffB);
            PG8_WAIT_V(6); PG8_BAR; PG8_MMA(1, 1, At, B1); PG8_BAR;
            PG8_LDB(B0, 1, 0); PG8_SCHED; PG8_LDA(At, 1, 0); PG8_STAGE(PG8_SA(0, 1), a2 + hstepA, voffA);
            PG8_WAIT_L(8); PG8_BAR; PG8_WAIT_L(0); PG8_MMA(0, 0, At, B0); PG8_BAR; PG8_SCHED;
            PG8_LDB(B1, 1, 1); PG8_STAGE(PG8_SB(1, 0), b3, voffB);
            PG8_BAR; PG8_WAIT_L(0); PG8_MMA(0, 1, At, B1); PG8_BAR;
            PG8_LDA(At, 1, 1); PG8_STAGE(PG8_SA(1, 0), a3, voffA);
            PG8_BAR; PG8_WAIT_L(0); PG8_MMA(1, 0, At, B0); PG8_BAR; PG8_SCHED;
            PG8_STAGE(PG8_SB(1, 1), b3 + hstepB, voffB);
            PG8_WAIT_V(6); PG8_BAR; PG8_MMA(1, 1, At, B1); PG8_BAR;
            }
        }
        if constexpr (ALIGN_EPI) { if (wr == 0) PG8_BAR; }
        if constexpr (!Epi::AFTER_DRAIN) { E(acc, cur, wr, wc, fr, fq); S.done(cur); }
        if (!has_next) break;
#pragma unroll
        for (int a = 0; a < 2; ++a)
#pragma unroll
            for (int b = 0; b < 2; ++b)
#pragma unroll
                for (int m = 0; m < 4; ++m)
#pragma unroll
                    for (int n = 0; n < 2; ++n) acc[a][b][m][n] = (f32x4){0.f, 0.f, 0.f, 0.f};
        cur = nxt; cA = nA; cB = nB; ++ui;
        if constexpr (ALIGN_EPI) { if (wr == 1) PG8_BAR; }
    }
    PG8_WAIT_V(0);
    if constexpr (!ALIGN_EPI) { if (wr == 0) PG8_BAR; }
    PG8_BAR;
    if constexpr (Epi::AFTER_DRAIN) { E.fused(acc, cur, wr, wc, fr, fq, lds, wid, lane); S.done(cur); }
#undef PG8_SA
#undef PG8_SB
#undef PG8_STAGE
#undef PG8_LDA
#undef PG8_LDB
#undef PG8_MMA
#undef PG8_WAIT_V
#undef PG8_WAIT_L
#undef PG8_BAR
#undef PG8_SCHED
}
}
#define GAS __attribute__((address_space(1)))
#define LAS __attribute__((address_space(3)))
typedef unsigned short bf16;
typedef unsigned v4u __attribute__((ext_vector_type(4)));
typedef float f32x4 __attribute__((ext_vector_type(4)));
typedef short bf16x8 __attribute__((ext_vector_type(8)));
typedef GAS unsigned gu32;
typedef GAS unsigned long long gu64;
#define RLX_AGENT __ATOMIC_RELAXED, __HIP_MEMORY_SCOPE_AGENT
#define LDS_WAIT() asm volatile("s_waitcnt lgkmcnt(0)" ::: "memory")
#define VM_WAIT() asm volatile("s_waitcnt vmcnt(0)" ::: "memory")
__device__ __forceinline__ unsigned long long rt() { return __builtin_amdgcn_s_memrealtime(); }

#define XB_TMO      128
#define XB_XCNT(j)  (256  + 64 * (j))
#define XB_XSUB(j)  (1280 + 64 * (j))
#define XB_XGEN(j)  (2304 + 64 * (j))
#define XB_TOP      3328
#define XB_TOPGEN   3392
#define XCD_BAR_WORDS 3456
#define XB_SPIN_CAP (1u << 18)

__device__ __forceinline__ unsigned xb_ld(unsigned* p)              { return __hip_atomic_load(p, __ATOMIC_RELAXED, __HIP_MEMORY_SCOPE_AGENT); }
__device__ __forceinline__ unsigned xb_add(unsigned* p, unsigned v) { return __hip_atomic_fetch_add(p, v, __ATOMIC_RELAXED, __HIP_MEMORY_SCOPE_AGENT); }
__device__ __forceinline__ unsigned xb_xcc_id() { return (unsigned)__builtin_amdgcn_s_getreg((3 << 11) | 20) & 0xFu; }
#define XB_SPIN(cond, bar) do { unsigned _sp = 0; while (cond) { __builtin_amdgcn_s_sleep(1); \
    if ((++_sp & 255u) == 0u) { if (xb_ld(&(bar)[XB_TMO])) break; if (_sp > XB_SPIN_CAP) { atomicAdd(&(bar)[XB_TMO], 1u); break; } } } } while (0)

struct XcdBarrier {
    unsigned* bar; unsigned x;
    volatile LAS unsigned* st;
};

__device__ __forceinline__ XcdBarrier xcd_barrier_post(unsigned* bar, volatile LAS unsigned* st) {
    XcdBarrier b; b.bar = bar; b.x = xb_xcc_id(); b.st = st;
    if (threadIdx.x == 0) (void)xb_add(&bar[XB_XCNT(b.x)], 1u);
    return b;
}
__device__ __forceinline__ void xcd_barrier_complete(unsigned* bar, unsigned x, unsigned& nloc, unsigned& nx) {
    const unsigned G = gridDim.x * gridDim.y * gridDim.z;
    unsigned sum, cnt, mine, sp = 0u;
    for (;;) {
        sum = 0u; cnt = 0u; mine = 0u;
#pragma unroll
        for (unsigned j = 0; j < 16; ++j) { const unsigned c = xb_ld(&bar[XB_XCNT(j)]); sum += c; cnt += (c > 0u) ? 1u : 0u; mine = (j == x) ? c : mine; }
        if (sum == G) break;
        __builtin_amdgcn_s_sleep(1);
        if ((++sp & 255u) == 0u) { if (xb_ld(&bar[XB_TMO])) break; if (sp > XB_SPIN_CAP) { atomicAdd(&bar[XB_TMO], 1u); break; } }
    }
    nloc = mine > 0u ? mine : 1u; nx = cnt > 0u ? cnt : 1u;
}

__device__ __forceinline__ void xcd_barrier(const XcdBarrier& b) {
    asm volatile("s_waitcnt vmcnt(0)" ::: "memory");
    __syncthreads();
    if (threadIdx.x == 0) {
        unsigned* bar = b.bar;
        __builtin_amdgcn_s_waitcnt(0);
        unsigned nloc = b.st[0], nx = b.st[1];
        if (nloc == 0u) { xcd_barrier_complete(bar, b.x, nloc, nx); b.st[0] = nloc; b.st[1] = nx; }
        const unsigned old = xb_add(&bar[XB_XSUB(b.x)], 1u);
        const unsigned gen = old / nloc;
        if (old + 1u == (gen + 1u) * nloc) {
            __builtin_amdgcn_fence(__ATOMIC_RELEASE, "agent");
            asm volatile("s_waitcnt vmcnt(0)" ::: "memory");
            const unsigned og = xb_add(&bar[XB_TOP], 1u);
            const unsigned tg = og / nx;
            if (og + 1u == (tg + 1u) * nx) xb_add(&bar[XB_TOPGEN], 1u);
            else XB_SPIN(xb_ld(&bar[XB_TOPGEN]) == tg, bar);
            __builtin_amdgcn_fence(__ATOMIC_ACQUIRE, "agent");
            xb_add(&bar[XB_XGEN(b.x)], 1u);
            asm volatile("s_waitcnt vmcnt(0)" ::: "memory");
        } else {
            XB_SPIN(xb_ld(&bar[XB_XGEN(b.x)]) == gen, bar);
            __builtin_amdgcn_fence(__ATOMIC_ACQUIRE, "agent");
            asm volatile("s_waitcnt vmcnt(0)" ::: "memory");
        }
    }
    __syncthreads();
}
#endif
struct DnPtrs {
    const bf16* QKV; const bf16* HALO; const float* BA; const float* conv_w; const float* a_log; const float* dt_bias; const float* dn_norm;
    bf16* WB; bf16* QD; bf16* KDT; unsigned* UB; bf16* AB; float* DL;
    const bf16* Z; bf16* OCAT; float* DSP;
    const float* state_delta; const float* state_conv; float* DSS;
};
namespace dn {
using namespace cfg;
constexpr int QN_LD = 136, TB_LD = 72, LM_LD = 68;
constexpr int L_QN = 0, L_KN = L_QN + 64 * QN_LD * 2, L_VBT = L_KN + 64 * QN_LD * 2, L_KBGT = L_VBT + 128 * TB_LD * 2, L_KDT = L_KBGT + 128 * TB_LD * 2,
              L_LM = L_KDT + 128 * 64 * 2, L_TM = L_LM + 64 * LM_LD * 4, L_TB = L_TM + 64 * LM_LD * 4, L_GC = L_TB + 64 * TB_LD * 2, L_BETA = L_GC + 256, L_PREP_END = L_BETA + 256;
static_assert(L_PREP_END <= P2_LDS, "prep LDS");

DI float softplus_f(float x) { return (x > 0.f ? x : 0.f) + log1pf(expf(-fabsf(x))); }

struct PrepRaw { unsigned q[11], k[11], v[11]; float ba0, ba1; };
DI void prep_fetch(const DnPtrs& P, PrepRaw& R, int b, int h, int n) {
    const int tid = t_id(), w = wave_id(), l = tid & 63;
    const int row0 = b * SEQ + n * CH, gch = row0 >> 6, c0 = iperm32k(2 * l);
    const float* ba = P.BA + (size_t)(row0 + l) * 16;
    R.ba0 = ba[h]; R.ba1 = ba[8 + h];
#pragma unroll
    for (int i = 0; i < 11; ++i) {
        const int rt = 8 * w - 3 + i;
        unsigned uq = 0, uk = 0, uv = 0;
        if (rt >= 0) { const bf16* p = P.QKV + (size_t)(row0 + rt) * QKVW + h * 128 + c0; uq = *(const unsigned*)p; uk = *(const unsigned*)(p + 1024); uv = *(const unsigned*)(p + 2048); }
        else if (n > 0) { const bf16* p = P.HALO + ((size_t)(gch - 1) * 3 + (rt + 3)) * QKVW + h * 128 + c0; uq = *(const unsigned*)p; uk = *(const unsigned*)(p + 1024); uv = *(const unsigned*)(p + 2048); }
        R.q[i] = uq; R.k[i] = uk; R.v[i] = uv;
    }
}
DI void prep_item(LP(unsigned char) lds, const DnPtrs& P, int b, int h, int n, PrepRaw& R, bool more, int bn, int hn, int nn) {
    const int tid = t_id(), w = wave_id(), l = tid & 63, fr = l & 15, fq = l >> 4;
    const int row0 = b * SEQ + n * CH, it = (b * H + h) * NCH + n, gch = row0 >> 6;
    LP(bf16) QN = (LP(bf16))(lds + L_QN); LP(bf16) KN = (LP(bf16))(lds + L_KN); LP(bf16) VBT = (LP(bf16))(lds + L_VBT); LP(bf16) KBGT = (LP(bf16))(lds + L_KBGT);
    LP(bf16) KDTl = (LP(bf16))(lds + L_KDT); LP(float) LM = (LP(float))(lds + L_LM); LP(float) TM = (LP(float))(lds + L_TM); LP(bf16) TB = (LP(bf16))(lds + L_TB);
    LP(float) GC = (LP(float))(lds + L_GC); LP(float) BETA = (LP(float))(lds + L_BETA);
    wg_sync();
#ifndef DUPP
#define DUPP 0
#endif
    float beta_t, gc_t;
    {
        beta_t = 1.0f / (1.0f + expf(-R.ba0));
        const float g = -expf(P.a_log[h]) * softplus_f(R.ba1 + P.dt_bias[h]);
        gc_t = g;
#pragma unroll
        for (int o = 1; o < 64; o <<= 1) { const float up = shfl_f(gc_t, (l - o) & 63); if (l >= o) gc_t += up; }
        if (w == 0) { GC[l] = gc_t; BETA[l] = beta_t; }
    }
    const float gc_last = lane_bcast(gc_t, 63);
    {
        const int c0 = iperm32k(2 * l);
        float wq[4][2], wk[4][2], wv[4][2];
#pragma unroll
        for (int i = 0; i < 4; ++i)
#pragma unroll
            for (int e = 0; e < 2; ++e) { wq[i][e] = P.conv_w[i * QKVW + h * 128 + c0 + e]; wk[i][e] = P.conv_w[i * QKVW + 1024 + h * 128 + c0 + e]; wv[i][e] = P.conv_w[i * QKVW + 2048 + h * 128 + c0 + e]; }
        float xq[11][2], xk[11][2], xv[11][2];
#pragma unroll
        for (int i = 0; i < 11; ++i) { xq[i][0] = bf_lo(R.q[i]); xq[i][1] = bf_hi(R.q[i]); xk[i][0] = bf_lo(R.k[i]); xk[i][1] = bf_hi(R.k[i]); xv[i][0] = bf_lo(R.v[i]); xv[i][1] = bf_hi(R.v[i]); }
        if (more) prep_fetch(P, R, bn, hn, nn);
        float kbg_prev[2] = {0.f, 0.f}, kd_prev[2] = {0.f, 0.f}, vb_prev[2] = {0.f, 0.f};
#pragma unroll
        for (int j = 0; j < 8; ++j) {
            const int t = 8 * w + j;
            float q[2], k[2], v[2];
#pragma unroll
            for (int e = 0; e < 2; ++e) {
                q[e] = silu_f(xq[j][e] * wq[0][e] + xq[j + 1][e] * wq[1][e] + xq[j + 2][e] * wq[2][e] + xq[j + 3][e] * wq[3][e]);
                k[e] = silu_f(xk[j][e] * wk[0][e] + xk[j + 1][e] * wk[1][e] + xk[j + 2][e] * wk[2][e] + xk[j + 3][e] * wk[3][e]);
                v[e] = silu_f(xv[j][e] * wv[0][e] + xv[j + 1][e] * wv[1][e] + xv[j + 2][e] * wv[2][e] + xv[j + 3][e] * wv[3][e]);
            }
            const float sq = wave_sum(q[0] * q[0] + q[1] * q[1]), sk = wave_sum(k[0] * k[0] + k[1] * k[1]);
            const float rq = frsq(sq + L2_EPS), rk = frsq(sk + L2_EPS);
            const float bt = lane_bcast(beta_t, t), gt = lane_bcast(gc_t, t);
            const float eg = fexp2(LOG2E * gt), egl = fexp2(LOG2E * (gc_last - gt));
            q[0] *= rq; q[1] *= rq; k[0] *= rk; k[1] *= rk;
            *(LP(unsigned))(QN + t * QN_LD + 2 * l) = pk2(q[0], q[1]);
            *(LP(unsigned))(KN + t * QN_LD + 2 * l) = pk2(k[0], k[1]);
            *(unsigned*)(P.QD + (size_t)(row0 + t) * D + h * 128 + 2 * l) = pk2(q[0] * eg * QSCALE_DN, q[1] * eg * QSCALE_DN);
            const float kbg[2] = {k[0] * bt * eg, k[1] * bt * eg}, kd[2] = {k[0] * egl, k[1] * egl}, vb[2] = {v[0] * bt, v[1] * bt};
            if (j & 1) {
#pragma unroll
                for (int e = 0; e < 2; ++e) {
                    *(LP(unsigned))(KBGT + (c0 + e) * TB_LD + (t - 1)) = pk2(kbg_prev[e], kbg[e]);
                    *(LP(unsigned))(VBT + (c0 + e) * TB_LD + (t - 1)) = pk2(vb_prev[e], vb[e]);
                    *(LP(unsigned))(KDTl + (c0 + e) * 64 + perm32k(t - 1)) = pk2(kd_prev[e], kd[e]);
                }
            }
            kbg_prev[0] = kbg[0]; kbg_prev[1] = kbg[1]; kd_prev[0] = kd[0]; kd_prev[1] = kd[1]; vb_prev[0] = vb[0]; vb_prev[1] = vb[1];
        }
    }
    wg_sync_lds();
    {
        const int s = w >> 2;
        {
            const int in = w & 3;
            f32x4 acc[2] = {{0.f, 0.f, 0.f, 0.f}, {0.f, 0.f, 0.f, 0.f}};
            bf16x8 qf[4], kf[2][4];
#pragma unroll
            for (int ks = 0; ks < 4; ++ks) qf[ks] = *(LP(bf16x8))(QN + (16 * in + fr) * QN_LD + 32 * ks + 8 * fq);
#pragma unroll
            for (int mm = 0; mm < 2; ++mm) if (in >= 2 * s + mm) {
#pragma unroll
                for (int ks = 0; ks < 4; ++ks) kf[mm][ks] = *(LP(bf16x8))(KN + (16 * (2 * s + mm) + fr) * QN_LD + 32 * ks + 8 * fq); }
#pragma unroll
            for (int mm = 0; mm < 2; ++mm) if (in >= 2 * s + mm) {
#pragma unroll
                for (int ks = 0; ks < 4; ++ks) acc[mm] = mfma16(kf[mm][ks], qf[ks], acc[mm]); }
            const int ti = 16 * in + fr; const float gi = GC[ti];
            float o[8];
#pragma unroll
            for (int mm = 0; mm < 2; ++mm)
#pragma unroll
                for (int r = 0; r < 4; ++r) { const int tj = 32 * s + 16 * mm + 4 * fq + r; o[4 * mm + r] = (ti >= tj) ? acc[mm][r] * fexp2(LOG2E * (gi - GC[tj])) * QSCALE_DN : 0.f; }
            u32x4 pk; pk.x = pk2(o[0], o[1]); pk.y = pk2(o[2], o[3]); pk.z = pk2(o[4], o[5]); pk.w = pk2(o[6], o[7]);
            *(u32x4*)(P.AB + (size_t)it * 4096 + ti * 64 + 32 * s + 8 * fq) = pk;
        }
        const int im = w >> 1;
        bf16x8 ka[4], kb[2][4];
#pragma unroll
        for (int ks = 0; ks < 4; ++ks) ka[ks] = *(LP(bf16x8))(KN + (16 * im + fr) * QN_LD + 32 * ks + 8 * fq);
#pragma unroll
        for (int jj = 0; jj < 2; ++jj) if (2 * (w & 1) + jj <= im) {
#pragma unroll
            for (int ks = 0; ks < 4; ++ks) kb[jj][ks] = *(LP(bf16x8))(KN + (16 * (2 * (w & 1) + jj) + fr) * QN_LD + 32 * ks + 8 * fq); }
#pragma unroll
        for (int jj = 0; jj < 2; ++jj) {
            const int jn = 2 * (w & 1) + jj;
            if (jn <= im) {
                f32x4 acc = {0.f, 0.f, 0.f, 0.f};
#pragma unroll
                for (int ks = 0; ks < 4; ++ks) acc = mfma16(ka[ks], kb[jj][ks], acc);
                const int tj = 16 * jn + fr; const float gj = GC[tj];
#pragma unroll
                for (int r = 0; r < 4; ++r) { const int ti = 16 * im + 4 * fq + r; LM[ti * LM_LD + tj] = (ti > tj) ? BETA[ti] * acc[r] * fexp2(LOG2E * (GC[ti] - gj)) : 0.f; }
            }
        }
    }
    wg_sync_lds();
    {
    if (w == 0) {
        const int I = fq, c = fr;
        f32x4 Lr[16][4];
#pragma unroll
        for (int r = 1; r < 16; ++r)
#pragma unroll
            for (int ch = 0; ch < 4; ++ch) if (4 * ch < r) Lr[r][ch] = *(LP(f32x4))(LM + (16 * I + r) * LM_LD + 16 * I + 4 * ch);
        float X[16];
#pragma unroll
        for (int r = 0; r < 16; ++r) {
            float a = (c == r) ? 1.f : 0.f;
#pragma unroll
            for (int j = 0; j < r; ++j) a -= Lr[r][j >> 2][j & 3] * X[j];
            X[r] = a;
        }
#pragma unroll
        for (int r = 0; r < 16; ++r) TM[(16 * I + r) * LM_LD + 16 * I + c] = X[r];
    }
    wg_sync_lds();
#pragma unroll
    for (int lev = 1; lev <= 3; ++lev) {
        if (w < 4 - lev) {
            const int J = w, I = w + lev;
            f32x4 la[3], tb[3], dd;
#pragma unroll
            for (int kk = 0; kk < 3; ++kk) if (kk < lev) { const int K = J + kk;
                la[kk] = *(LP(f32x4))(LM + (16 * I + fr) * LM_LD + 16 * K + 4 * fq);
#pragma unroll
                for (int s = 0; s < 4; ++s) tb[kk][s] = TM[(16 * K + 4 * fq + s) * LM_LD + 16 * J + fr]; }
            dd = *(LP(f32x4))(TM + (16 * I + fr) * LM_LD + 16 * I + 4 * fq);
            f32x4 y = {0.f, 0.f, 0.f, 0.f};
#pragma unroll
            for (int kk = 0; kk < 3; ++kk) if (kk < lev) {
#pragma unroll
                for (int s = 0; s < 4; ++s) y = mfma16f(la[kk][s], tb[kk][s], y); }
            f32x4 x = {0.f, 0.f, 0.f, 0.f};
#pragma unroll
            for (int s = 0; s < 4; ++s) x = mfma16f(dd[s], y[s], x);
#pragma unroll
            for (int r = 0; r < 4; ++r) TM[(16 * I + 4 * fq + r) * LM_LD + 16 * J + fr] = -x[r];
        }
        wg_sync_lds();
    }
    }
    {
        const int i = tid >> 3, j0 = (tid & 7) * 8;
        float v[8];
#pragma unroll
        for (int e = 0; e < 8; ++e) v[e] = ((j0 >> 4) <= (i >> 4)) ? TM[i * LM_LD + j0 + e] : 0.f;
        u32x4 pk; pk.x = pk2(v[0], v[1]); pk.y = pk2(v[2], v[3]); pk.z = pk2(v[4], v[5]); pk.w = pk2(v[6], v[7]);
        *(LP(u32x4))(TB + i * TB_LD + j0) = pk;
    }
    wg_sync_lds();
    {
        f32x4 u[4];
        bf16x8 tf[4][2], vf[2], kbf[2][2], tbf[2][2];
        const int s = w >> 1;
#pragma unroll
        for (int ks = 0; ks < 2; ++ks) { vf[ks] = *(LP(bf16x8))(VBT + (16 * w + fr) * TB_LD + 32 * ks + 8 * fq);
#pragma unroll
            for (int i = 0; i < 4; ++i) if (ks == 0 || i >= 2) tf[i][ks] = *(LP(bf16x8))(TB + (16 * i + fr) * TB_LD + 32 * ks + 8 * fq);
#pragma unroll
            for (int mm = 0; mm < 2; ++mm) kbf[mm][ks] = *(LP(bf16x8))(KBGT + (32 * s + 16 * mm + fr) * TB_LD + 32 * ks + 8 * fq);
#pragma unroll
            for (int nn = 0; nn < 2; ++nn) tbf[nn][ks] = *(LP(bf16x8))(TB + (16 * (2 * (w & 1) + nn) + fr) * TB_LD + 32 * ks + 8 * fq); }
#pragma unroll
        for (int i = 0; i < 4; ++i) {
            u[i] = (f32x4){0.f, 0.f, 0.f, 0.f};
#pragma unroll
            for (int ks = 0; ks < 2; ++ks) if (ks == 0 || i >= 2) u[i] = mfma16(tf[i][ks], vf[ks], u[i]);
            unsigned* ub = P.UB + (size_t)it * 4096 + ((w * 4 + i) * 2) * 64 + l;
            ub[0] = pk2(u[i][0], u[i][1]); ub[64] = pk2(u[i][2], u[i][3]);
        }
#pragma unroll
        for (int nn = 0; nn < 2; ++nn) {
            const int nt = 2 * (w & 1) + nn;
            f32x4 acc[2] = {{0.f, 0.f, 0.f, 0.f}, {0.f, 0.f, 0.f, 0.f}};
#pragma unroll
            for (int mm = 0; mm < 2; ++mm)
#pragma unroll
                for (int ks = 0; ks < 2; ++ks) if (ks == 0 || nt >= 2) acc[mm] = mfma16(kbf[mm][ks], tbf[nn][ks], acc[mm]);
            u32x4 pk; pk.x = pk2(acc[0][0], acc[0][1]); pk.y = pk2(acc[0][2], acc[0][3]); pk.z = pk2(acc[1][0], acc[1][1]); pk.w = pk2(acc[1][2], acc[1][3]);
            *(u32x4*)(P.WB + (size_t)(row0 + 16 * nt + fr) * D + h * 128 + 32 * s + 8 * fq) = pk;
        }
#pragma unroll
        for (int e = 0; e < 2; ++e) { const int o = (tid + 512 * e) * 8; *(u32x4*)(P.KDT + (size_t)it * 8192 + o) = *(LP(u32x4))(KDTl + o); }
        if (tid == 0) P.DL[it] = expf(gc_last);
    }
}

constexpr int W_LD = 136, A_LD = 72;
constexpr int SB_W = 0, SB_Q = SB_W + 64 * W_LD * 2, SB_A = SB_Q + 64 * W_LD * 2, SB_KD = SB_A + 64 * A_LD * 2, SB_SIZE = SB_KD + 128 * A_LD * 2;
constexpr int L_PL = 2 * SB_SIZE, L_RL = L_PL + 8 * 64 * 4, L_OL = L_RL + 64 * 4, L_SCAN_END = L_OL + 64 * W_LD * 2;
static_assert(L_SCAN_END <= P2_LDS, "scan LDS");
DI bf16x8 pack8(const f32x4& a, const f32x4& b) { u32x4 p; p.x = pk2(a[0], a[1]); p.y = pk2(a[2], a[3]); p.z = pk2(b[0], b[1]); p.w = pk2(b[2], b[3]); return __builtin_bit_cast(bf16x8, p); }

DI void scan_item(LP(unsigned char) lds, const DnPtrs& P, int b, int h) {
    const int tid = t_id(), w = wave_id(), l = tid & 63, fr = l & 15, fq = l >> 4;
    const int it0 = (b * H + h) * NCH;
    LP(float) PL = (LP(float))(lds + L_PL); LP(float) RL = (LP(float))(lds + L_RL); LP(bf16) OL = (LP(bf16))(lds + L_OL);
    f32x4 S[8];
#pragma unroll
    for (int m = 0; m < 8; ++m) S[m] = (f32x4){0.f, 0.f, 0.f, 0.f};
    u32x4 pw[2], pq[2], pa, pkd[2], pz[2], zcur[2]; unsigned pu[8], ucur[8]; float pdl, dlcur;
    const float dnn = P.dn_norm[16 * w + fr];
#define DN_LOAD(n_) do { const int it_ = it0 + (n_); const size_t r0_ = (size_t)(b * SEQ + (n_) * CH); \
        _Pragma("unroll") for (int e = 0; e < 2; ++e) { const int p_ = tid + 512 * e; \
            pw[e] = *(const u32x4*)(P.WB + (r0_ + (p_ >> 4)) * D + h * 128 + (p_ & 15) * 8); pq[e] = *(const u32x4*)(P.QD + (r0_ + (p_ >> 4)) * D + h * 128 + (p_ & 15) * 8); \
            pkd[e] = *(const u32x4*)(P.KDT + (size_t)it_ * 8192 + (p_ >> 3) * 64 + (p_ & 7) * 8); \
            pz[e] = *(const u32x4*)(P.Z + (r0_ + (p_ >> 4)) * D + h * 128 + (p_ & 15) * 8); } \
        pa = *(const u32x4*)(P.AB + (size_t)it_ * 4096 + (tid >> 3) * 64 + (tid & 7) * 8); \
        _Pragma("unroll") for (int e = 0; e < 8; ++e) pu[e] = P.UB[(size_t)it_ * 4096 + (w * 8 + e) * 64 + l]; \
        pdl = P.DL[it_]; } while (0)
#define DN_STORE(buf_) do { LP(unsigned char) sb_ = lds + (buf_) * SB_SIZE; \
        _Pragma("unroll") for (int e = 0; e < 2; ++e) { const int p_ = tid + 512 * e; \
            *(LP(u32x4))(sb_ + SB_W + ((p_ >> 4) * W_LD + (p_ & 15) * 8) * 2) = pw[e]; *(LP(u32x4))(sb_ + SB_Q + ((p_ >> 4) * W_LD + (p_ & 15) * 8) * 2) = pq[e]; \
            *(LP(u32x4))(sb_ + SB_KD + ((p_ >> 3) * A_LD + (p_ & 7) * 8) * 2) = pkd[e]; } \
        *(LP(u32x4))(sb_ + SB_A + ((tid >> 3) * A_LD + (tid & 7) * 8) * 2) = pa; } while (0)
    wg_sync();
    DN_LOAD(0); DN_STORE(0);
#pragma unroll
    for (int e = 0; e < 8; ++e) ucur[e] = pu[e];
    zcur[0] = pz[0]; zcur[1] = pz[1]; dlcur = pdl;
    wg_sync();
    DN_LOAD(1);
    for (int n = 0; n < NCH; ++n) {
        const size_t row0 = (size_t)(b * SEQ + n * CH);
        LP(unsigned char) sb = lds + (n & 1) * SB_SIZE;
        LP(bf16) Wl = (LP(bf16))(sb + SB_W); LP(bf16) Ql = (LP(bf16))(sb + SB_Q); LP(bf16) Al = (LP(bf16))(sb + SB_A); LP(bf16) KDl = (LP(bf16))(sb + SB_KD);
        const float dl = dlcur;
        bf16x8 Bs[4];
#pragma unroll
        for (int ks = 0; ks < 4; ++ks) Bs[ks] = pack8(S[2 * ks], S[2 * ks + 1]);
        bf16x8 fa[8], fb[8];
#define FR128(dst, base, ld, t0) do { _Pragma("unroll") for (int ii = 0; ii < 2; ++ii) _Pragma("unroll") for (int ks = 0; ks < 4; ++ks) \
            dst[4 * ii + ks] = *(LP(bf16x8))((base) + (16 * ((t0) + ii) + fr) * (ld) + 32 * ks + 8 * fq); } while (0)
#define FR64(dst, base, ld, t0) do { _Pragma("unroll") for (int ii = 0; ii < 4; ++ii) _Pragma("unroll") for (int s2 = 0; s2 < 2; ++s2) \
            dst[2 * ii + s2] = *(LP(bf16x8))((base) + (16 * ((t0) + ii) + fr) * (ld) + 32 * s2 + 8 * fq); } while (0)
        FR128(fa, Wl, W_LD, 0); FR128(fb, Wl, W_LD, 2);
        f32x4 vn[4], o[4];
#pragma unroll
        for (int ii = 0; ii < 2; ++ii) { f32x4 acc = {0.f, 0.f, 0.f, 0.f};
#pragma unroll
            for (int ks = 0; ks < 4; ++ks) acc = mfma16(fa[4 * ii + ks], Bs[ks], acc);
            vn[ii] = acc; }
        FR128(fa, Ql, W_LD, 0);
#pragma unroll
        for (int ii = 0; ii < 2; ++ii) { f32x4 acc = {0.f, 0.f, 0.f, 0.f};
#pragma unroll
            for (int ks = 0; ks < 4; ++ks) acc = mfma16(fb[4 * ii + ks], Bs[ks], acc);
            vn[2 + ii] = acc; }
        FR128(fb, Ql, W_LD, 2);
#pragma unroll
        for (int i = 0; i < 4; ++i) { vn[i][0] = bf_lo(ucur[2 * i]) - vn[i][0]; vn[i][1] = bf_hi(ucur[2 * i]) - vn[i][1]; vn[i][2] = bf_lo(ucur[2 * i + 1]) - vn[i][2]; vn[i][3] = bf_hi(ucur[2 * i + 1]) - vn[i][3]; }
        bf16x8 Bv[2];
        Bv[0] = pack8(vn[0], vn[1]); Bv[1] = pack8(vn[2], vn[3]);
#pragma unroll
        for (int ii = 0; ii < 2; ++ii) { f32x4 acc = {0.f, 0.f, 0.f, 0.f};
#pragma unroll
            for (int ks = 0; ks < 4; ++ks) acc = mfma16(fa[4 * ii + ks], Bs[ks], acc);
            o[ii] = acc; }
        FR64(fa, Al, A_LD, 0);
#pragma unroll
        for (int ii = 0; ii < 2; ++ii) { f32x4 acc = {0.f, 0.f, 0.f, 0.f};
#pragma unroll
            for (int ks = 0; ks < 4; ++ks) acc = mfma16(fb[4 * ii + ks], Bs[ks], acc);
            o[2 + ii] = acc; }
        FR64(fb, KDl, A_LD, 0);
#pragma unroll
        for (int i = 0; i < 4; ++i)
#pragma unroll
            for (int s2 = 0; s2 < 2; ++s2) if (s2 == 0 || i >= 2) o[i] = mfma16(fa[2 * i + s2], Bv[s2], o[i]);
        FR64(fa, KDl, A_LD, 4);
#pragma unroll
        for (int m = 0; m < 4; ++m) { f32x4 acc = S[m] * dl;
#pragma unroll
            for (int s2 = 0; s2 < 2; ++s2) acc = mfma16(fb[2 * m + s2], Bv[s2], acc);
            S[m] = acc; }
#pragma unroll
        for (int m = 0; m < 4; ++m) { f32x4 acc = S[4 + m] * dl;
#pragma unroll
            for (int s2 = 0; s2 < 2; ++s2) acc = mfma16(fa[2 * m + s2], Bv[s2], acc);
            S[4 + m] = acc; }
#undef FR128
#undef FR64
#ifdef PROBE_XBAR
        wg_sync_lds();
#endif
#pragma unroll
        for (int i = 0; i < 4; ++i)
#pragma unroll
            for (int r = 0; r < 4; ++r) { const float s = row_sum16(o[i][r] * o[i][r]); if (fr == 0) PL[w * 64 + 16 * i + 4 * fq + r] = s; }
        wg_sync_lds();
        {
            const int tok = 8 * w + (l >> 3);
            const float s = row_sum8(PL[(l & 7) * 64 + tok]);
            if ((l & 7) == 0) RL[tok] = 1.0f / sqrtf(s * (1.0f / 128.0f) + RMS_EPS);
        }
        if (n + 1 < NCH) DN_STORE((n + 1) & 1);
        wg_sync_lds();
#pragma unroll
        for (int i = 0; i < 4; ++i)
#pragma unroll
            for (int r = 0; r < 4; ++r) { const int tok = 16 * i + 4 * fq + r; OL[tok * W_LD + 16 * w + fr] = (bf16)f2bf(o[i][r] * RL[tok] * dnn); }
        wg_sync_lds();
#pragma unroll
        for (int e = 0; e < 2; ++e) {
            const int p = tid + 512 * e, row = p >> 4, c8 = (p & 15) * 8;
            const u32x4 ov = *(LP(u32x4))(OL + row * W_LD + c8);
            const u32x4 zv = zcur[e];
            u32x4 r;
            r.x = pk2(bf_lo(ov.x) * bf_lo(zv.x), bf_hi(ov.x) * bf_hi(zv.x)); r.y = pk2(bf_lo(ov.y) * bf_lo(zv.y), bf_hi(ov.y) * bf_hi(zv.y));
            r.z = pk2(bf_lo(ov.z) * bf_lo(zv.z), bf_hi(ov.z) * bf_hi(zv.z)); r.w = pk2(bf_lo(ov.w) * bf_lo(zv.w), bf_hi(ov.w) * bf_hi(zv.w));
            *(u32x4*)(P.OCAT + (row0 + row) * 2048 + h * 128 + c8) = r;
        }
#pragma unroll
        for (int e = 0; e < 8; ++e) ucur[e] = pu[e];
        zcur[0] = pz[0]; zcur[1] = pz[1]; dlcur = pdl;
        if (n + 2 < NCH) DN_LOAD(n + 2);
    }
#undef DN_LOAD
#undef DN_STORE
#pragma unroll
    for (int m = 0; m < 8; ++m)
#pragma unroll
        for (int r = 0; r < 4; ++r) P.DSP[((size_t)(b * H + h) * 128 + 16 * m + 4 * fq + r) * 128 + 16 * w + fr] = S[m][r];
}

constexpr int L_CV = 0, L_QS = L_CV + 8 * 384 * 4, L_KS = L_QS + 8 * 128 * 4, L_VS = L_KS + 8 * 128 * 4, L_BG = L_VS + 8 * 128 * 4, L_RED = L_BG + 256, L_OS = L_RED + 2 * 4 * 128 * 4, L_SAMP_END = L_OS + 8 * 128 * 4;
DI void sample_item(LP(unsigned char) lds, const DnPtrs& P, int b, int h) {
    const int tid = t_id(), w = wave_id(), l = tid & 63, dv = tid & 127, dkb = tid >> 7;
    LP(float) CV = (LP(float))(lds + L_CV); LP(float) QS = (LP(float))(lds + L_QS); LP(float) KS = (LP(float))(lds + L_KS); LP(float) VS = (LP(float))(lds + L_VS);
    LP(float) BG = (LP(float))(lds + L_BG); LP(float) RED = (LP(float))(lds + L_RED); LP(float) OS = (LP(float))(lds + L_OS);
    const size_t sbase = ((size_t)(b * H + h) * 128 + 32 * dkb) * 128 + dv;
    const int rowb = MP + 8 * b;
    wg_sync();
    float S[32];
#pragma unroll
    for (int i = 0; i < 32; ++i) S[i] = P.state_delta[sbase + (size_t)i * 128];
    if (tid < 384) {
        const int col = (tid >> 7) * 1024 + h * 128 + (tid & 127);
        float x[11], cw[4];
#pragma unroll
        for (int i = 0; i < 4; ++i) cw[i] = P.conv_w[i * QKVW + col];
#pragma unroll
        for (int i = 0; i < 3; ++i) x[i] = P.state_conv[((size_t)b * 3 + i) * QKVW + col];
#pragma unroll
        for (int t = 0; t < 8; ++t) x[3 + t] = bf2f(P.QKV[(size_t)(rowb + t) * QKVW + col]);
#pragma unroll
        for (int t = 0; t < 8; ++t) CV[t * 384 + tid] = silu_f(x[t] * cw[0] + x[t + 1] * cw[1] + x[t + 2] * cw[2] + x[t + 3] * cw[3]);
    }
    wg_sync();
    {
        const int t = w;
        const float q0 = CV[t * 384 + 2 * l], q1 = CV[t * 384 + 2 * l + 1], k0 = CV[t * 384 + 128 + 2 * l], k1 = CV[t * 384 + 128 + 2 * l + 1];
        const float rq = 1.0f / sqrtf(wave_sum(q0 * q0 + q1 * q1) + L2_EPS) * QSCALE_DN, rk = 1.0f / sqrtf(wave_sum(k0 * k0 + k1 * k1) + L2_EPS);
        QS[t * 128 + 2 * l] = q0 * rq; QS[t * 128 + 2 * l + 1] = q1 * rq; KS[t * 128 + 2 * l] = k0 * rk; KS[t * 128 + 2 * l + 1] = k1 * rk;
        VS[t * 128 + 2 * l] = CV[t * 384 + 256 + 2 * l]; VS[t * 128 + 2 * l + 1] = CV[t * 384 + 256 + 2 * l + 1];
        if (l == 0) { const float* ba = P.BA + (size_t)(rowb + t) * 16; BG[2 * t] = 1.0f / (1.0f + expf(-ba[h])); BG[2 * t + 1] = expf(-expf(P.a_log[h]) * softplus_f(ba[8 + h] + P.dt_bias[h])); }
    }
    wg_sync();
    for (int t = 0; t < 8; ++t) {
        const float beta = BG[2 * t], eg = BG[2 * t + 1];
        float p = 0.f;
#pragma unroll
        for (int i = 0; i < 32; ++i) p += KS[t * 128 + 32 * dkb + i] * S[i];
        RED[dkb * 128 + dv] = p;
        wg_sync();
        const float kS = (RED[dv] + RED[128 + dv]) + (RED[256 + dv] + RED[384 + dv]);
        const float d = beta * (VS[t * 128 + dv] - eg * kS);
        float po = 0.f;
#pragma unroll
        for (int i = 0; i < 32; ++i) { S[i] = eg * S[i] + KS[t * 128 + 32 * dkb + i] * d; po += QS[t * 128 + 32 * dkb + i] * S[i]; }
        RED[512 + dkb * 128 + dv] = po;
        wg_sync();
        if (dkb == 0) OS[t * 128 + dv] = (RED[512 + dv] + RED[640 + dv]) + (RED[768 + dv] + RED[896 + dv]);
    }
    wg_sync();
    {
        const int t = w, row = rowb + t;
        const float o0 = OS[t * 128 + 2 * l], o1 = OS[t * 128 + 2 * l + 1];
        const float rs = 1.0f / sqrtf(wave_sum(o0 * o0 + o1 * o1) * (1.0f / 128.0f) + RMS_EPS);
        const unsigned zz = *(const unsigned*)(P.Z + (size_t)row * D + h * 128 + 2 * l);
        *(unsigned*)(P.OCAT + (size_t)row * 2048 + h * 128 + 2 * l) = pk2(o0 * rs * P.dn_norm[2 * l] * bf_lo(zz), o1 * rs * P.dn_norm[2 * l + 1] * bf_hi(zz));
    }
#pragma unroll
    for (int i = 0; i < 32; ++i) P.DSS[sbase + (size_t)i * 128] = S[i];
}

constexpr int SB_WAVE = 8 * 256 * 4 + 8 * 64 * 4 + 64, L_SB_SS = 8 * SB_WAVE, L_SB_END = L_SB_SS + 4 * 2 * 8 * 4;
static_assert(L_SB_END <= P2_LDS, "sample batch LDS");
DI void sample_batch(LP(unsigned char) lds, const DnPtrs& P, int q4) {
    const int tid = t_id(), w = wave_id(), l = tid & 63, c = l & 15, q = l >> 4;
    const int b = q4 >> 1, h = 4 * (q4 & 1) + (w >> 1), half = w & 1, rowb = MP + 8 * b;
    LP(float) KQ = (LP(float))(lds + w * SB_WAVE);
    LP(float) VV = KQ + 8 * 256;
    LP(float) BG = VV + 8 * 64;
    LP(float) SSQ = (LP(float))(lds + L_SB_SS);
    wg_sync();
    const size_t sbase = ((size_t)(b * H + h) * 128 + q) * 128 + 64 * half + 4 * c;
    {
        float xq[11][2], xk[11][2], xv[11];
        const int cq = h * 128 + 2 * l, cv = 2048 + h * 128 + 64 * half + l;
#pragma unroll
        for (int i = 0; i < 3; ++i) { const float* sc = P.state_conv + ((size_t)b * 3 + i) * QKVW; xq[i][0] = sc[cq]; xq[i][1] = sc[cq + 1]; xk[i][0] = sc[1024 + cq]; xk[i][1] = sc[1024 + cq + 1]; xv[i] = sc[cv]; }
#pragma unroll
        for (int t = 0; t < 8; ++t) { const bf16* r = P.QKV + (size_t)(rowb + t) * QKVW; const unsigned uq = *(const unsigned*)(r + cq), uk = *(const unsigned*)(r + 1024 + cq);
            xq[3 + t][0] = bf_lo(uq); xq[3 + t][1] = bf_hi(uq); xk[3 + t][0] = bf_lo(uk); xk[3 + t][1] = bf_hi(uk); xv[3 + t] = bf2f(r[cv]); }
        float wq[4][2], wk[4][2], wv[4];
#pragma unroll
        for (int i = 0; i < 4; ++i) { wq[i][0] = P.conv_w[i * QKVW + cq]; wq[i][1] = P.conv_w[i * QKVW + cq + 1]; wk[i][0] = P.conv_w[i * QKVW + 1024 + cq]; wk[i][1] = P.conv_w[i * QKVW + 1024 + cq + 1]; wv[i] = P.conv_w[i * QKVW + cv]; }
#pragma unroll
        for (int t = 0; t < 8; ++t) {
            float qq[2], kk[2];
#pragma unroll
            for (int e = 0; e < 2; ++e) { qq[e] = silu_f(xq[t][e] * wq[0][e] + xq[t + 1][e] * wq[1][e] + xq[t + 2][e] * wq[2][e] + xq[t + 3][e] * wq[3][e]);
                                          kk[e] = silu_f(xk[t][e] * wk[0][e] + xk[t + 1][e] * wk[1][e] + xk[t + 2][e] * wk[2][e] + xk[t + 3][e] * wk[3][e]); }
            const float vv = silu_f(xv[t] * wv[0] + xv[t + 1] * wv[1] + xv[t + 2] * wv[2] + xv[t + 3] * wv[3]);
            const float rq = frsq(wave_sum(qq[0] * qq[0] + qq[1] * qq[1]) + L2_EPS) * QSCALE_DN, rk = frsq(wave_sum(kk[0] * kk[0] + kk[1] * kk[1]) + L2_EPS);
#pragma unroll
            for (int e = 0; e < 2; ++e) { const int dk = 2 * l + e, pos = (dk & 3) * 32 + (dk >> 2); KQ[t * 256 + pos] = kk[e] * rk; KQ[t * 256 + 128 + pos] = qq[e] * rq; }
            VV[t * 64 + l] = vv;
            if (l == 0) { const float* ba = P.BA + (size_t)(rowb + t) * 16; BG[2 * t] = 1.0f / (1.0f + expf(-ba[h])); BG[2 * t + 1] = expf(-expf(P.a_log[h]) * softplus_f(ba[8 + h] + P.dt_bias[h])); }
        }
    }
    wave_sync();
    f32x4 S[32];
#pragma unroll
    for (int i = 0; i < 32; ++i) S[i] = *(const f32x4*)(P.state_delta + sbase + (size_t)(4 * i) * 128);
    LP(float) OSW = VV;
#pragma unroll 1
    for (int t = 0; t < 8; ++t) {
        const float beta = BG[2 * t], eg = BG[2 * t + 1];
        f32x4 kS = {0.f, 0.f, 0.f, 0.f};
#pragma unroll
        for (int j = 0; j < 8; ++j) { const f32x4 kv = *(LP(f32x4))(KQ + t * 256 + q * 32 + 4 * j);
#pragma unroll
            for (int e = 0; e < 4; ++e) kS += S[4 * j + e] * kv[e]; }
#pragma unroll
        for (int e = 0; e < 4; ++e) { kS[e] += shfl_xor_f(kS[e], 16); kS[e] += shfl_xor_f(kS[e], 32); }
        const f32x4 vv = *(LP(f32x4))(VV + t * 64 + 4 * c);
        const f32x4 dd = (vv - kS * eg) * beta;
        f32x4 o = {0.f, 0.f, 0.f, 0.f};
#pragma unroll
        for (int j = 0; j < 8; ++j) { const f32x4 kv = *(LP(f32x4))(KQ + t * 256 + q * 32 + 4 * j), qv = *(LP(f32x4))(KQ + t * 256 + 128 + q * 32 + 4 * j);
#pragma unroll
            for (int e = 0; e < 4; ++e) { S[4 * j + e] = S[4 * j + e] * eg + dd * kv[e]; o += S[4 * j + e] * qv[e]; } }
#pragma unroll
        for (int e = 0; e < 4; ++e) { o[e] += shfl_xor_f(o[e], 16); o[e] += shfl_xor_f(o[e], 32); }
        const float ss = row_sum16((o[0] * o[0] + o[1] * o[1]) + (o[2] * o[2] + o[3] * o[3]));
        if (l == 0) SSQ[((w >> 1) * 2 + half) * 8 + t] = ss;
        wave_sync();
        if (q == 0) *(LP(f32x4))(OSW + t * 64 + 4 * c) = o;
    }
#pragma unroll
    for (int i = 0; i < 32; ++i) *(f32x4*)(P.DSS + sbase + (size_t)(4 * i) * 128) = S[i];
    wg_sync();
    if (q == 0) {
        const f32x4 dn4 = *(const f32x4*)(P.dn_norm + 64 * half + 4 * c);
#pragma unroll
        for (int t = 0; t < 8; ++t) {
            const float rs = 1.0f / sqrtf((SSQ[((w >> 1) * 2) * 8 + t] + SSQ[((w >> 1) * 2 + 1) * 8 + t]) * (1.0f / 128.0f) + RMS_EPS);
            const size_t row = (size_t)(rowb + t);
            const u32x2 zz = *(const u32x2*)(P.Z + row * D + h * 128 + 64 * half + 4 * c);
            const f32x4 ot = *(LP(f32x4))(OSW + t * 64 + 4 * c);
            u32x2 ov; ov.x = pk2(ot[0] * rs * dn4[0] * bf_lo(zz.x), ot[1] * rs * dn4[1] * bf_hi(zz.x)); ov.y = pk2(ot[2] * rs * dn4[2] * bf_lo(zz.y), ot[3] * rs * dn4[3] * bf_hi(zz.y));
            *(u32x2*)(P.OCAT + row * 2048 + h * 128 + 64 * half + 4 * c) = ov;
        }
    }
}
}
struct SgPtrs { const bf16* UV; const bf16* SGWT; const float* sgu_w; const float* sgu_b; const float* sgu_norm; bf16* OCAT; float* SGV; };
namespace sg {
using namespace cfg;
constexpr int VT_LD = 136, L_VT = 0, L_R = 4 * 128 * VT_LD * 2, L_SG_END = L_R + 512;
static_assert(L_SG_END <= P2_LDS, "sgu LDS");
DI void sgu_item(LP(unsigned char) lds, const SgPtrs& P, int b, int c) {
    const int tid = t_id(), w = wave_id(), l = tid & 63, fr = l & 15, fq = l >> 4;
    const size_t row0 = (size_t)b * SEQ + 128 * c;
    LP(bf16) VT = (LP(bf16))(lds + L_VT);
    wg_sync();
    {
        u32x4 v[16];
#pragma unroll
        for (int j = 0; j < 16; ++j) v[j] = *(const u32x4*)(P.UV + (row0 + 16 * w + j) * D + 512 + 8 * l);
        float gn[8];
        { const f32x4 g0 = *(const f32x4*)(P.sgu_norm + 8 * l), g1 = *(const f32x4*)(P.sgu_norm + 8 * l + 4); gn[0] = g0[0]; gn[1] = g0[1]; gn[2] = g0[2]; gn[3] = g0[3]; gn[4] = g1[0]; gn[5] = g1[1]; gn[6] = g1[2]; gn[7] = g1[3]; }
        LP(bf16) vt = VT + (size_t)(l >> 4) * 128 * VT_LD;
        const int cc0 = 8 * (l & 15), swz = (l & 15);
#pragma unroll
        for (int jp = 0; jp < 8; ++jp) {
            float x0[8], x1[8];
            { const u32x4 a = v[2 * jp], bq = v[2 * jp + 1];
              x0[0] = bf_lo(a.x); x0[1] = bf_hi(a.x); x0[2] = bf_lo(a.y); x0[3] = bf_hi(a.y); x0[4] = bf_lo(a.z); x0[5] = bf_hi(a.z); x0[6] = bf_lo(a.w); x0[7] = bf_hi(a.w);
              x1[0] = bf_lo(bq.x); x1[1] = bf_hi(bq.x); x1[2] = bf_lo(bq.y); x1[3] = bf_hi(bq.y); x1[4] = bf_lo(bq.z); x1[5] = bf_hi(bq.z); x1[6] = bf_lo(bq.w); x1[7] = bf_hi(bq.w); }
            float s0 = 0.f, s1 = 0.f;
#pragma unroll
            for (int e = 0; e < 8; ++e) { s0 += x0[e] * x0[e]; s1 += x1[e] * x1[e]; }
            const float r0 = 1.0f / sqrtf(wave_sum(s0) * (1.0f / 512.0f) + RMS_EPS), r1 = 1.0f / sqrtf(wave_sum(s1) * (1.0f / 512.0f) + RMS_EPS);
            const int s = 16 * w + 2 * jp;
            const int pos = (((s >> 3) ^ swz) << 3) + (s & 7);
#pragma unroll
            for (int e = 0; e < 8; ++e) *(LP(unsigned))(vt + (cc0 + e) * VT_LD + pos) = pk2(x0[e] * r0 * gn[e], x1[e] * r1 * gn[e]);
        }
    }
    wg_sync();
    {
        const int t = 16 * w + fr, kmax = (16 * w + 15) >> 5;
#pragma unroll 1
        for (int g = 0; g < 4; ++g) {
            LP(bf16) vt = VT + (size_t)g * 128 * VT_LD;
            f32x4 acc[8];
#pragma unroll
            for (int m = 0; m < 8; ++m) acc[m] = (f32x4){0.f, 0.f, 0.f, 0.f};
            bf16x8 wf[4];
#pragma unroll
            for (int ks = 0; ks < 4; ++ks) wf[ks] = *(const bf16x8*)(P.SGWT + ((size_t)g * 128 + t) * 128 + 32 * ks + 8 * fq);
            const float bias = P.sgu_b[g * 128 + t];
            u32x2 uu[8];
#pragma unroll
            for (int m = 0; m < 8; ++m) uu[m] = *(const u32x2*)(P.UV + (row0 + t) * D + g * 128 + 16 * m + 4 * fq);
#pragma unroll
            for (int ks = 0; ks < 4; ++ks) if (ks <= kmax) {
#pragma unroll
                for (int m = 0; m < 8; ++m) acc[m] = mfma16(*(LP(bf16x8))(vt + (16 * m + fr) * VT_LD + (((4 * ks + fq) ^ (2 * m + (fr >> 3))) << 3)), wf[ks], acc[m]);
            }
#pragma unroll
            for (int m = 0; m < 8; ++m) {
                u32x2 o; o.x = pk2(bf_lo(uu[m].x) * (acc[m][0] + bias), bf_hi(uu[m].x) * (acc[m][1] + bias)); o.y = pk2(bf_lo(uu[m].y) * (acc[m][2] + bias), bf_hi(uu[m].y) * (acc[m][3] + bias));
                *(u32x2*)(P.OCAT + (row0 + t) * 2048 + 1024 + g * 128 + 16 * m + 4 * fq) = o;
            }
        }
    }
}
DI void sgu_sample_item(LP(unsigned char) lds, const SgPtrs& P, int b) {
    const int tid = t_id(), w = wave_id(), l = tid & 63, g = tid >> 7;
    LP(float) RED = (LP(float))(lds);
    const size_t rowb = (size_t)MP + 8 * b;
    float v[8], u[8];
    wg_sync();
#pragma unroll
    for (int t = 0; t < 8; ++t) { v[t] = bf2f(P.UV[(rowb + t) * D + 512 + tid]); u[t] = bf2f(P.UV[(rowb + t) * D + tid]); const float s = wave_sum(v[t] * v[t]); if (l == 0) RED[t * 8 + w] = s; }
    wg_sync();
    const float gain = P.sgu_norm[tid];
#pragma unroll
    for (int t = 0; t < 8; ++t) {
        float s = 0.f;
#pragma unroll
        for (int j = 0; j < 8; ++j) s += RED[t * 8 + j];
        v[t] = v[t] * (1.0f / sqrtf(s * (1.0f / 512.0f) + RMS_EPS)) * gain;
        P.SGV[((size_t)b * 8 + t) * 512 + tid] = v[t];
    }
#pragma unroll
    for (int t = 0; t < 8; ++t) {
        float mx = P.sgu_b[g * 128 + t];
#pragma unroll
        for (int s = 0; s <= t; ++s) mx += P.sgu_w[((size_t)g * 128 + t) * 128 + s] * v[s];
        P.OCAT[(rowb + t) * 2048 + 1024 + tid] = (bf16)f2bf(u[t] * mx);
    }
}
}

namespace at {
using namespace cfg;
constexpr int K_LD = 136, V_LD = 264, L_K = 0, L_V = 256 * K_LD * 2, L_AT_END = L_V + 128 * V_LD * 2, OS_LD = 72;
static_assert(L_AT_END <= P2_LDS && 8 * 32 * OS_LD * 2 <= L_V, "attention LDS");
DI int crow(int i, int h) { return (i & 3) + 8 * (i >> 2) + 4 * h; }
DI void attn_item(LP(unsigned char) lds, const bf16* Q, int nq, const float* K, const float* V, bf16* O) {
    const int tid = t_id(), w = wave_id(), l = tid & 63, r32 = l & 31, hh = l >> 5;
    LP(bf16) KL = (LP(bf16))(lds + L_K); LP(bf16) VT = (LP(bf16))(lds + L_V);
    wg_sync();
    {
        f32x4 kv[16];
#pragma unroll
        for (int e = 0; e < 16; ++e) { const int p = tid + 512 * e; kv[e] = *(const f32x4*)(K + (size_t)(p >> 5) * 512 + (p & 31) * 4); }
#pragma unroll
        for (int e = 0; e < 16; ++e) { const int p = tid + 512 * e; u32x2 pk; pk.x = pk2(kv[e][0], kv[e][1]); pk.y = pk2(kv[e][2], kv[e][3]); *(LP(u32x2))(KL + (p >> 5) * K_LD + (p & 31) * 4) = pk; }
    }
    {
        f32x4 v0[8], v1[8];
#pragma unroll
        for (int e = 0; e < 8; ++e) { const int u = tid + 512 * e, d4 = (u & 31) * 4, key = 2 * (u >> 5); v0[e] = *(const f32x4*)(V + (size_t)key * 512 + d4); v1[e] = *(const f32x4*)(V + (size_t)(key + 1) * 512 + d4); }
#pragma unroll
        for (int e = 0; e < 8; ++e) {
            const int u = tid + 512 * e, d4 = (u & 31) * 4, kp = perm16k(2 * (u >> 5));
            const int pos = (((kp >> 3) ^ (u & 31)) << 3) + (kp & 7);
#pragma unroll
            for (int i = 0; i < 4; ++i) *(LP(unsigned))(VT + (d4 + i) * V_LD + pos) = pk2(v0[e][i], v1[e][i]);
        }
    }
    wg_sync();
    const int q0 = 32 * w;
    const bool active = q0 < nq;
    bf16x8 Pf[8][2];
    float inv = 0.f;
    if (active) {
        bf16x8 Bq[8];
        const bool qok = (q0 + r32) < nq;
#pragma unroll
        for (int ks = 0; ks < 8; ++ks) { Bq[ks] = (bf16x8){0, 0, 0, 0, 0, 0, 0, 0}; if (qok) Bq[ks] = *(const bf16x8*)(Q + (size_t)(q0 + r32) * 512 + 16 * ks + 8 * hh); }
        f32x16 acc[8];
#pragma unroll
        for (int kt = 0; kt < 8; ++kt) {
#pragma unroll
            for (int i = 0; i < 16; ++i) acc[kt][i] = 0.f;
#pragma unroll
            for (int ks = 0; ks < 8; ++ks) acc[kt] = mfma32(*(LP(bf16x8))(KL + (32 * kt + r32) * K_LD + 16 * ks + 8 * hh), Bq[ks], acc[kt]);
#ifndef HOST_EMU
            asm volatile("" ::: "memory");
#endif
        }
        float mx = -3.0e38f;
#pragma unroll
        for (int kt = 0; kt < 8; ++kt)
#pragma unroll
            for (int i = 0; i < 16; ++i) mx = fmaxf(mx, acc[kt][i]);
        mx = fmaxf(mx, shfl_xor_f(mx, 32));
        float sum = 0.f;
#pragma unroll
        for (int kt = 0; kt < 8; ++kt) {
#pragma unroll
            for (int i = 0; i < 16; ++i) { const float p = fexp2(acc[kt][i] - mx); acc[kt][i] = p; sum += p; }
#pragma unroll
            for (int s = 0; s < 2; ++s) {
                u32x4 pa; pa.x = pk2(acc[kt][8 * s], acc[kt][8 * s + 1]); pa.y = pk2(acc[kt][8 * s + 2], acc[kt][8 * s + 3]); pa.z = pk2(acc[kt][8 * s + 4], acc[kt][8 * s + 5]); pa.w = pk2(acc[kt][8 * s + 6], acc[kt][8 * s + 7]);
                Pf[kt][s] = __builtin_bit_cast(bf16x8, pa);
            }
        }
        sum += shfl_xor_f(sum, 32);
        inv = 1.0f / sum;
    }
    wg_sync();
    if (active) {
        LP(bf16) OS = (LP(bf16))(lds + L_K) + (size_t)w * 32 * OS_LD;
        float invq[16];
#pragma unroll
        for (int i = 0; i < 16; ++i) invq[i] = shfl_f(inv, crow(i, hh));
#pragma unroll
        for (int dh = 0; dh < 2; ++dh) {
            f32x16 o[2];
#pragma unroll
            for (int dt = 0; dt < 2; ++dt)
#pragma unroll
                for (int i = 0; i < 16; ++i) o[dt][i] = 0.f;
#pragma unroll
            for (int kt = 0; kt < 8; ++kt) {
#pragma unroll
                for (int s = 0; s < 2; ++s) {
#pragma unroll
                    for (int dt = 0; dt < 2; ++dt) { const int d = 64 * dh + 32 * dt + r32;
                        o[dt] = mfma32(Pf[kt][s], *(LP(bf16x8))(VT + d * V_LD + (((4 * kt + 2 * s + hh) ^ ((d >> 2) & 31)) << 3)), o[dt]); }
                }
#ifndef HOST_EMU
                asm volatile("" ::: "memory");
#endif
            }
#pragma unroll
            for (int i = 0; i < 16; ++i)
#pragma unroll
                for (int dt = 0; dt < 2; ++dt) OS[crow(i, hh) * OS_LD + 32 * dt + r32] = (bf16)f2bf(o[dt][i] * invq[i]);
            wave_sync();
#pragma unroll
            for (int j = 0; j < 4; ++j) {
                const int ch = l + 64 * j, q = ch >> 3, c8 = (ch & 7) * 8;
                const u32x4 ov = *(LP(u32x4))(OS + q * OS_LD + c8);
                if (q0 + q < nq) *(u32x4*)(O + (size_t)(q0 + q) * 2048 + 64 * dh + c8) = ov;
            }
            wave_sync();
        }
    }
}
}
namespace mini {
using namespace cfg;
constexpr int ML_LD = 264, ML_STAGE = 2 * 64 * ML_LD * 2, L_MINI_RED = 2 * ML_STAGE;
static_assert(L_MINI_RED + 512 <= P2_LDS, "mini LDS");
DI void mm_tile(LP(unsigned char) lds, const bf16* A, int lda, const bf16* Bt, int ldb, int K, int row0, int col0, f32x4 (&acc)[2]) {
    const int tid = t_id(), w = wave_id(), l = tid & 63, fr = l & 15, fq = l >> 4;
    u32x4 ra[4], rb[4];
#define MM_FETCH(k0) do { _Pragma("unroll") for (int e = 0; e < 4; ++e) { const int c_ = tid + 512 * e; \
        ra[e] = *(const u32x4*)(A + (size_t)(row0 + (c_ >> 5)) * lda + (k0) + 8 * (c_ & 31)); rb[e] = *(const u32x4*)(Bt + (size_t)(col0 + (c_ >> 5)) * ldb + (k0) + 8 * (c_ & 31)); } } while (0)
#define MM_PUT(st) do { LP(bf16) as_ = (LP(bf16))(lds + (st) * ML_STAGE); LP(bf16) bs_ = as_ + 64 * ML_LD; _Pragma("unroll") for (int e = 0; e < 4; ++e) { const int c_ = tid + 512 * e; \
        *(LP(u32x4))(as_ + (c_ >> 5) * ML_LD + 8 * (c_ & 31)) = ra[e]; *(LP(u32x4))(bs_ + (c_ >> 5) * ML_LD + 8 * (c_ & 31)) = rb[e]; } } while (0)
    wg_sync();
    MM_FETCH(0); MM_PUT(0);
    wg_sync_lds();
    const int ns = K >> 8;
#pragma unroll 1
    for (int s = 0; s < ns; ++s) {
        if (s + 1 < ns) MM_FETCH((s + 1) << 8);
        LP(bf16) as = (LP(bf16))(lds + (s & 1) * ML_STAGE) + (16 * (w & 3) + fr) * ML_LD + 8 * fq;
        LP(bf16) bs = (LP(bf16))(lds + (s & 1) * ML_STAGE) + (64 + 32 * (w >> 2) + fr) * ML_LD + 8 * fq;
        bf16x8 fa[8], f0[8], f1[8];
#pragma unroll
        for (int j = 0; j < 8; ++j) { fa[j] = *(LP(bf16x8))(as + 32 * j); f0[j] = *(LP(bf16x8))(bs + 32 * j); f1[j] = *(LP(bf16x8))(bs + 16 * ML_LD + 32 * j); }
#pragma unroll
        for (int j = 0; j < 8; ++j) { acc[0] = mfma16(f0[j], fa[j], acc[0]); acc[1] = mfma16(f1[j], fa[j], acc[1]); }
        if (s + 1 < ns) MM_PUT((s + 1) & 1);
        wg_sync_lds();
    }
#undef MM_FETCH
#undef MM_PUT
}
DI int tile_of(int i) { return i; }
struct MiniPtrs { const bf16* OCAT; const bf16* WBR; const bf16* GATES; bf16* MERGED; const bf16* WO; const float* xs; float* Y; bf16* X1B; float* SS1; const bf16* HB; const bf16* WDN; float* SS2; };
DI void br_tile(LP(unsigned char) lds, const MiniPtrs& P, int t) {
    const int tid = t_id(), w = wave_id(), l = tid & 63, fr = l & 15, fq = l >> 4;
    const int row0 = MP + 64 * (t >> 4), col0 = 64 * (t & 15), row = row0 + 16 * (w & 3) + fr;
    const int koff[3] = {0, 1024, 1536}, klen[3] = {1024, 512, 512};
    f32x4 m[2] = {{0.f, 0.f, 0.f, 0.f}, {0.f, 0.f, 0.f, 0.f}};
#pragma unroll
    for (int b = 0; b < 3; ++b) {
        f32x4 acc[2] = {{0.f, 0.f, 0.f, 0.f}, {0.f, 0.f, 0.f, 0.f}};
        mm_tile(lds, P.OCAT + koff[b], 2048, P.WBR + koff[b], 2048, klen[b], row0, col0, acc);
#pragma unroll
        for (int n = 0; n < 2; ++n) {
            const u32x2 g = *(const u32x2*)(P.GATES + (size_t)row * NGATE + b * D + col0 + 32 * (w >> 2) + 16 * n + 4 * fq);
            m[n][0] += bf_lo(g.x) * acc[n][0]; m[n][1] += bf_hi(g.x) * acc[n][1]; m[n][2] += bf_lo(g.y) * acc[n][2]; m[n][3] += bf_hi(g.y) * acc[n][3];
        }
    }
#pragma unroll
    for (int n = 0; n < 2; ++n) { u32x2 o; o.x = pk2(m[n][0], m[n][1]); o.y = pk2(m[n][2], m[n][3]); *(u32x2*)(P.MERGED + (size_t)row * D + col0 + 32 * (w >> 2) + 16 * n + 4 * fq) = o; }
}
DI void gate_tile(LP(unsigned char) lds, const bf16* XB, const bf16* WG, const float* rstd, bf16* GATES, int t) {
    const int tid = t_id(), w = wave_id(), l = tid & 63, fr = l & 15, fq = l >> 4;
    const int row0 = MP + 64 * (t / 48), col0 = 64 * (t % 48), row = row0 + 16 * (w & 3) + fr;
    f32x4 acc[2] = {{0.f, 0.f, 0.f, 0.f}, {0.f, 0.f, 0.f, 0.f}};
    const float rs = rstd[row];
    mm_tile(lds, XB, D, WG, D, D, row0, col0, acc);
#pragma unroll
    for (int n = 0; n < 2; ++n) { u32x2 o; o.x = pk2(sigmoid_f(acc[n][0] * rs), sigmoid_f(acc[n][1] * rs)); o.y = pk2(sigmoid_f(acc[n][2] * rs), sigmoid_f(acc[n][3] * rs));
        *(u32x2*)(GATES + (size_t)row * NGATE + col0 + 32 * (w >> 2) + 16 * n + 4 * fq) = o; }
}
DI void res_tile(LP(unsigned char) lds, const bf16* A, int lda, const bf16* Bt, int ldb, int K, const float* xin, int xin_row0, const bf16* xin_b, float* Y, bf16* XB, float* SS, int t) {
    const int tid = t_id(), w = wave_id(), l = tid & 63, fr = l & 15, fq = l >> 4;
    const int row0 = MP + 64 * (t >> 4), col0 = 64 * (t & 15), row = row0 + 16 * (w & 3) + fr;
    LP(float) RED = (LP(float))(lds + L_MINI_RED);
    f32x4 acc[2] = {{0.f, 0.f, 0.f, 0.f}, {0.f, 0.f, 0.f, 0.f}};
    mm_tile(lds, A, lda, Bt, ldb, K, row0, col0, acc);
    float ss = 0.f;
#pragma unroll
    for (int n = 0; n < 2; ++n) {
        const int c = col0 + 32 * (w >> 2) + 16 * n + 4 * fq;
        f32x4 xi;
        if (xin_b) { const u32x2 xb = *(const u32x2*)(xin_b + (size_t)row * D + c); xi = (f32x4){bf_lo(xb.x), bf_hi(xb.x), bf_lo(xb.y), bf_hi(xb.y)}; }
        else xi = *(const f32x4*)(xin + (size_t)(row - xin_row0) * D + c);
        const f32x4 x = xi + acc[n];
        if (Y) *(f32x4*)(Y + (size_t)row * D + c) = x;
        if (XB) { u32x2 o; o.x = pk2(x[0], x[1]); o.y = pk2(x[2], x[3]); *(u32x2*)(XB + (size_t)row * D + c) = o; }
        ss += (x[0] * x[0] + x[1] * x[1]) + (x[2] * x[2] + x[3] * x[3]);
    }
    ss += shfl_xor_f(ss, 16); ss += shfl_xor_f(ss, 32);
    wg_sync();
    if (w >= 4 && fq == 0) RED[16 * (w & 3) + fr] = ss;
    wg_sync();
    if (w < 4 && fq == 0) SS[(size_t)row * 16 + (t & 15)] = ss + RED[16 * w + fr];
}
#ifndef HOST_EMU
DI void fin_tile(LP(unsigned char) lds, const bf16* A, int lda, const bf16* Bt, int ldb, int K, const bf16* xin_b, const float* gain, float* Y, float* SS, unsigned* cnt, unsigned* tmo, int t) {
    const int tid = t_id(), w = wave_id(), l = tid & 63, fr = l & 15, fq = l >> 4;
    const int row0 = MP + 64 * (t >> 4), col0 = 64 * (t & 15), row = row0 + 16 * (w & 3) + fr;
    LP(float) RED = (LP(float))(lds + L_MINI_RED);
    f32x4 acc[2] = {{0.f, 0.f, 0.f, 0.f}, {0.f, 0.f, 0.f, 0.f}};
    mm_tile(lds, A, lda, Bt, ldb, K, row0, col0, acc);
    float ss = 0.f;
#pragma unroll
    for (int n = 0; n < 2; ++n) {
        const int c = col0 + 32 * (w >> 2) + 16 * n + 4 * fq;
        const u32x2 xb = *(const u32x2*)(xin_b + (size_t)row * D + c);
        acc[n] = acc[n] + (f32x4){bf_lo(xb.x), bf_hi(xb.x), bf_lo(xb.y), bf_hi(xb.y)};
        ss += (acc[n][0] * acc[n][0] + acc[n][1] * acc[n][1]) + (acc[n][2] * acc[n][2] + acc[n][3] * acc[n][3]);
    }
    ss += shfl_xor_f(ss, 16); ss += shfl_xor_f(ss, 32);
    wg_sync();
    if (w >= 4 && fq == 0) RED[16 * (w & 3) + fr] = ss;
    wg_sync();
    if (w < 4) {
        if (fq == 0) __hip_atomic_store((unsigned*)(SS + (size_t)row * 16 + (t & 15)), __float_as_uint(ss + RED[16 * w + fr]), __ATOMIC_RELAXED, __HIP_MEMORY_SCOPE_AGENT);
        asm volatile("s_waitcnt vmcnt(0)" ::: "memory");
        if (l == 0) __hip_atomic_fetch_add(cnt + 64 * (t >> 4), 1u, __ATOMIC_RELAXED, __HIP_MEMORY_SCOPE_AGENT);
    }
    if (w == 0) {
        unsigned spins = 0;
        while ((unsigned)__builtin_amdgcn_readfirstlane(__hip_atomic_load(cnt + 64 * (t >> 4), __ATOMIC_RELAXED, __HIP_MEMORY_SCOPE_AGENT)) < 64u) {
            __builtin_amdgcn_s_sleep(2);
            if (++spins > (1u << 22)) { if (l == 0) __hip_atomic_store(tmo, 1u, __ATOMIC_RELAXED, __HIP_MEMORY_SCOPE_AGENT); break; }
        }
        __builtin_amdgcn_fence(__ATOMIC_ACQUIRE, "agent");
    }
    asm volatile("s_waitcnt vmcnt(0) lgkmcnt(0)" ::: "memory"); __builtin_amdgcn_s_barrier(); asm volatile("" ::: "memory");
    if (w < 4 && fq == 0) {
        const unsigned* sl = (const unsigned*)(SS + (size_t)row * 16);
        float s = 0.f;
#pragma unroll
        for (int j = 0; j < 16; ++j) s += __uint_as_float(__hip_atomic_load(sl + j, __ATOMIC_RELAXED, __HIP_MEMORY_SCOPE_AGENT));
        RED[64 + 16 * w + fr] = 1.0f / sqrtf(s * (1.0f / D) + RMS_EPS);
    }
    wg_sync();
    const float rs = RED[64 + 16 * (w & 3) + fr];
#pragma unroll
    for (int n = 0; n < 2; ++n) { const int c = col0 + 32 * (w >> 2) + 16 * n + 4 * fq; *(f32x4*)(Y + (size_t)row * D + c) = acc[n] * rs * *(const f32x4*)(gain + c); }
}
#endif
}
#ifndef HOST_EMU
namespace ep {
using namespace cfg;
using pg8::Unit; using pg8::HALF; using pg8::BM;
DI u32x4 pack8f(const f32x4& a, const f32x4& b) { u32x4 w; w.x = pg8::cvt_pk_bf16(a[0], a[1]); w.y = pg8::cvt_pk_bf16(a[2], a[3]); w.z = pg8::cvt_pk_bf16(b[0], b[1]); w.w = pg8::cvt_pk_bf16(b[2], b[3]); return w; }
DI void unpack8(const u32x4& w, f32x4& a, f32x4& b) { a[0] = bf_lo(w.x); a[1] = bf_hi(w.x); a[2] = bf_lo(w.y); a[3] = bf_hi(w.y); b[0] = bf_lo(w.z); b[1] = bf_hi(w.z); b[2] = bf_lo(w.w); b[3] = bf_hi(w.w); }

struct EpiG1 {
    static constexpr bool PERM = true, AFTER_DRAIN = false;
    bf16 *QKV, *Z, *UV, *QMEM, *HALO; float *CSP, *CSS; const float* rstd;
    DI void operator()(const f32x4 (&acc)[2][2][4][2], const Unit& u, int wr, int wc, int fr, int fq) const {
        const int row0 = u.pm * BM + wr * 64 + fr, pn = u.pn;
        bf16* base; int ld, colt, mode;
        if (pn < 12) { base = QKV; ld = QKVW; colt = pn * 256; mode = 0; }
        else if (pn < 16) { base = Z; ld = D; colt = (pn - 12) * 256; mode = 1; }
        else if (pn < 20) { base = UV; ld = D; colt = (pn - 16) * 256; mode = 2; }
        else { base = QMEM; ld = MEMW; colt = (pn - 20) * 256; mode = 3; }
        const int col0 = colt + wc * 32 + 8 * fq;
        float rsv[2][4];
#pragma unroll
        for (int ai = 0; ai < 2; ++ai)
#pragma unroll
            for (int m = 0; m < 4; ++m) rsv[ai][m] = rstd[row0 + ai * HALF + m * 16];
#pragma unroll
        for (int ai = 0; ai < 2; ++ai)
#pragma unroll
            for (int m = 0; m < 4; ++m) {
                const int r = row0 + ai * HALF + m * 16; const float rs = rsv[ai][m];
#pragma unroll
                for (int bj = 0; bj < 2; ++bj) {
                    f32x4 v0 = acc[ai][bj][m][0] * rs, v1 = acc[ai][bj][m][1] * rs;
                    if (mode == 1) {
#pragma unroll
                        for (int j = 0; j < 4; ++j) { v0[j] = silu_f(v0[j]); v1[j] = silu_f(v1[j]); } }
                    else if (mode == 2) {
#pragma unroll
                        for (int j = 0; j < 4; ++j) { v0[j] = gelu_tanh_f(v0[j]); v1[j] = gelu_tanh_f(v1[j]); } }
                    else if (mode == 3) { v0 = v0 * QSCALE_MEM; v1 = v1 * QSCALE_MEM; }
                    const u32x4 w = pack8f(v0, v1);
                    *(u32x4*)(base + (size_t)r * ld + col0 + bj * HALF) = w;
                    if (mode == 0) {
                        const int c = col0 + bj * HALF;
                        if (m == 3 && fr >= 13) {
                            *(u32x4*)(HALO + ((size_t)(r >> 6) * 3 + ((r & 63) - 61)) * QKVW + c) = w;
                            if (r < MP && (r & 2047) >= 2045) { float* d = CSP + ((size_t)(r >> 11) * 3 + ((r & 2047) - 2045)) * QKVW + c; *(f32x4*)d = v0; *(f32x4*)(d + 4) = v1; }
                        }
                        if (r >= MP && (r & 7) >= 5) { float* d = CSS + ((size_t)((r - MP) >> 3) * 3 + ((r & 7) - 5)) * QKVW + c; *(f32x4*)d = v0; *(f32x4*)(d + 4) = v1; }
                    }
                }
            }
    }
};
struct EpiKV {
    static constexpr bool PERM = false, AFTER_DRAIN = false;
    float *MK, *MV; const float* rstd;
    DI void operator()(const f32x4 (&acc)[2][2][4][2], const Unit& u, int wr, int wc, int fr, int fq) const {
        const int row0 = u.pm * BM + wr * 64 + fr, col0 = u.pn * BM + wc * 32 + 4 * fq;
        float rsv[2][4];
#pragma unroll
        for (int ai = 0; ai < 2; ++ai)
#pragma unroll
            for (int m = 0; m < 4; ++m) rsv[ai][m] = rstd[row0 + ai * HALF + m * 16];
#pragma unroll
        for (int ai = 0; ai < 2; ++ai)
#pragma unroll
            for (int m = 0; m < 4; ++m) {
                const int r = row0 + ai * HALF + m * 16; const float rs = rsv[ai][m];
#pragma unroll
                for (int bj = 0; bj < 2; ++bj)
#pragma unroll
                    for (int n = 0; n < 2; ++n) { const int c = col0 + bj * HALF + n * 16; float* d = (c < MEMW) ? MK + (size_t)r * MEMW + c : MV + (size_t)r * MEMW + (c - MEMW); *(f32x4*)d = acc[ai][bj][m][n] * rs; }
            }
    }
};
struct EpiGate {
    static constexpr bool PERM = true, AFTER_DRAIN = false;
    bf16* G; const float* rstd; int skip;
    DI void operator()(const f32x4 (&acc)[2][2][4][2], const Unit& u, int wr, int wc, int fr, int fq) const {
        if (skip) { asm volatile("" :: "v"(acc[0][0][0][0][0]), "v"(acc[1][1][3][1][3])); return; }
        const int row0 = u.pm * BM + wr * 64 + fr, col0 = u.pn * BM + wc * 32 + 8 * fq;
        float rsv[2][4];
#pragma unroll
        for (int ai = 0; ai < 2; ++ai)
#pragma unroll
            for (int m = 0; m < 4; ++m) rsv[ai][m] = rstd[row0 + ai * HALF + m * 16];
#pragma unroll
        for (int ai = 0; ai < 2; ++ai)
#pragma unroll
            for (int m = 0; m < 4; ++m) {
                const int r = row0 + ai * HALF + m * 16; const float rs = rsv[ai][m];
#pragma unroll
                for (int bj = 0; bj < 2; ++bj) {
                    f32x4 v0 = acc[ai][bj][m][0] * rs, v1 = acc[ai][bj][m][1] * rs;
#pragma unroll
                    for (int j = 0; j < 4; ++j) { v0[j] = sigmoid_f(v0[j]); v1[j] = sigmoid_f(v1[j]); }
                    *(u32x4*)(G + (size_t)r * NGATE + col0 + bj * HALF) = pack8f(v0, v1);
                }
            }
    }
};
struct EpiBr {
    static constexpr bool PERM = true, AFTER_DRAIN = false;
    const bf16* G; bf16* MG; int b;
    DI void operator()(const f32x4 (&acc)[2][2][4][2], const Unit& u, int wr, int wc, int fr, int fq) const {
        const int row0 = u.pm * BM + wr * 64 + fr, col0 = u.pn * BM + wc * 32 + 8 * fq;
#pragma unroll
        for (int ai = 0; ai < 2; ++ai) {
            u32x4 gv[4][2], ov[4][2];
#pragma unroll
            for (int m = 0; m < 4; ++m)
#pragma unroll
                for (int bj = 0; bj < 2; ++bj) {
                    const size_t r = (size_t)(row0 + ai * HALF + m * 16); const int c = col0 + bj * HALF;
                    gv[m][bj] = *(const u32x4*)(G + r * NGATE + b * D + c);
                    ov[m][bj] = (b > 0) ? *(const u32x4*)(MG + r * D + c) : (u32x4){0u, 0u, 0u, 0u};
                }
#pragma unroll
            for (int m = 0; m < 4; ++m)
#pragma unroll
                for (int bj = 0; bj < 2; ++bj) {
                    const size_t r = (size_t)(row0 + ai * HALF + m * 16); const int c = col0 + bj * HALF;
                    f32x4 g0, g1, o0, o1; unpack8(gv[m][bj], g0, g1); unpack8(ov[m][bj], o0, o1);
                    const f32x4 v0 = acc[ai][bj][m][0] * g0 + o0, v1 = acc[ai][bj][m][1] * g1 + o1;
                    *(u32x4*)(MG + r * D + c) = pack8f(v0, v1);
                }
            asm volatile("" ::: "memory");
        }
    }
};
struct EpiRes {
    static constexpr bool PERM = false, AFTER_DRAIN = false;
    const float* xin_p; const float* xin_s; const bf16* xin_b; float* Y; bf16* XB; float* SS;
    DI void operator()(const f32x4 (&acc)[2][2][4][2], const Unit& u, int wr, int wc, int fr, int fq) const {
        const int row0 = u.pm * BM + wr * 64 + fr, col0 = u.pn * BM + wc * 32 + 4 * fq;
#pragma unroll
        for (int ai = 0; ai < 2; ++ai) {
            f32x4 xv[4][2][2];
            if (xin_b) {
                u32x2 xb[4][2][2];
#pragma unroll
                for (int m = 0; m < 4; ++m)
#pragma unroll
                    for (int bj = 0; bj < 2; ++bj)
#pragma unroll
                        for (int n = 0; n < 2; ++n) xb[m][bj][n] = *(const u32x2*)(xin_b + (size_t)(row0 + ai * HALF + m * 16) * D + col0 + bj * HALF + n * 16);
#pragma unroll
                for (int m = 0; m < 4; ++m)
#pragma unroll
                    for (int bj = 0; bj < 2; ++bj)
#pragma unroll
                        for (int n = 0; n < 2; ++n) xv[m][bj][n] = (f32x4){bf_lo(xb[m][bj][n].x), bf_hi(xb[m][bj][n].x), bf_lo(xb[m][bj][n].y), bf_hi(xb[m][bj][n].y)};
            } else {
#pragma unroll
                for (int m = 0; m < 4; ++m) {
                    const int r = row0 + ai * HALF + m * 16;
                    const float* xin = (r < MP) ? xin_p + (size_t)r * D : xin_s + (size_t)(r - MP) * D;
#pragma unroll
                    for (int bj = 0; bj < 2; ++bj)
#pragma unroll
                        for (int n = 0; n < 2; ++n) xv[m][bj][n] = *(const f32x4*)(xin + col0 + bj * HALF + n * 16);
                }
            }
#pragma unroll
            for (int m = 0; m < 4; ++m) {
                const int r = row0 + ai * HALF + m * 16;
                float ss = 0.f;
#pragma unroll
                for (int bj = 0; bj < 2; ++bj)
#pragma unroll
                    for (int n = 0; n < 2; ++n) {
                        const int c = col0 + bj * HALF + n * 16;
                        const f32x4 x = xv[m][bj][n] + acc[ai][bj][m][n];
                        if (Y) *(f32x4*)(Y + (size_t)r * D + c) = x;
                        if (XB) { u32x2 w; w.x = pg8::cvt_pk_bf16(x[0], x[1]); w.y = pg8::cvt_pk_bf16(x[2], x[3]); *(u32x2*)(XB + (size_t)r * D + c) = w; }
                        ss += (x[0] * x[0] + x[1] * x[1]) + (x[2] * x[2] + x[3] * x[3]);
                    }
                ss += __shfl_xor(ss, 16); ss += __shfl_xor(ss, 32);
                if (fq == 0) SS[(size_t)r * 16 + u.pn * 4 + wc] = ss;
            }
            asm volatile("" ::: "memory");
        }
    }
};
DI float rstd_from_ss(const float* SS, int r) {
    const f32x4 a = *(const f32x4*)(SS + (size_t)r * 16), b = *(const f32x4*)(SS + (size_t)r * 16 + 4), c = *(const f32x4*)(SS + (size_t)r * 16 + 8), d = *(const f32x4*)(SS + (size_t)r * 16 + 12);
    const float s = (((a[0] + a[1]) + (a[2] + a[3])) + ((b[0] + b[1]) + (b[2] + b[3]))) + (((c[0] + c[1]) + (c[2] + c[3])) + ((d[0] + d[1]) + (d[2] + d[3])));
    return 1.0f / sqrtf(s * (1.0f / D) + RMS_EPS);
}
struct EpiGU {
    static constexpr bool PERM = true, AFTER_DRAIN = false;
    const float* SS; bf16* HB;
    DI void operator()(const f32x4 (&acc)[2][2][4][2], const Unit& u, int wr, int wc, int fr, int fq) const {
        const int row0 = u.pm * BM + wr * 64 + fr, col0 = u.pn * HALF + wc * 32 + 8 * fq;
#pragma unroll
        for (int ai = 0; ai < 2; ++ai) {
            f32x4 sv[4][4];
#pragma unroll
            for (int m = 0; m < 4; ++m)
#pragma unroll
                for (int j = 0; j < 4; ++j) sv[m][j] = *(const f32x4*)(SS + (size_t)(row0 + ai * HALF + m * 16) * 16 + 4 * j);
#pragma unroll
            for (int m = 0; m < 4; ++m) {
                const int r = row0 + ai * HALF + m * 16;
                const f32x4 a4 = sv[m][0], b4 = sv[m][1], c4 = sv[m][2], d4 = sv[m][3];
                const float ssum = (((a4[0] + a4[1]) + (a4[2] + a4[3])) + ((b4[0] + b4[1]) + (b4[2] + b4[3]))) + (((c4[0] + c4[1]) + (c4[2] + c4[3])) + ((d4[0] + d4[1]) + (d4[2] + d4[3])));
                const float rs = 1.0f / sqrtf(ssum * (1.0f / D) + RMS_EPS);
                f32x4 h0, h1;
#pragma unroll
                for (int j = 0; j < 4; ++j) { h0[j] = silu_f(acc[ai][0][m][0][j] * rs) * (acc[ai][1][m][0][j] * rs); h1[j] = silu_f(acc[ai][0][m][1][j] * rs) * (acc[ai][1][m][1][j] * rs); }
                *(u32x4*)(HB + (size_t)r * FF + col0) = pack8f(h0, h1);
            }
            asm volatile("" ::: "memory");
        }
    }
};
struct EpiFinal {
    static constexpr bool PERM = false, AFTER_DRAIN = true;
    const bf16* xin_b; const float* gain; float* Y; float* SS; unsigned* cnt; unsigned* tmo;
    DI void fused(f32x4 (&acc)[2][2][4][2], const Unit& u, int wr, int wc, int fr, int fq, PG8_LAS unsigned char* lds, int wid, int lane) const {
        PG8_LAS float* P = (PG8_LAS float*)lds;
        PG8_LAS float* R = (PG8_LAS float*)(lds + 8192);
        const int row0 = u.pm * BM + wr * 64 + fr, col0 = u.pn * BM + wc * 32 + 4 * fq;
#pragma unroll
        for (int ai = 0; ai < 2; ++ai) {
            u32x2 xb[4][2][2];
#pragma unroll
            for (int m = 0; m < 4; ++m)
#pragma unroll
                for (int bj = 0; bj < 2; ++bj)
#pragma unroll
                    for (int n = 0; n < 2; ++n) xb[m][bj][n] = *(const u32x2*)(xin_b + (size_t)(row0 + ai * HALF + m * 16) * D + col0 + bj * HALF + n * 16);
#pragma unroll
            for (int m = 0; m < 4; ++m) {
                float ss = 0.f;
#pragma unroll
                for (int bj = 0; bj < 2; ++bj)
#pragma unroll
                    for (int n = 0; n < 2; ++n) {
                        const f32x4 x = (f32x4){bf_lo(xb[m][bj][n].x), bf_hi(xb[m][bj][n].x), bf_lo(xb[m][bj][n].y), bf_hi(xb[m][bj][n].y)} + acc[ai][bj][m][n];
                        acc[ai][bj][m][n] = x; ss += (x[0] * x[0] + x[1] * x[1]) + (x[2] * x[2] + x[3] * x[3]);
                    }
                ss += __shfl_xor(ss, 16); ss += __shfl_xor(ss, 32);
                if (fq == 0) P[(ai * HALF + wr * 64 + m * 16 + fr) * 4 + wc] = ss;
            }
            asm volatile("" ::: "memory");
        }
        asm volatile("s_waitcnt lgkmcnt(0)" ::: "memory"); __builtin_amdgcn_s_barrier(); asm volatile("" ::: "memory");
        const int row = wid * 32 + (lane & 31);
        if (lane < 32) {
            const float t = (P[row * 4 + 0] + P[row * 4 + 1]) + (P[row * 4 + 2] + P[row * 4 + 3]);
            __hip_atomic_store((unsigned*)(SS + (size_t)(u.pm * BM + row) * 16 + u.pn), __float_as_uint(t), __ATOMIC_RELAXED, __HIP_MEMORY_SCOPE_AGENT);
        }
        asm volatile("s_waitcnt vmcnt(0)" ::: "memory");
        if (lane == 0) __hip_atomic_fetch_add(cnt + 64 * u.pm, 1u, __ATOMIC_RELAXED, __HIP_MEMORY_SCOPE_AGENT);
        if (wid == 0) {
            unsigned spins = 0;
            while ((unsigned)__builtin_amdgcn_readfirstlane(__hip_atomic_load(cnt + 64 * u.pm, __ATOMIC_RELAXED, __HIP_MEMORY_SCOPE_AGENT)) < 32u) {
                __builtin_amdgcn_s_sleep(2);
                if (++spins > (1u << 22)) { if (lane == 0) __hip_atomic_store(tmo, 1u, __ATOMIC_RELAXED, __HIP_MEMORY_SCOPE_AGENT); break; }
            }
            __builtin_amdgcn_fence(__ATOMIC_ACQUIRE, "agent");
        }
        asm volatile("s_waitcnt vmcnt(0) lgkmcnt(0)" ::: "memory"); __builtin_amdgcn_s_barrier(); asm volatile("" ::: "memory");
        if (lane < 32) {
            const unsigned* sl = (const unsigned*)(SS + (size_t)(u.pm * BM + row) * 16);
            const float s = (__uint_as_float(__hip_atomic_load(sl + 0, __ATOMIC_RELAXED, __HIP_MEMORY_SCOPE_AGENT)) + __uint_as_float(__hip_atomic_load(sl + 1, __ATOMIC_RELAXED, __HIP_MEMORY_SCOPE_AGENT)))
                          + (__uint_as_float(__hip_atomic_load(sl + 2, __ATOMIC_RELAXED, __HIP_MEMORY_SCOPE_AGENT)) + __uint_as_float(__hip_atomic_load(sl + 3, __ATOMIC_RELAXED, __HIP_MEMORY_SCOPE_AGENT)));
            R[row] = 1.0f / sqrtf(s * (1.0f / D) + RMS_EPS);
        }
        asm volatile("s_waitcnt lgkmcnt(0)" ::: "memory"); __builtin_amdgcn_s_barrier(); asm volatile("" ::: "memory");
        f32x4 gv[2][2];
#pragma unroll
        for (int bj = 0; bj < 2; ++bj)
#pragma unroll
            for (int n = 0; n < 2; ++n) gv[bj][n] = *(const f32x4*)(gain + col0 + bj * HALF + n * 16);
#pragma unroll
        for (int ai = 0; ai < 2; ++ai)
#pragma unroll
            for (int m = 0; m < 4; ++m) {
                const int rl = ai * HALF + wr * 64 + m * 16 + fr; const float rs = R[rl];
#pragma unroll
                for (int bj = 0; bj < 2; ++bj)
#pragma unroll
                    for (int n = 0; n < 2; ++n) *(f32x4*)(Y + (size_t)(u.pm * BM + rl) * D + col0 + bj * HALF + n * 16) = acc[ai][bj][m][n] * rs * gv[bj][n];
            }
    }
};
}
using namespace cfg;
constexpr int NWAVES = 8;
#ifndef MK_N_LAUNCHES
#define MK_N_LAUNCHES 1
#endif
constexpr int N_PHASES = 9;
struct Args { const float* in[26]; float* out; unsigned char* ws; int ph_lo, ph_hi, li, pad; };
static_assert(sizeof(Args) == 26 * 8 + 8 + 8 + 16, "no padding bytes in the kernel argument");
enum { I_XP = 0, I_XS, I_SD, I_SC, I_CK, I_CV, I_MEM, I_NMIX, I_WIN, I_CONVW, I_ALOG, I_DTB, I_DNN, I_SGN, I_SGW, I_SGB, I_WBD, I_WBS, I_WBM, I_WO, I_MNORM, I_WKV, I_NFFN, I_WGU, I_WDN, I_NFIN };

DI void p0_transpose_item(const float* W, int ld_src, int n0, int k0, const float* gain, bf16* WT, int ld_dst, int drow0, int koff, LAS float* scr, int lane) {
    float wv[32], gv[32];
#pragma unroll
    for (int i = 0; i < 32; ++i) { const int kk = 2 * i + (lane >> 5); wv[i] = W[(size_t)(k0 + kk) * ld_src + n0 + (lane & 31)]; gv[i] = gain ? gain[k0 + kk] : 1.0f; }
#pragma unroll
    for (int i = 0; i < 32; ++i) { const int kk = 2 * i + (lane >> 5); scr[kk * 33 + (lane & 31)] = wv[i] * gv[i]; }
    LDS_WAIT(); asm volatile("" ::: "memory");
    const int c = lane & 7;
#pragma unroll
    for (int j = 0; j < 4; ++j) { const int n = (lane >> 3) + 8 * j; const LAS float* s = scr + (8 * c) * 33 + n;
        v4u o; o.x = pk2(s[0 * 33], s[1 * 33]); o.y = pk2(s[2 * 33], s[3 * 33]); o.z = pk2(s[4 * 33], s[5 * 33]); o.w = pk2(s[6 * 33], s[7 * 33]);
        *(GAS v4u*)(WT + (size_t)(drow0 + n) * ld_dst + koff + k0 + 8 * c) = o; }
    LDS_WAIT(); asm volatile("" ::: "memory");
}

DI void p0_prologue(const Args& a, LAS unsigned char* lds, int vcu, int G) {
    const int tid = t_id(), lane = tid & 63, wave = __builtin_amdgcn_readfirstlane(tid >> 6);
    unsigned char* ws = a.ws;
    LAS float* scr = (LAS float*)(lds + wave * 16384);
    const int gw = vcu * NWAVES + wave, NGW = G * NWAVES;
    constexpr int I0 = 16 * 272, I1 = I0 + 16 * 32, I2 = I1 + 8 * 32, I3 = I2 + 8 * 32, I4 = I3 + 16 * 32, I5 = I4 + 16 * 32, I6 = I5 + 16 * 176, I7 = I6 + 44 * 32;
#ifndef DUP0
#define DUP0 0
#endif
    for (int rep0 = 0; rep0 < ((DUP0 & 1) ? 2 : 1); ++rep0)
    for (int it = gw; it < I7; it += NGW) {
        if (it < I0) { const int kb = it / 272, nb = it % 272, dr = 32 * nb; p0_transpose_item(a.in[I_WIN], DIN, dr < 4096 ? dr : dr + 16, 64 * kb, a.in[I_NMIX], (bf16*)(ws + WS_WIN), D, dr, 0, scr, lane); }
        else if (it < I1) { const int r = it - I0, kb = r / 32, nb = r % 32; p0_transpose_item(a.in[I_WBD], D, 32 * nb, 64 * kb, nullptr, (bf16*)(ws + WS_WBR), 2048, 32 * nb, 0, scr, lane); }
        else if (it < I2) { const int r = it - I1, kb = r / 32, nb = r % 32; p0_transpose_item(a.in[I_WBS], D, 32 * nb, 64 * kb, nullptr, (bf16*)(ws + WS_WBR), 2048, 32 * nb, 1024, scr, lane); }
        else if (it < I3) { const int r = it - I2, kb = r / 32, nb = r % 32; p0_transpose_item(a.in[I_WBM], D, 32 * nb, 64 * kb, nullptr, (bf16*)(ws + WS_WBR), 2048, 32 * nb, 1536, scr, lane); }
        else if (it < I4) { const int r = it - I3, kb = r / 32, nb = r % 32; p0_transpose_item(a.in[I_WO], D, 32 * nb, 64 * kb, nullptr, (bf16*)(ws + WS_WO), D, 32 * nb, 0, scr, lane); }
        else if (it < I5) { const int r = it - I4, kb = r / 32, nb = r % 32; p0_transpose_item(a.in[I_WKV], D, 32 * nb, 64 * kb, a.in[I_MNORM], (bf16*)(ws + WS_WKV), D, 32 * nb, 0, scr, lane); }
        else if (it < I6) { const int r = it - I5, kb = r / 176, nb = r % 176, n0 = 32 * nb, up = n0 >= FF, f0 = n0 - up * FF;
            p0_transpose_item(a.in[I_WGU], 2 * FF, n0, 64 * kb, a.in[I_NFFN], (bf16*)(ws + WS_WGU), D, 256 * (f0 / 128) + 128 * up + (f0 % 128), 0, scr, lane); }
        else { const int r = it - I6, kb = r / 32, nb = r % 32; p0_transpose_item(a.in[I_WDN], D, 32 * nb, 64 * kb, nullptr, (bf16*)(ws + WS_WDN), FF, 32 * nb, 0, scr, lane); }
    }
    { bf16* sw = (bf16*)(ws + WS_SGW); const float* w = a.in[I_SGW];
      for (int i = (vcu * NWAVES * 64) + tid; i < 4 * 128 * 128; i += G * NWAVES * 64) { const int t = (i >> 7) & 127, s = i & 127; sw[i] = (bf16)f2bf(s <= t ? w[i] : 0.f); } }
    __syncthreads();
    LAS float* img = (LAS float*)lds;
    for (int i = tid; i < 16 * 1024; i += NWAVES * 64) { const int k = i >> 4, c = i & 15; img[c * 1024 + k] = a.in[I_WIN][(size_t)k * DIN + 4096 + c] * a.in[I_NMIX][k]; }
    __syncthreads();
    bf16* XB = (bf16*)(ws + WS_XB); float* RS = (float*)(ws + WS_RSTDX); float* BA = (float*)(ws + WS_BA);
    f32x4 vnx[4];
    { const int m = gw; if (m < M) { const float* xrow = (m < MP) ? a.in[I_XP] + (size_t)m * D : a.in[I_XS] + (size_t)(m - MP) * D; const GAS f32x4* xr = (const GAS f32x4*)xrow + lane;
#pragma unroll
        for (int j = 0; j < 4; ++j) vnx[j] = xr[64 * j]; } }
    for (int m = gw; m < M; m += NGW) {
        f32x4 v[4]; float s = 0.f;
#pragma unroll
        for (int j = 0; j < 4; ++j) v[j] = vnx[j];
        { const int mn = m + NGW; if (mn < M) { const float* xrow = (mn < MP) ? a.in[I_XP] + (size_t)mn * D : a.in[I_XS] + (size_t)(mn - MP) * D; const GAS f32x4* xr = (const GAS f32x4*)xrow + lane;
#pragma unroll
            for (int j = 0; j < 4; ++j) vnx[j] = xr[64 * j]; } }
#pragma unroll
        for (int j = 0; j < 4; ++j) s += (v[j].x * v[j].x + v[j].y * v[j].y) + (v[j].z * v[j].z + v[j].w * v[j].w);
        const float rstd = 1.f / sqrtf(wave_sum(s) * (1.f / D) + RMS_EPS);
        GAS unsigned long long* o8 = (GAS unsigned long long*)(XB + (size_t)m * D) + lane;
#pragma unroll
        for (int j = 0; j < 4; ++j) o8[64 * j] = (unsigned long long)pk2(v[j].x, v[j].y) | ((unsigned long long)pk2(v[j].z, v[j].w) << 32);
        float mine = 0.f;
#pragma unroll 1
        for (int c = 0; c < 16; ++c) {
            float p = 0.f;
#pragma unroll
            for (int j = 0; j < 4; ++j) { const f32x4 wv = *(const LAS f32x4*)(img + c * 1024 + 256 * j + 4 * lane); p += (v[j].x * wv.x + v[j].y * wv.y) + (v[j].z * wv.z + v[j].w * wv.w); }
            p = wave_sum(p);
            if (lane == c) mine = p;
        }
        if (lane < 16) BA[(size_t)m * 16 + lane] = mine * rstd;
        if (lane == 0) RS[m] = rstd;
    }
    bf16* MB = (bf16*)(ws + WS_MB); float* RM = (float*)(ws + WS_RSTDM);
    for (int m = gw; m < NB * MEMT; m += NGW) {
        const GAS f32x4* xr = (const GAS f32x4*)(a.in[I_MEM] + (size_t)m * D) + lane;
        f32x4 v[4]; float s = 0.f;
#pragma unroll
        for (int j = 0; j < 4; ++j) { v[j] = xr[64 * j]; s += (v[j].x * v[j].x + v[j].y * v[j].y) + (v[j].z * v[j].z + v[j].w * v[j].w); }
        const float rstd = 1.f / sqrtf(wave_sum(s) * (1.f / D) + RMS_EPS);
        GAS unsigned long long* o8 = (GAS unsigned long long*)(MB + (size_t)m * D) + lane;
#pragma unroll
        for (int j = 0; j < 4; ++j) o8[64 * j] = (unsigned long long)pk2(v[j].x, v[j].y) | ((unsigned long long)pk2(v[j].z, v[j].w) << 32);
        if (lane == 0) RM[m] = rstd;
    }
}

DI void stagger_delay(unsigned ticks) { const unsigned long long t0 = __builtin_amdgcn_s_memrealtime(); while (__builtin_amdgcn_s_memrealtime() - t0 < ticks) __builtin_amdgcn_s_sleep(8); }
struct RotOrder : pg8::StaticOrder { };

__global__ void __launch_bounds__(NWAVES * 64, 2) hyb_fwd(Args args) {
    extern __shared__ __attribute__((aligned(16))) unsigned char lds_raw[];
    LAS unsigned char* lds = (LAS unsigned char*)lds_raw;
    volatile LAS unsigned* MISC = (volatile LAS unsigned*)(lds + MISC_OFF);
    const int G = gridDim.x, bx = blockIdx.x, vcu = (G % 8 == 0) ? (bx % 8) * (G / 8) + bx / 8 : bx;
    for (int u = t_id(); u < 128; u += NWAVES * 64) ((LAS unsigned*)(lds + MISC_OFF))[u] = 0u;
    unsigned char* const ws = args.ws; float* const out = args.out; gu32* const ctl = (gu32*)(ws + WS_CTL);
    __syncthreads();
    XcdBarrier bar; bar.bar = (unsigned*)(ctl + CW_BAR) + args.li * XCD_BAR_WORDS; bar.x = 0; bar.st = nullptr;
    if (MK_N_LAUNCHES <= 2) bar = xcd_barrier_post((unsigned*)(ctl + CW_BAR) + args.li * XCD_BAR_WORDS, MISC + 8);
    const int lo = args.ph_lo, hi = args.ph_hi, pass = args.li;
#ifndef PH_MASK
#define PH_MASK 0x3ff
#endif
#define IN(k) (((PH_MASK >> (k)) & 1) && lo <= (k) && (k) < hi)
#define SEAM(k) do { if (IN(k) && IN((k) + 1)) xcd_barrier(bar); } while (0)
    bf16* const XB = (bf16*)(ws + WS_XB); const float* const RSX = (const float*)(ws + WS_RSTDX);

    if (IN(0)) { p0_prologue(args, lds, vcu, G); }
    SEAM(0);
    if (IN(1)) {
#ifdef STAGGER
        if ((bx >> 3) & 1) stagger_delay(STAGGER);
#endif
        { pg8::Gemm g{XB, (const bf16*)(ws + WS_WIN), MP, 4096, D, D, D}; pg8::StaticOrder S; S.init(MP, 4096, G, bx);
          ep::EpiG1 E{(bf16*)(ws + WS_QKV), (bf16*)out  , (bf16*)out + (size_t)M * D, (bf16*)(ws + WS_QMEM), (bf16*)(ws + WS_HALO), out + O_CSP, out + O_CSS, RSX};
          pg8::gemm_phase<ep::EpiG1, pg8::StaticOrder, true, true>(lds, g, S, E); }
    }
    SEAM(1);
    DnPtrs DP{(const bf16*)(ws + WS_QKV), (const bf16*)(ws + WS_HALO), (const float*)(ws + WS_BA), args.in[I_CONVW], args.in[I_ALOG], args.in[I_DTB], args.in[I_DNN],
              (bf16*)(ws + WS_WB), (bf16*)(ws + WS_QD), (bf16*)(ws + WS_KDT), (unsigned*)(ws + WS_UB), (bf16*)(ws + WS_AB), (float*)(ws + WS_DL),
              (const bf16*)out, (bf16*)(ws + WS_OCAT), out + O_DSP, args.in[I_SD], args.in[I_SC], out + O_DSS};
    if (IN(2)) {
        dn::PrepRaw R;
        if (vcu < NB * H * NCH) dn::prep_fetch(DP, R, vcu >> 8, (vcu >> 5) & 7, vcu & 31);
        for (int i = vcu; i < NB * H * NCH; i += G) { const int in = i + G; dn::prep_item(lds, DP, i >> 8, (i >> 5) & 7, i & 31, R, in < NB * H * NCH, in >> 8, (in >> 5) & 7, in & 31); }
        __syncthreads();
    }
    SEAM(2);
    if (IN(3)) {
#ifndef IT_MASK
#define IT_MASK 0x3f
#endif
#ifndef DUPQ
#define DUPQ 0
#endif
        gu32* const sub = ctl + 3072 + 64 * pass;
        if (bx < NB * H) { for (int rep = 0; rep < ((DUPQ & 1) ? 2 : 1); ++rep) dn::scan_item(lds, DP, bx >> 3, bx & 7); }
        else {
            const int cr = bx - NB * H, nq_ = G - NB * H, c = (nq_ % 8 == 0) ? (cr % 8) * (nq_ / 8) + cr / 8 : cr;
            { pg8::Gemm g{XB, (const bf16*)(ws + WS_WIN), M, N1, D, D, D}; pg8::ListG1 S{c, nq_};
              ep::EpiG1 E{(bf16*)(ws + WS_QKV), (bf16*)out, (bf16*)out + (size_t)M * D, (bf16*)(ws + WS_QMEM), (bf16*)(ws + WS_HALO), out + O_CSP, out + O_CSS, RSX};
              pg8::gemm_phase<ep::EpiG1, pg8::ListG1, true, true>(lds, g, S, E); }
            const int e = c - (pg8::ListG1::NU - 2 * nq_);
            constexpr int NGU = (MS / 256) * (NGATE / 256), NKV = (NB * MEMT / 256) * (D / 256);
            if (e >= 0 && e < NGU) { pg8::Gemm g{XB, (const bf16*)(ws + WS_WIN) + (size_t)N1 * D, M, NGATE, D, D, D}; pg8::OneUnit S{MP / 256 + e / (NGATE / 256), e % (NGATE / 256)};
                ep::EpiGate E{(bf16*)(ws + WS_GATES_S) - (size_t)MP * NGATE, RSX, 0};
                pg8::gemm_phase<ep::EpiGate, pg8::OneUnit, true, true>(lds, g, S, E); }
            else if (e >= NGU && e < NGU + NKV) { const int k = e - NGU; pg8::Gemm g{(const bf16*)(ws + WS_MB), (const bf16*)(ws + WS_WKV), NB * MEMT, D, D, D, D}; pg8::OneUnit S{k / (D / 256), k % (D / 256)};
                ep::EpiKV E{out + O_MK, out + O_MV, (const float*)(ws + WS_RSTDM)};
                pg8::gemm_phase<ep::EpiKV, pg8::OneUnit, true, true>(lds, g, S, E); }
        }
        asm volatile("s_waitcnt vmcnt(0)" ::: "memory");
        __syncthreads();
        if (threadIdx.x == 0) {
            if (bx >= NB * H) { __builtin_amdgcn_fence(__ATOMIC_RELEASE, "agent"); asm volatile("s_waitcnt vmcnt(0)" ::: "memory"); (void)xb_add((unsigned*)sub, 1u); }
            XB_SPIN(xb_ld((unsigned*)sub) < (unsigned)(G - NB * H), (unsigned*)(ctl + CW_BAR) + args.li * XCD_BAR_WORDS);
            __builtin_amdgcn_fence(__ATOMIC_ACQUIRE, "agent"); asm volatile("s_waitcnt vmcnt(0)" ::: "memory");
        }
        __syncthreads();
        SgPtrs SP{(const bf16*)out + (size_t)M * D, (const bf16*)(ws + WS_SGW), args.in[I_SGW], args.in[I_SGB], args.in[I_SGN], (bf16*)(ws + WS_OCAT), out + O_SGV};
        const bf16* QM = (const bf16*)(ws + WS_QMEM); bf16* OC = (bf16*)(ws + WS_OCAT);
#ifndef SB_REP
#define SB_REP 1
#endif
#ifndef SG_REP
#define SG_REP 1
#endif
#ifndef PA_REP
#define PA_REP 1
#endif
#ifndef SA_REP
#define SA_REP 1
#endif
#ifndef SS_REP
#define SS_REP 1
#endif
        constexpr int QG = 0, Q0 = QG + SG_REP * (NB * 16), Q1 = Q0 + SB_REP * (DB * H / 4), Q2 = Q1 + PA_REP * (NB * MEMH * 8), Q3 = Q2 + SA_REP * (DB * MEMH), Q4 = Q3 + SS_REP * DB;
#define Q_FETCH() do { __syncthreads(); if (t_id() == 0) MISC[16] = __hip_atomic_fetch_add(ctl + 2048 + 64 * pass, 1u, __ATOMIC_RELAXED, __HIP_MEMORY_SCOPE_AGENT); __syncthreads(); q = (int)MISC[16]; } while (0)
        int q; Q_FETCH();
        while (q < Q0) { const int r = (q - QG) % (NB * 16); sg::sgu_item(lds, SP, r >> 4, r & 15); Q_FETCH(); }
        while (q < Q1) { dn::sample_batch(lds, DP, (q - Q0) % (DB * H / 4)); Q_FETCH(); }
        while (q < Q3) {
            const bf16* Qp; const float* Kp; const float* Vp; bf16* Op; int nq;
            if (q >= Q2) { const int r = (q - Q2) % (DB * MEMH), b = r >> 2, hd = r & 3; nq = 8;
                Qp = QM + (size_t)(MP + 8 * b) * MEMW + hd * 128; Kp = args.in[I_CK] + (size_t)b * MEMT * MEMW + hd * 128; Vp = args.in[I_CV] + (size_t)b * MEMT * MEMW + hd * 128; Op = OC + (size_t)(MP + 8 * b) * 2048 + 1536 + hd * 128; }
            else { const int r = (q - Q1) % (NB * MEMH * 8), b = r >> 5, hd = (r >> 3) & 3, qb = r & 7; const size_t row = (size_t)b * SEQ + 256 * qb; nq = 256;
                Qp = QM + row * MEMW + hd * 128; Kp = out + O_MK + (size_t)b * MEMT * MEMW + hd * 128; Vp = out + O_MV + (size_t)b * MEMT * MEMW + hd * 128; Op = OC + row * 2048 + 1536 + hd * 128; }
            at::attn_item(lds, Qp, nq, Kp, Vp, Op);
            Q_FETCH();
        }
        while (q < Q4) { sg::sgu_sample_item(lds, SP, (q - Q3) % DB); Q_FETCH(); }
#undef Q_FETCH
        __syncthreads();
    }
    SEAM(3);
#ifdef P3_FILL
    if (IN(4)) { u32x4* gp = (u32x4*)(ws + WS_GATES); const size_t n16 = (size_t)M * NGATE * 2 / 16;
        for (size_t i = (size_t)bx * 512 + t_id(); i < n16; i += (size_t)G * 512) { const unsigned w = 0x3f003e80u + (unsigned)(i & 63); gp[i] = (u32x4){w, w, w, w}; } }
    if (0) {
#else
    if (IN(4)) {
#endif
        pg8::Gemm g{XB, (const bf16*)(ws + WS_WIN) + (size_t)N1 * D, MP, NGATE, D, D, D}; pg8::StaticOrder S; S.init(MP, NGATE, G, bx);
#ifdef PROBE_SKIP_EPI
        ep::EpiGate E{(bf16*)(ws + WS_GATES), RSX, args.li};
#else
        ep::EpiGate E{(bf16*)(ws + WS_GATES), RSX, 0};
#endif
        pg8::gemm_phase<ep::EpiGate, pg8::StaticOrder, true, true>(lds, g, S, E);
    }
    SEAM(4);
    if (IN(5)) {
        const bf16* OC = (const bf16*)(ws + WS_OCAT); const bf16* WBR = (const bf16*)(ws + WS_WBR);
        const int koff[3] = {0, 1024, 1536}, klen[3] = {1024, 512, 512};
#pragma unroll
        for (int b = 0; b < 3; ++b) {
#ifdef P4_PASSES
            if (!((P4_PASSES >> b) & 1)) continue;
#endif
            pg8::Gemm g{OC + koff[b], WBR + koff[b], MP, D, klen[b], 2048, 2048}; pg8::StaticOrder S; S.init(MP, D, G, bx);
            ep::EpiBr E{(const bf16*)(ws + WS_GATES), (bf16*)(ws + WS_MERGED), b};
            pg8::gemm_phase<ep::EpiBr, pg8::StaticOrder, true, true>(lds, g, S, E);
        }
        { const mini::MiniPtrs MPp{OC, WBR, (const bf16*)(ws + WS_GATES_S) - (size_t)MP * NGATE, (bf16*)(ws + WS_MERGED), nullptr, nullptr, nullptr, nullptr, nullptr, nullptr, nullptr, nullptr};
#ifndef DUP_MINI
#define DUP_MINI 1
#endif
          for (int rep = 0; rep < DUP_MINI; ++rep) for (int t = bx; t < 256; t += G) mini::br_tile(lds, MPp, mini::tile_of(t)); }
    }
    SEAM(5);
    if (IN(6)) {
        pg8::Gemm g{(const bf16*)(ws + WS_MERGED), (const bf16*)(ws + WS_WO), MP, D, D, D, D}; pg8::StaticOrder S; S.init(MP, D, G, bx);
        ep::EpiRes E{args.in[I_XP], args.in[I_XS], nullptr, nullptr, (bf16*)(ws + WS_X1B), (float*)(ws + WS_SS1)};
        pg8::gemm_phase<ep::EpiRes, pg8::StaticOrder, true, true>(lds, g, S, E);
        for (int t = bx; t < 256; t += G) mini::res_tile(lds, (const bf16*)(ws + WS_MERGED), D, (const bf16*)(ws + WS_WO), D, D, args.in[I_XS], MP, nullptr, nullptr, (bf16*)(ws + WS_X1B), (float*)(ws + WS_SS1), mini::tile_of(t));
        __syncthreads();
    }
    SEAM(6);
    if (IN(7)) {
#ifdef STAGGER
        if ((bx >> 3) & 1) stagger_delay(STAGGER);
#endif
        pg8::Gemm g{(const bf16*)(ws + WS_X1B), (const bf16*)(ws + WS_WGU), M, 2 * FF, D, D, D}; pg8::StaticOrder S; S.init(M, 2 * FF, G, bx);
        ep::EpiGU E{(const float*)(ws + WS_SS1), (bf16*)(ws + WS_HB)};
        pg8::gemm_phase<ep::EpiGU, pg8::StaticOrder, true, true>(lds, g, S, E);
    }
    SEAM(7);
    if (IN(8)) {
        pg8::Gemm g{(const bf16*)(ws + WS_HB), (const bf16*)(ws + WS_WDN), MP, D, FF, FF, FF}; pg8::StaticOrder S; S.init(MP, D, G, bx);
        ep::EpiFinal E{(const bf16*)(ws + WS_X1B), args.in[I_NFIN], out + O_Y, (float*)(ws + WS_SS2), (unsigned*)(ctl + CW_FIN), (unsigned*)(ctl + CW_TMO)};
        pg8::gemm_phase<ep::EpiFinal, pg8::StaticOrder, false, true>(lds, g, S, E);
        for (int t = bx; t < 256; t += G) mini::fin_tile(lds, (const bf16*)(ws + WS_HB), FF, (const bf16*)(ws + WS_WDN), FF, FF, (const bf16*)(ws + WS_X1B), args.in[I_NFIN], out + O_Y, (float*)(ws + WS_SS2), (unsigned*)(ctl + CW_FIN2), (unsigned*)(ctl + CW_TMO), mini::tile_of(t));
    }
#undef IN
#undef SEAM
}

extern "C" void kernel_launch(void* const* d_in, const int* in_sizes, int n_in, void* d_out, int out_size, void* d_ws, size_t ws_size, hipStream_t stream) {
    static int grid = 0;
    if (grid == 0) {
        if (n_in != 26 || in_sizes[0] != MP * D || (size_t)out_size != O_END || ws_size < WS_END) { fprintf(stderr, "kernel_launch: unexpected shapes (n_in %d, in0 %d, out %d, ws %zu < %zu); nothing launched\n", n_in, n_in > 0 ? in_sizes[0] : -1, out_size, ws_size, (size_t)WS_END); grid = -1; return; }
        int dev = 0, cus = 0, per_cu = 0;
        if (hipGetDevice(&dev) != hipSuccess || hipDeviceGetAttribute(&cus, hipDeviceAttributeMultiprocessorCount, dev) != hipSuccess) { grid = -1; return; }
        if (hipFuncSetAttribute((const void*)hyb_fwd, hipFuncAttributeMaxDynamicSharedMemorySize, LDS_BYTES) != hipSuccess) { fprintf(stderr, "kernel_launch: hipFuncSetAttribute failed\n"); grid = -1; return; }
        if (hipOccupancyMaxActiveBlocksPerMultiprocessor(&per_cu, (const void*)hyb_fwd, NWAVES * 64, LDS_BYTES) != hipSuccess || per_cu < 1) fprintf(stderr, "kernel_launch: occupancy query reports %d blocks per CU\n", per_cu);
        (void)hipGetLastError();
        grid = cus;
        if (cus != 256) { fprintf(stderr, "kernel_launch: built for a 256-CU device (one 256x256 unit per CU in the N = 1024 projections, fused row-statistics exchanges); found %d CUs; nothing launched\n", cus); grid = -1; return; }
    }
    if (grid < 0) return;
    if (hipMemsetAsync((char*)d_ws + WS_CTL, 0, CTL_ZERO_BYTES, stream) != hipSuccess) return;
    Args a{};
    for (int i = 0; i < 26; ++i) a.in[i] = (const float*)d_in[i];
    a.out = (float*)d_out; a.ws = (unsigned char*)d_ws;
#if MK_N_LAUNCHES == 1
    a.ph_lo = 0; a.ph_hi = N_PHASES;
    hipLaunchKernelGGL(hyb_fwd, dim3(grid), dim3(NWAVES * 64), LDS_BYTES, stream, a);
#elif MK_N_LAUNCHES == 2
    a.ph_lo = 0; a.ph_hi = PROBE_HI + 1; a.li = 0; hipLaunchKernelGGL(hyb_fwd, dim3(grid), dim3(NWAVES * 64), LDS_BYTES, stream, a);
    a.ph_lo = PROBE_LO; a.ph_hi = N_PHASES; a.li = 1; hipLaunchKernelGGL(hyb_fwd, dim3(grid), dim3(NWAVES * 64), LDS_BYTES, stream, a);
#else
    for (int p = 0; p < N_PHASES; ++p) { a.ph_lo = p; a.ph_hi = p + 1; hipLaunchKernelGGL(hyb_fwd, dim3(grid), dim3(NWAVES * 64), LDS_BYTES, stream, a); }
#endif
}
#endif
```

```cpp
#ifndef HOST_EMU
#include <hip/hip_runtime.h>
#include <cstdio>
#include <cstdint>
#endif

namespace cfg {
constexpr int D = 1024, NB = 8, SEQ = 2048, DB = 128, DT = 8;
constexpr int MP = NB * SEQ, MS = DB * DT, M = MP + MS;
constexpr int H = 8, DK = 128, DV = 128, QKVW = 3072, CH = 64, NCH = SEQ / CH;
constexpr int SGW = 512, SGG = 4, SGC = 128;
constexpr int MEMT = 256, MEMH = 4, MEMD = 128, MEMW = 512;
constexpr int FF = 2816, DIN = 8720, N1 = 5632, NGATE = 3072, NIN = N1 + NGATE;
constexpr float RMS_EPS = 1e-6f, L2_EPS = 1e-6f;
constexpr float LOG2E = 1.4426950408889634f;
constexpr float QSCALE_MEM = 0.08838834764831845f * 1.4426950408889634f;
constexpr float QSCALE_DN = 0.08838834764831845f;
constexpr size_t O_Y = 0, O_DSP = 17825792, O_CSP = 18874368, O_MK = 18948096, O_MV = 19996672, O_DSS = 21045248, O_CSS = 37822464, O_SGV = 39002112, O_END = 39526400;
constexpr size_t MiB = 1u << 20;
constexpr size_t WS_CTL = 0, CTL_ZERO_BYTES = 128 * 1024;
constexpr size_t WS_RSTDX = 1 * MiB, WS_RSTDM = WS_RSTDX + 128 * 1024, WS_DL = WS_RSTDM + 64 * 1024, WS_BA = 1 * MiB + 256 * 1024;
constexpr size_t WS_SS1 = 5 * MiB / 2, WS_SS2 = 15 * MiB / 4;
constexpr size_t WS_WIN = 5 * MiB, WS_WBR = 22 * MiB, WS_WO = 26 * MiB, WS_WKV = 28 * MiB, WS_WGU = 30 * MiB, WS_WDN = 41 * MiB, WS_SGW = 93 * MiB / 2;
constexpr size_t WS_XB = 47 * MiB;
constexpr size_t WS_MB = 81 * MiB;
constexpr size_t WS_QMEM = 85 * MiB;
constexpr size_t WS_HALO = 102 * MiB;
constexpr size_t WS_QKV = 107 * MiB;
constexpr size_t WS_OCAT = WS_QKV, WS_X1B = WS_QKV + 68 * MiB;
constexpr size_t WS_INTER = 209 * MiB;
constexpr size_t WS_WB = WS_INTER, WS_QD = WS_INTER + 32 * MiB, WS_KDT = WS_INTER + 64 * MiB, WS_UB = WS_INTER + 96 * MiB, WS_AB = WS_INTER + 128 * MiB;
constexpr size_t WS_GATES = WS_INTER, WS_HB = WS_INTER, WS_MERGED = WS_XB;
constexpr size_t WS_GATES_S = WS_QKV + 69 * MiB;
constexpr size_t WS_END = 353 * MiB;
static_assert(WS_BA + (size_t)M * 16 * 4 <= WS_SS1 && WS_SS1 + (size_t)M * 64 <= WS_SS2 && WS_SS2 + (size_t)M * 64 <= WS_WIN, "small buffers");
static_assert(WS_WIN + (size_t)NIN * D * 2 <= WS_WBR && WS_WGU + (size_t)2 * FF * D * 2 <= WS_WDN && WS_WDN + (size_t)D * FF * 2 <= WS_SGW && WS_SGW + 4 * 128 * 128 * 2 <= WS_XB, "weights");
static_assert(WS_XB + (size_t)M * D * 2 <= WS_MB && WS_MB + 2048 * 1024 * 2 <= WS_QMEM && WS_QMEM + (size_t)M * 512 * 2 <= WS_HALO && WS_HALO + 272 * 3 * 3072 * 2 <= WS_QKV, "acts");
static_assert(WS_QKV + (size_t)M * 3072 * 2 <= WS_INTER && WS_X1B + (size_t)M * D * 2 <= WS_INTER && WS_OCAT + (size_t)M * 2048 * 2 <= WS_X1B, "qkv region");
static_assert(WS_GATES_S >= WS_OCAT + (size_t)M * 2048 * 2 && WS_GATES_S + (size_t)MS * 3072 * 2 <= WS_QKV + (size_t)MP * 3072 * 2, "sample gates");
static_assert(WS_AB + (size_t)2048 * 8192 <= WS_END && WS_GATES + (size_t)M * 3072 * 2 <= WS_END && WS_HB + (size_t)M * FF * 2 <= WS_END, "inter region");
constexpr int CW_TMO = 0, CW_CODE = 1, CW_BAR = 4096, CW_FIN = 16384, CW_FIN2 = 20480;
constexpr int RING_BYTES = 131072, LDS_BYTES = 163840, MISC_OFF = LDS_BYTES - 512;
constexpr int P2_LDS = MISC_OFF;
}

typedef unsigned short bf16;
typedef short bf16x8 __attribute__((ext_vector_type(8)));
typedef float f32x4 __attribute__((ext_vector_type(4)));
typedef float f32x16 __attribute__((ext_vector_type(16)));
typedef unsigned u32x4 __attribute__((ext_vector_type(4)));
typedef unsigned u32x2 __attribute__((ext_vector_type(2)));

#ifndef HOST_EMU
#define DI __device__ __forceinline__
#define LP(T) __attribute__((address_space(3))) T*
DI int t_id() { int t = (int)threadIdx.x; asm volatile("" : "+v"(t)); return t; }
DI void wg_sync() { __syncthreads(); }
DI void wg_sync_lds() { asm volatile("s_waitcnt lgkmcnt(0)" ::: "memory"); __builtin_amdgcn_s_barrier(); asm volatile("" ::: "memory"); }
DI void wave_sync() { __builtin_amdgcn_wave_barrier(); }
DI f32x4 mfma16(bf16x8 a, bf16x8 b, f32x4 c) { return __builtin_amdgcn_mfma_f32_16x16x32_bf16(a, b, c, 0, 0, 0); }
DI f32x16 mfma32(bf16x8 a, bf16x8 b, f32x16 c) { return __builtin_amdgcn_mfma_f32_32x32x16_bf16(a, b, c, 0, 0, 0); }
DI f32x4 mfma16f(float a, float b, f32x4 c) { return __builtin_amdgcn_mfma_f32_16x16x4f32(a, b, c, 0, 0, 0); }
DI float shfl_xor_f(float v, int m) { return __shfl_xor(v, m); }
DI float shfl_f(float v, int src) { return __shfl(v, src); }
DI float fexp2(float x) { return __builtin_amdgcn_exp2f(x); }
DI float frcp(float x) { return __builtin_amdgcn_rcpf(x); }
DI float frsq(float x) { return __builtin_amdgcn_rsqf(x); }
DI float lane_bcast(float v, int src) { return __builtin_bit_cast(float, __builtin_amdgcn_readlane(__builtin_bit_cast(int, v), __builtin_amdgcn_readfirstlane(src))); }
template <int CTRL> DI float dpp_f(float v) { return __builtin_bit_cast(float, __builtin_amdgcn_update_dpp(0, __builtin_bit_cast(int, v), CTRL, 0xf, 0xf, true)); }
DI float row_sum16(float v) { v += dpp_f<0x128>(v); v += dpp_f<0x124>(v); v += dpp_f<0x4E>(v); v += dpp_f<0xB1>(v); return v; }
DI float row_sum8(float v) { v += dpp_f<0xB1>(v); v += dpp_f<0x4E>(v); v += dpp_f<0x141>(v); return v; }
DI float wave_sum(float v) { v = row_sum16(v);
    v += __builtin_bit_cast(float, __builtin_amdgcn_update_dpp(0, __builtin_bit_cast(int, v), 0x142, 0xa, 0xf, false));
    v += __builtin_bit_cast(float, __builtin_amdgcn_update_dpp(0, __builtin_bit_cast(int, v), 0x143, 0xc, 0xf, false));
    return __builtin_bit_cast(float, __builtin_amdgcn_readlane(__builtin_bit_cast(int, v), 63)); }
DI int wave_id() { return __builtin_amdgcn_readfirstlane((int)threadIdx.x >> 6); }
#endif

#ifndef HOST_EMU
typedef float f32x2_t __attribute__((ext_vector_type(2)));
typedef __bf16 bf16x2_t __attribute__((ext_vector_type(2)));
DI unsigned pk2(float lo, float hi) { const f32x2_t v = {lo, hi}; const bf16x2_t b = __builtin_convertvector(v, bf16x2_t); return __builtin_bit_cast(unsigned, b); }
DI unsigned f2bf(float f) { return (unsigned)__builtin_bit_cast(unsigned short, (__bf16)f); }
#else
DI unsigned f2bf(float f) { unsigned u = __builtin_bit_cast(unsigned, f); return (u + 0x7fffu + ((u >> 16) & 1u)) >> 16; }
DI unsigned pk2(float lo, float hi) { return f2bf(lo) | (f2bf(hi) << 16); }
#endif
DI float bf_lo(unsigned w) { return __builtin_bit_cast(float, w << 16); }
DI float bf_hi(unsigned w) { return __builtin_bit_cast(float, w & 0xffff0000u); }
DI float bf2f(bf16 b) { return __builtin_bit_cast(float, ((unsigned)b) << 16); }
DI float sigmoid_f(float x) { return frcp(1.0f + fexp2(-cfg::LOG2E * x)); }
DI float silu_f(float x) { return x * sigmoid_f(x); }
DI float gelu_tanh_f(float x) { return x * frcp(1.0f + fexp2(-2.302208198f * (x + 0.044715f * x * x * x))); }
#ifdef HOST_EMU
DI int wave_id() { return t_id() >> 6; }
DI float lane_bcast(float v, int src) { return shfl_f(v, src); }
DI float row_sum16(float v) { v += shfl_xor_f(v, 8); v += shfl_xor_f(v, 4); v += shfl_xor_f(v, 2); v += shfl_xor_f(v, 1); return v; }
DI float row_sum8(float v) { v += shfl_xor_f(v, 1); v += shfl_xor_f(v, 2); v += shfl_xor_f(v, 4); return v; }
DI float wave_sum(float v) { v = row_sum16(v); return (shfl_f(v, 48) + shfl_f(v, 32)) + (shfl_f(v, 16) + shfl_f(v, 0)); }
#endif
DI int perm32k(int k) { const int kk = k & 31; return (k & ~31) + 8 * ((kk & 15) >> 2) + 4 * (kk >> 4) + (kk & 3); }
DI int iperm32k(int p) { const int pp = p & 31; return (p & ~31) + 16 * ((pp >> 2) & 1) + 4 * (pp >> 3) + (pp & 3); }
DI int perm16k(int k) { const int kk = k & 15; return (k & ~15) + 8 * ((kk >> 2) & 1) + 4 * (kk >> 3) + (kk & 3); }
#ifndef HOST_EMU
namespace pg8 {
#define PG8_LAS __attribute__((address_space(3)))
typedef unsigned short bf16_t;
typedef unsigned u32x4 __attribute__((ext_vector_type(4)));
constexpr int BM = 256, BK = 64, HALF = 128, HTB = HALF * BK * 2  , STAGE_BYTES = 8 * HTB, NXCD = 8, WGM = 8;

__host__ __device__ __forceinline__ int lds_byte(int r, int c) { const int st = (r >> 4) * 2 + (c >> 5), rr = r & 15, cc = c & 31, ob = rr * 64 + cc * 2; return st * 1024 + (ob ^ (((ob >> 9) & 1) << 5)); }
__host__ __device__ __forceinline__ void stage_rc(int b, int& R, int& C) { const int st = b / 1024, sb = b % 1024, swz = sb ^ (((sb >> 9) & 1) << 5); R = (st >> 1) * 16 + swz / 64; C = (st & 1) * 32 + (swz % 64) / 2; }
__host__ __device__ __forceinline__ int perm32(int rho) { const int n = rho >> 4, i = rho & 15; return 8 * (i >> 2) + 4 * n + (i & 3); }

struct Unit { int pm, pn; };
struct Gemm { const bf16_t* A; const bf16_t* Bt; int M, N, K, lda, ldb; };

struct StaticOrder {
    int nM, nN, nwg, G, c;
    __host__ __device__ void init(int M, int N, int G_, int c_) { nM = M / BM; nN = N / BM; nwg = nM * nN; G = G_; c = c_; }
    __host__ __device__ bool next(int i, Unit& u) const {
        const long L = (long)i * G + c; if (L >= nwg) return false;
        int wgid = (int)L; { const int q = nwg / NXCD, r = nwg % NXCD, xcd = wgid % NXCD, off = wgid / NXCD; wgid = (xcd < r ? xcd * (q + 1) : r * (q + 1) + (xcd - r) * q) + off; }
        const int nig = WGM * nN, gid = wgid / nig, fm = gid * WGM, gsz = (nM - fm) < WGM ? (nM - fm) : WGM;
        u.pm = fm + ((wgid % nig) % gsz); u.pn = (wgid % nig) / gsz; return true;
    }
    __device__ __forceinline__ void a_ready(const Unit&) const {}
    __device__ __forceinline__ void done(const Unit&) const {}
};

struct OneUnit {
    int pm, pn;
    __host__ __device__ bool next(int i, Unit& u) const { if (i) return false; u.pm = pm; u.pn = pn; return true; }
    __device__ __forceinline__ void a_ready(const Unit&) const {}
    __device__ __forceinline__ void done(const Unit&) const {}
};

struct ListG1 {
    int c, n;
    static constexpr int NU = 64 * 6 + 4 * 22;
    __host__ __device__ bool next(int i, Unit& u) const {
        const int U = i * n + c; if (U >= NU) return false;
        if (U < 384) { u.pm = U / 6; u.pn = 16 + U % 6; } else { const int s = U - 384; u.pm = 64 + s / 22; u.pn = s % 22; }
        return true;
    }
    __device__ __forceinline__ void a_ready(const Unit&) const {}
    __device__ __forceinline__ void done(const Unit&) const {}
};

__device__ __forceinline__ unsigned cvt_pk_bf16(float lo, float hi) { return pk2(lo, hi); }
template <class Epi, class Sched, bool ALIGN_EPI = false, bool SP2 = false>
__device__ __forceinline__ void gemm_phase(PG8_LAS unsigned char* lds, const Gemm g, const Sched& S, const Epi& E) {
    const int tid = t_id(), wid = __builtin_amdgcn_readfirstlane(tid >> 6), lane = tid & 63, wr = wid >> 2, wc = wid & 3, fr = lane & 15, fq = lane >> 4;
    const int K = g.K, nt = K / BK;
    unsigned voffA[2], voffB[2];
#pragma unroll
    for (int i = 0; i < 2; ++i) { int R, C; stage_rc(tid * 16 + i * 8192, R, C); const int Rb = Epi::PERM ? ((R & ~31) + perm32(R & 31)) : R;
        voffA[i] = (unsigned)(R * g.lda + C) * 2u; voffB[i] = (unsigned)(Rb * g.ldb + C) * 2u; }
    const size_t kstep = (size_t)(BK * 2);
    const size_t hstepA = (size_t)HALF * g.lda * 2, hstepB = (size_t)HALF * g.ldb * 2;
    const size_t tstepA = 2 * hstepA, tstepB = 2 * hstepB;
    const unsigned ldsw = (unsigned)wid * 1024u;
    const int aoff = lds_byte(wr * 64 + fr, fq * 8), boff = lds_byte(wc * 32 + fr, fq * 8);
#define PG8_SA(b, h) (((b) * 2 + (h)) * HTB)
#define PG8_SB(b, h) ((4 + (b) * 2 + (h)) * HTB)
#define PG8_STAGE(bufoff, gbase, voff) do { _Pragma("unroll") for (int _i = 0; _i < 2; ++_i) \
        __builtin_amdgcn_global_load_lds((const unsigned*)((const char*)(gbase) + (voff)[_i]), (PG8_LAS unsigned*)(lds + (bufoff) + ldsw + _i * 8192), 16, 0, 0); } while (0)
#define PG8_LDA(dst, b, h) do { _Pragma("unroll") for (int m = 0; m < 4; ++m) _Pragma("unroll") for (int k = 0; k < 2; ++k) dst[m][k] = *(const PG8_LAS bf16x8*)(lds + PG8_SA(b, h) + aoff + m * 2048 + k * 1024); } while (0)
#define PG8_LDB(dst, b, h) do { _Pragma("unroll") for (int n = 0; n < 2; ++n) _Pragma("unroll") for (int k = 0; k < 2; ++k) dst[n][k] = *(const PG8_LAS bf16x8*)(lds + PG8_SB(b, h) + boff + n * 2048 + k * 1024); } while (0)
#define PG8_MMA(ai, bj, At, Bt) do { __builtin_amdgcn_s_setprio(1); _Pragma("unroll") for (int m = 0; m < 4; ++m) _Pragma("unroll") for (int n = 0; n < 2; ++n) _Pragma("unroll") for (int k = 0; k < 2; ++k) \
        acc[ai][bj][m][n] = __builtin_amdgcn_mfma_f32_16x16x32_bf16(Bt[n][k], At[m][k], acc[ai][bj][m][n], 0, 0, 0); __builtin_amdgcn_s_setprio(0); } while (0)
#define PG8_WAIT_V(n) asm volatile("s_waitcnt vmcnt(" #n ")" ::: "memory")
#define PG8_WAIT_L(n) asm volatile("s_waitcnt lgkmcnt(" #n ")" ::: "memory")
#define PG8_BAR __builtin_amdgcn_s_barrier()
#define PG8_SCHED __builtin_amdgcn_sched_barrier(0)
    Unit cur, nxt; int ui = 0;
    if (!S.next(0, cur)) return;
    f32x4 acc[2][2][4][2];
#pragma unroll
    for (int a = 0; a < 2; ++a)
#pragma unroll
        for (int b = 0; b < 2; ++b)
#pragma unroll
            for (int m = 0; m < 4; ++m)
#pragma unroll
                for (int n = 0; n < 2; ++n) acc[a][b][m][n] = (f32x4){0.f, 0.f, 0.f, 0.f};
    bf16x8 At[4][2], B0[2][2], B1[2][2];
    const char* cA = (const char*)g.A + (size_t)cur.pm * tstepA; const char* cB = (const char*)g.Bt + (size_t)cur.pn * tstepB;
    S.a_ready(cur);
    if constexpr (SP2) {
        PG8_STAGE(PG8_SB(0, 0), cB, voffB); PG8_STAGE(PG8_SB(0, 1), cB + hstepB, voffB); PG8_STAGE(PG8_SA(0, 0), cA, voffA); PG8_STAGE(PG8_SA(0, 1), cA + hstepA, voffA);
        if (wr == 1) PG8_BAR;
        PG8_WAIT_V(2); PG8_BAR;
        PG8_STAGE(PG8_SB(1, 0), cB + kstep, voffB); PG8_STAGE(PG8_SA(1, 0), cA + kstep, voffA); PG8_STAGE(PG8_SB(1, 1), cB + hstepB + kstep, voffB);
        PG8_WAIT_V(6); PG8_BAR;
    } else {
        PG8_STAGE(PG8_SB(0, 0), cB, voffB); PG8_STAGE(PG8_SA(0, 0), cA, voffA); PG8_STAGE(PG8_SB(0, 1), cB + hstepB, voffB); PG8_STAGE(PG8_SA(0, 1), cA + hstepA, voffA);
        if (wr == 1) PG8_BAR;
        PG8_WAIT_V(4); PG8_BAR;
        PG8_STAGE(PG8_SB(1, 0), cB + kstep, voffB); PG8_STAGE(PG8_SA(1, 0), cA + kstep, voffA); PG8_STAGE(PG8_SB(1, 1), cB + hstepB + kstep, voffB);
        PG8_WAIT_V(6); PG8_BAR;
    }
    for (;;) {
        const bool has_next = S.next(ui + 1, nxt);
        const char* nA = has_next ? (const char*)g.A + (size_t)nxt.pm * tstepA : cA; const char* nB = has_next ? (const char*)g.Bt + (size_t)nxt.pn * tstepB : cB;
        for (int t = 0; t < nt; t += 2) {
            const bool last = (t == nt - 2);
            const char* a1 = cA + (size_t)(t + 1) * kstep;
            const char* a2 = last ? nA : cA + (size_t)(t + 2) * kstep; const char* b2 = last ? nB : cB + (size_t)(t + 2) * kstep;
            const char* a3 = a2 + kstep; const char* b3 = b2 + kstep;
            if (last && has_next) S.a_ready(nxt);
            if constexpr (SP2) {
            PG8_LDB(B0, 0, 0); PG8_LDB(B1, 0, 1); PG8_SCHED; PG8_LDA(At, 0, 0); PG8_STAGE(PG8_SA(1, 1), a1 + hstepA, voffA);
            PG8_WAIT_V(8); PG8_WAIT_L(0); PG8_BAR; PG8_MMA(0, 0, At, B0); PG8_MMA(0, 1, At, B1); PG8_BAR; PG8_SCHED;
            PG8_LDA(At, 0, 1); PG8_STAGE(PG8_SB(0, 0), b2, voffB); PG8_STAGE(PG8_SB(0, 1), b2 + hstepB, voffB); PG8_STAGE(PG8_SA(0, 0), a2, voffA);
            PG8_WAIT_V(8); PG8_WAIT_L(0); PG8_BAR; PG8_MMA(1, 0, At, B0); PG8_MMA(1, 1, At, B1); PG8_BAR; PG8_SCHED;
            PG8_LDB(B0, 1, 0); PG8_LDB(B1, 1, 1); PG8_SCHED; PG8_LDA(At, 1, 0); PG8_STAGE(PG8_SA(0, 1), a2 + hstepA, voffA);
            PG8_WAIT_V(8); PG8_WAIT_L(0); PG8_BAR; PG8_MMA(0, 0, At, B0); PG8_MMA(0, 1, At, B1); PG8_BAR; PG8_SCHED;
            PG8_LDA(At, 1, 1); PG8_STAGE(PG8_SB(1, 0), b3, voffB); PG8_STAGE(PG8_SB(1, 1), b3 + hstepB, voffB); PG8_STAGE(PG8_SA(1, 0), a3, voffA);
            PG8_WAIT_V(8); PG8_WAIT_L(0); PG8_BAR; PG8_MMA(1, 0, At, B0); PG8_MMA(1, 1, At, B1); PG8_BAR; PG8_SCHED;
            } else {
            PG8_LDB(B0, 0, 0); PG8_SCHED; PG8_LDA(At, 0, 0); PG8_STAGE(PG8_SA(1, 1), a1 + hstepA, voffA);
            PG8_WAIT_L(8); PG8_BAR; PG8_WAIT_L(0); PG8_MMA(0, 0, At, B0); PG8_BAR; PG8_SCHED;
            PG8_LDB(B1, 0, 1); PG8_STAGE(PG8_SB(0, 0), b2, voffB);
            PG8_BAR; PG8_WAIT_L(0); PG8_MMA(0, 1, At, B1); PG8_BAR;
            PG8_LDA(At, 0, 1); PG8_STAGE(PG8_SA(0, 0), a2, voffA);
            PG8_BAR; PG8_WAIT_L(0); PG8_MMA(1, 0, At, B0); PG8_BAR; PG8_SCHED;
            PG8_STAGE(PG8_SB(0, 1), b2 + hstepB, voffB);
            PG8_WAIT_V(6); PG8_BAR; PG8_MMA(1, 1, At, B1); PG8_BAR;
            PG8_LDB(B0, 1, 0); PG8_SCHED; PG8_LDA(At, 1, 0); PG8_STAGE(PG8_SA(0, 1), a2 + hstepA, voffA);
            PG8_WAIT_L(8); PG8_BAR; PG8_WAIT_L(0); PG8_MMA(0, 0, At, B0); PG8_BAR; PG8_SCHED;
            PG8_LDB(B1, 1, 1); PG8_STAGE(PG8_SB(1, 0), b3, voffB);
            PG8_BAR; PG8_WAIT_L(0); PG8_MMA(0, 1, At, B1); PG8_BAR;
            PG8_LDA(At, 1, 1); PG8_STAGE(PG8_SA(1, 0), a3, voffA);
            PG8_BAR; PG8_WAIT_L(0); PG8_MMA(1, 0, At, B0); PG8_BAR; PG8_SCHED;
            PG8_STAGE(PG8_SB(1, 1), b3 + hstepB, voffB);
            PG8_WAIT_V(6); PG8_BAR; PG8_MMA(1, 1, At, B1); PG8_BAR;
            }
        }
        if constexpr (ALIGN_EPI) { if (wr == 0) PG8_BAR; }
        if constexpr (!Epi::AFTER_DRAIN) { E(acc, cur, wr, wc, fr, fq); S.done(cur); }
        if (!has_next) break;
#pragma unroll
        for (int a = 0; a < 2; ++a)
#pragma unroll
            for (int b = 0; b < 2; ++b)
#pragma unroll
                for (int m = 0; m < 4; ++m)
#pragma unroll
                    for (int n = 0; n < 2; ++n) acc[a][b][m][n] = (f32x4){0.f, 0.f, 0.f, 0.f};
        cur = nxt; cA = nA; cB = nB; ++ui;
        if constexpr (ALIGN_EPI) { if (wr == 1) PG8_BAR; }
    }
    PG8_WAIT_V(0);
    if constexpr (!ALIGN_EPI) { if (wr == 0) PG8_BAR; }
    PG8_BAR;
    if constexpr (Epi::AFTER_DRAIN) { E.fused(acc, cur, wr, wc, fr, fq, lds, wid, lane); S.done(cur); }
#undef PG8_SA
#undef PG8_SB
#undef PG8_STAGE
#undef PG8_LDA
#undef PG8_LDB
#undef PG8_MMA
#undef PG8_WAIT_V
#undef PG8_WAIT_L
#undef PG8_BAR
#undef PG8_SCHED
}
}
#define GAS __attribute__((address_space(1)))
#define LAS __attribute__((address_space(3)))
typedef unsigned short bf16;
typedef unsigned v4u __attribute__((ext_vector_type(4)));
typedef float f32x4 __attribute__((ext_vector_type(4)));
typedef short bf16x8 __attribute__((ext_vector_type(8)));
typedef GAS unsigned gu32;
typedef GAS unsigned long long gu64;
#define RLX_AGENT __ATOMIC_RELAXED, __HIP_MEMORY_SCOPE_AGENT
#define LDS_WAIT() asm volatile("s_waitcnt lgkmcnt(0)" ::: "memory")
#define VM_WAIT() asm volatile("s_waitcnt vmcnt(0)" ::: "memory")
__device__ __forceinline__ unsigned long long rt() { return __builtin_amdgcn_s_memrealtime(); }

#define XB_TMO      128
#define XB_XCNT(j)  (256  + 64 * (j))
#define XB_XSUB(j)  (1280 + 64 * (j))
#define XB_XGEN(j)  (2304 + 64 * (j))
#define XB_TOP      3328
#define XB_TOPGEN   3392
#define XCD_BAR_WORDS 3456
#define XB_SPIN_CAP (1u << 18)

__device__ __forceinline__ unsigned xb_ld(unsigned* p)              { return __hip_atomic_load(p, __ATOMIC_RELAXED, __HIP_MEMORY_SCOPE_AGENT); }
__device__ __forceinline__ unsigned xb_add(unsigned* p, unsigned v) { return __hip_atomic_fetch_add(p, v, __ATOMIC_RELAXED, __HIP_MEMORY_SCOPE_AGENT); }
__device__ __forceinline__ unsigned xb_xcc_id() { return (unsigned)__builtin_amdgcn_s_getreg((3 << 11) | 20) & 0xFu; }
#define XB_SPIN(cond, bar) do { unsigned _sp = 0; while (cond) { __builtin_amdgcn_s_sleep(1); \
    if ((++_sp & 255u) == 0u) { if (xb_ld(&(bar)[XB_TMO])) break; if (_sp > XB_SPIN_CAP) { atomicAdd(&(bar)[XB_TMO], 1u); break; } } } } while (0)

struct XcdBarrier {
    unsigned* bar; unsigned x;
    volatile LAS unsigned* st;
};

__device__ __forceinline__ XcdBarrier xcd_barrier_post(unsigned* bar, volatile LAS unsigned* st) {
    XcdBarrier b; b.bar = bar; b.x = xb_xcc_id(); b.st = st;
    if (threadIdx.x == 0) (void)xb_add(&bar[XB_XCNT(b.x)], 1u);
    return b;
}
__device__ __forceinline__ void xcd_barrier_complete(unsigned* bar, unsigned x, unsigned& nloc, unsigned& nx) {
    const unsigned G = gridDim.x * gridDim.y * gridDim.z;
    unsigned sum, cnt, mine, sp = 0u;
    for (;;) {
        sum = 0u; cnt = 0u; mine = 0u;
#pragma unroll
        for (unsigned j = 0; j < 16; ++j) { const unsigned c = xb_ld(&bar[XB_XCNT(j)]); sum += c; cnt += (c > 0u) ? 1u : 0u; mine = (j == x) ? c : mine; }
        if (sum == G) break;
        __builtin_amdgcn_s_sleep(1);
        if ((++sp & 255u) == 0u) { if (xb_ld(&bar[XB_TMO])) break; if (sp > XB_SPIN_CAP) { atomicAdd(&bar[XB_TMO], 1u); break; } }
    }
    nloc = mine > 0u ? mine : 1u; nx = cnt > 0u ? cnt : 1u;
}

__device__ __forceinline__ void xcd_barrier(const XcdBarrier& b) {
    asm volatile("s_waitcnt vmcnt(0)" ::: "memory");
    __syncthreads();
    if (threadIdx.x == 0) {
        unsigned* bar = b.bar;
        __builtin_amdgcn_s_waitcnt(0);
        unsigned nloc = b.st[0], nx = b.st[1];
        if (nloc == 0u) { xcd_barrier_complete(bar, b.x, nloc, nx); b.st[0] = nloc; b.st[1] = nx; }
        const unsigned old = xb_add(&bar[XB_XSUB(b.x)], 1u);
        const unsigned gen = old / nloc;
        if (old + 1u == (gen + 1u) * nloc) {
            __builtin_amdgcn_fence(__ATOMIC_RELEASE, "agent");
            asm volatile("s_waitcnt vmcnt(0)" ::: "memory");
            const unsigned og = xb_add(&bar[XB_TOP], 1u);
            const unsigned tg = og / nx;
            if (og + 1u == (tg + 1u) * nx) xb_add(&bar[XB_TOPGEN], 1u);
            else XB_SPIN(xb_ld(&bar[XB_TOPGEN]) == tg, bar);
            __builtin_amdgcn_fence(__ATOMIC_ACQUIRE, "agent");
            xb_add(&bar[XB_XGEN(b.x)], 1u);
            asm volatile("s_waitcnt vmcnt(0)" ::: "memory");
        } else {
            XB_SPIN(xb_ld(&bar[XB_XGEN(b.x)]) == gen, bar);
            __builtin_amdgcn_fence(__ATOMIC_ACQUIRE, "agent");
            asm volatile("s_waitcnt vmcnt(0)" ::: "memory");
        }
    }
    __syncthreads();
}
#endif
struct DnPtrs {
    const bf16* QKV; const bf16* HALO; const float* BA; const float* conv_w; const float* a_log; const float* dt_bias; const float* dn_norm;
    bf16* WB; bf16* QD; bf16* KDT; unsigned* UB; bf16* AB; float* DL;
    const bf16* Z; bf16* OCAT; float* DSP;
    const float* state_delta; const float* state_conv; float* DSS;
};
namespace dn {
using namespace cfg;
constexpr int QN_LD = 136, TB_LD = 72, LM_LD = 68;
constexpr int L_QN = 0, L_KN = L_QN + 64 * QN_LD * 2, L_VBT = L_KN + 64 * QN_LD * 2, L_KBGT = L_VBT + 128 * TB_LD * 2, L_KDT = L_KBGT + 128 * TB_LD * 2,
              L_LM = L_KDT + 128 * 64 * 2, L_TM = L_LM + 64 * LM_LD * 4, L_TB = L_TM + 64 * LM_LD * 4, L_GC = L_TB + 64 * TB_LD * 2, L_BETA = L_GC + 256, L_PREP_END = L_BETA + 256;
static_assert(L_PREP_END <= P2_LDS, "prep LDS");

DI float softplus_f(float x) { return (x > 0.f ? x : 0.f) + log1pf(expf(-fabsf(x))); }

struct PrepRaw { unsigned q[11], k[11], v[11]; float ba0, ba1; };
DI void prep_fetch(const DnPtrs& P, PrepRaw& R, int b, int h, int n) {
    const int tid = t_id(), w = wave_id(), l = tid & 63;
    const int row0 = b * SEQ + n * CH, gch = row0 >> 6, c0 = iperm32k(2 * l);
    const float* ba = P.BA + (size_t)(row0 + l) * 16;
    R.ba0 = ba[h]; R.ba1 = ba[8 + h];
#pragma unroll
    for (int i = 0; i < 11; ++i) {
        const int rt = 8 * w - 3 + i;
        unsigned uq = 0, uk = 0, uv = 0;
        if (rt >= 0) { const bf16* p = P.QKV + (size_t)(row0 + rt) * QKVW + h * 128 + c0; uq = *(const unsigned*)p; uk = *(const unsigned*)(p + 1024); uv = *(const unsigned*)(p + 2048); }
        else if (n > 0) { const bf16* p = P.HALO + ((size_t)(gch - 1) * 3 + (rt + 3)) * QKVW + h * 128 + c0; uq = *(const unsigned*)p; uk = *(const unsigned*)(p + 1024); uv = *(const unsigned*)(p + 2048); }
        R.q[i] = uq; R.k[i] = uk; R.v[i] = uv;
    }
}
DI void prep_item(LP(unsigned char) lds, const DnPtrs& P, int b, int h, int n, PrepRaw& R, bool more, int bn, int hn, int nn) {
    const int tid = t_id(), w = wave_id(), l = tid & 63, fr = l & 15, fq = l >> 4;
    const int row0 = b * SEQ + n * CH, it = (b * H + h) * NCH + n, gch = row0 >> 6;
    LP(bf16) QN = (LP(bf16))(lds + L_QN); LP(bf16) KN = (LP(bf16))(lds + L_KN); LP(bf16) VBT = (LP(bf16))(lds + L_VBT); LP(bf16) KBGT = (LP(bf16))(lds + L_KBGT);
    LP(bf16) KDTl = (LP(bf16))(lds + L_KDT); LP(float) LM = (LP(float))(lds + L_LM); LP(float) TM = (LP(float))(lds + L_TM); LP(bf16) TB = (LP(bf16))(lds + L_TB);
    LP(float) GC = (LP(float))(lds + L_GC); LP(float) BETA = (LP(float))(lds + L_BETA);
    wg_sync();
#ifndef DUPP
#define DUPP 0
#endif
    float beta_t, gc_t;
    {
        beta_t = 1.0f / (1.0f + expf(-R.ba0));
        const float g = -expf(P.a_log[h]) * softplus_f(R.ba1 + P.dt_bias[h]);
        gc_t = g;
#pragma unroll
        for (int o = 1; o < 64; o <<= 1) { const float up = shfl_f(gc_t, (l - o) & 63); if (l >= o) gc_t += up; }
        if (w == 0) { GC[l] = gc_t; BETA[l] = beta_t; }
    }
    const float gc_last = lane_bcast(gc_t, 63);
    {
        const int c0 = iperm32k(2 * l);
        float wq[4][2], wk[4][2], wv[4][2];
#pragma unroll
        for (int i = 0; i < 4; ++i)
#pragma unroll
            for (int e = 0; e < 2; ++e) { wq[i][e] = P.conv_w[i * QKVW + h * 128 + c0 + e]; wk[i][e] = P.conv_w[i * QKVW + 1024 + h * 128 + c0 + e]; wv[i][e] = P.conv_w[i * QKVW + 2048 + h * 128 + c0 + e]; }
        float xq[11][2], xk[11][2], xv[11][2];
#pragma unroll
        for (int i = 0; i < 11; ++i) { xq[i][0] = bf_lo(R.q[i]); xq[i][1] = bf_hi(R.q[i]); xk[i][0] = bf_lo(R.k[i]); xk[i][1] = bf_hi(R.k[i]); xv[i][0] = bf_lo(R.v[i]); xv[i][1] = bf_hi(R.v[i]); }
        if (more) prep_fetch(P, R, bn, hn, nn);
        float kbg_prev[2] = {0.f, 0.f}, kd_prev[2] = {0.f, 0.f}, vb_prev[2] = {0.f, 0.f};
#pragma unroll
        for (int j = 0; j < 8; ++j) {
            const int t = 8 * w + j;
            float q[2], k[2], v[2];
#pragma unroll
            for (int e = 0; e < 2; ++e) {
                q[e] = silu_f(xq[j][e] * wq[0][e] + xq[j + 1][e] * wq[1][e] + xq[j + 2][e] * wq[2][e] + xq[j + 3][e] * wq[3][e]);
                k[e] = silu_f(xk[j][e] * wk[0][e] + xk[j + 1][e] * wk[1][e] + xk[j + 2][e] * wk[2][e] + xk[j + 3][e] * wk[3][e]);
                v[e] = silu_f(xv[j][e] * wv[0][e] + xv[j + 1][e] * wv[1][e] + xv[j + 2][e] * wv[2][e] + xv[j + 3][e] * wv[3][e]);
            }
            const float sq = wave_sum(q[0] * q[0] + q[1] * q[1]), sk = wave_sum(k[0] * k[0] + k[1] * k[1]);
            const float rq = frsq(sq + L2_EPS), rk = frsq(sk + L2_EPS);
            const float bt = lane_bcast(beta_t, t), gt = lane_bcast(gc_t, t);
            const float eg = fexp2(LOG2E * gt), egl = fexp2(LOG2E * (gc_last - gt));
            q[0] *= rq; q[1] *= rq; k[0] *= rk; k[1] *= rk;
            *(LP(unsigned))(QN + t * QN_LD + 2 * l) = pk2(q[0], q[1]);
            *(LP(unsigned))(KN + t * QN_LD + 2 * l) = pk2(k[0], k[1]);
            *(unsigned*)(P.QD + (size_t)(row0 + t) * D + h * 128 + 2 * l) = pk2(q[0] * eg * QSCALE_DN, q[1] * eg * QSCALE_DN);
            const float kbg[2] = {k[0] * bt * eg, k[1] * bt * eg}, kd[2] = {k[0] * egl, k[1] * egl}, vb[2] = {v[0] * bt, v[1] * bt};
            if (j & 1) {
#pragma unroll
                for (int e = 0; e < 2; ++e) {
                    *(LP(unsigned))(KBGT + (c0 + e) * TB_LD + (t - 1)) = pk2(kbg_prev[e], kbg[e]);
                    *(LP(unsigned))(VBT + (c0 + e) * TB_LD + (t - 1)) = pk2(vb_prev[e], vb[e]);
                    *(LP(unsigned))(KDTl + (c0 + e) * 64 + perm32k(t - 1)) = pk2(kd_prev[e], kd[e]);
                }
            }
            kbg_prev[0] = kbg[0]; kbg_prev[1] = kbg[1]; kd_prev[0] = kd[0]; kd_prev[1] = kd[1]; vb_prev[0] = vb[0]; vb_prev[1] = vb[1];
        }
    }
    wg_sync_lds();
    {
        const int s = w >> 2;
        {
            const int in = w & 3;
            f32x4 acc[2] = {{0.f, 0.f, 0.f, 0.f}, {0.f, 0.f, 0.f, 0.f}};
            bf16x8 qf[4], kf[2][4];
#pragma unroll
            for (int ks = 0; ks < 4; ++ks) qf[ks] = *(LP(bf16x8))(QN + (16 * in + fr) * QN_LD + 32 * ks + 8 * fq);
#pragma unroll
            for (int mm = 0; mm < 2; ++mm) if (in >= 2 * s + mm) {
#pragma unroll
                for (int ks = 0; ks < 4; ++ks) kf[mm][ks] = *(LP(bf16x8))(KN + (16 * (2 * s + mm) + fr) * QN_LD + 32 * ks + 8 * fq); }
#pragma unroll
            for (int mm = 0; mm < 2; ++mm) if (in >= 2 * s + mm) {
#pragma unroll
                for (int ks = 0; ks < 4; ++ks) acc[mm] = mfma16(kf[mm][ks], qf[ks], acc[mm]); }
            const int ti = 16 * in + fr; const float gi = GC[ti];
            float o[8];
#pragma unroll
            for (int mm = 0; mm < 2; ++mm)
#pragma unroll
                for (int r = 0; r < 4; ++r) { const int tj = 32 * s + 16 * mm + 4 * fq + r; o[4 * mm + r] = (ti >= tj) ? acc[mm][r] * fexp2(LOG2E * (gi - GC[tj])) * QSCALE_DN : 0.f; }
            u32x4 pk; pk.x = pk2(o[0], o[1]); pk.y = pk2(o[2], o[3]); pk.z = pk2(o[4], o[5]); pk.w = pk2(o[6], o[7]);
            *(u32x4*)(P.AB + (size_t)it * 4096 + ti * 64 + 32 * s + 8 * fq) = pk;
        }
        const int im = w >> 1;
        bf16x8 ka[4], kb[2][4];
#pragma unroll
        for (int ks = 0; ks < 4; ++ks) ka[ks] = *(LP(bf16x8))(KN + (16 * im + fr) * QN_LD + 32 * ks + 8 * fq);
#pragma unroll
        for (int jj = 0; jj < 2; ++jj) if (2 * (w & 1) + jj <= im) {
#pragma unroll
            for (int ks = 0; ks < 4; ++ks) kb[jj][ks] = *(LP(bf16x8))(KN + (16 * (2 * (w & 1) + jj) + fr) * QN_LD + 32 * ks + 8 * fq); }
#pragma unroll
        for (int jj = 0; jj < 2; ++jj) {
            const int jn = 2 * (w & 1) + jj;
            if (jn <= im) {
                f32x4 acc = {0.f, 0.f, 0.f, 0.f};
#pragma unroll
                for (int ks = 0; ks < 4; ++ks) acc = mfma16(ka[ks], kb[jj][ks], acc);
                const int tj = 16 * jn + fr; const float gj = GC[tj];
#pragma unroll
                for (int r = 0; r < 4; ++r) { const int ti = 16 * im + 4 * fq + r; LM[ti * LM_LD + tj] = (ti > tj) ? BETA[ti] * acc[r] * fexp2(LOG2E * (GC[ti] - gj)) : 0.f; }
            }
        }
    }
    wg_sync_lds();
    {
    if (w == 0) {
        const int I = fq, c = fr;
        f32x4 Lr[16][4];
#pragma unroll
        for (int r = 1; r < 16; ++r)
#pragma unroll
            for (int ch = 0; ch < 4; ++ch) if (4 * ch < r) Lr[r][ch] = *(LP(f32x4))(LM + (16 * I + r) * LM_LD + 16 * I + 4 * ch);
        float X[16];
#pragma unroll
        for (int r = 0; r < 16; ++r) {
            float a = (c == r) ? 1.f : 0.f;
#pragma unroll
            for (int j = 0; j < r; ++j) a -= Lr[r][j >> 2][j & 3] * X[j];
            X[r] = a;
        }
#pragma unroll
        for (int r = 0; r < 16; ++r) TM[(16 * I + r) * LM_LD + 16 * I + c] = X[r];
    }
    wg_sync_lds();
#pragma unroll
    for (int lev = 1; lev <= 3; ++lev) {
        if (w < 4 - lev) {
            const int J = w, I = w + lev;
            f32x4 la[3], tb[3], dd;
#pragma unroll
            for (int kk = 0; kk < 3; ++kk) if (kk < lev) { const int K = J + kk;
                la[kk] = *(LP(f32x4))(LM + (16 * I + fr) * LM_LD + 16 * K + 4 * fq);
#pragma unroll
                for (int s = 0; s < 4; ++s) tb[kk][s] = TM[(16 * K + 4 * fq + s) * LM_LD + 16 * J + fr]; }
            dd = *(LP(f32x4))(TM + (16 * I + fr) * LM_LD + 16 * I + 4 * fq);
            f32x4 y = {0.f, 0.f, 0.f, 0.f};
#pragma unroll
            for (int kk = 0; kk < 3; ++kk) if (kk < lev) {
#pragma unroll
                for (int s = 0; s < 4; ++s) y = mfma16f(la[kk][s], tb[kk][s], y); }
            f32x4 x = {0.f, 0.f, 0.f, 0.f};
#pragma unroll
            for (int s = 0; s < 4; ++s) x = mfma16f(dd[s], y[s], x);
#pragma unroll
            for (int r = 0; r < 4; ++r) TM[(16 * I + 4 * fq + r) * LM_LD + 16 * J + fr] = -x[r];
        }
        wg_sync_lds();
    }
    }
    {
        const int i = tid >> 3, j0 = (tid & 7) * 8;
        float v[8];
#pragma unroll
        for (int e = 0; e < 8; ++e) v[e] = ((j0 >> 4) <= (i >> 4)) ? TM[i * LM_LD + j0 + e] : 0.f;
        u32x4 pk; pk.x = pk2(v[0], v[1]); pk.y = pk2(v[2], v[3]); pk.z = pk2(v[4], v[5]); pk.w = pk2(v[6], v[7]);
        *(LP(u32x4))(TB + i * TB_LD + j0) = pk;
    }
    wg_sync_lds();
    {
        f32x4 u[4];
        bf16x8 tf[4][2], vf[2], kbf[2][2], tbf[2][2];
        const int s = w >> 1;
#pragma unroll
        for (int ks = 0; ks < 2; ++ks) { vf[ks] = *(LP(bf16x8))(VBT + (16 * w + fr) * TB_LD + 32 * ks + 8 * fq);
#pragma unroll
            for (int i = 0; i < 4; ++i) if (ks == 0 || i >= 2) tf[i][ks] = *(LP(bf16x8))(TB + (16 * i + fr) * TB_LD + 32 * ks + 8 * fq);
#pragma unroll
            for (int mm = 0; mm < 2; ++mm) kbf[mm][ks] = *(LP(bf16x8))(KBGT + (32 * s + 16 * mm + fr) * TB_LD + 32 * ks + 8 * fq);
#pragma unroll
            for (int nn = 0; nn < 2; ++nn) tbf[nn][ks] = *(LP(bf16x8))(TB + (16 * (2 * (w & 1) + nn) + fr) * TB_LD + 32 * ks + 8 * fq); }
#pragma unroll
        for (int i = 0; i < 4; ++i) {
            u[i] = (f32x4){0.f, 0.f, 0.f, 0.f};
#pragma unroll
            for (int ks = 0; ks < 2; ++ks) if (ks == 0 || i >= 2) u[i] = mfma16(tf[i][ks], vf[ks], u[i]);
            unsigned* ub = P.UB + (size_t)it * 4096 + ((w * 4 + i) * 2) * 64 + l;
            ub[0] = pk2(u[i][0], u[i][1]); ub[64] = pk2(u[i][2], u[i][3]);
        }
#pragma unroll
        for (int nn = 0; nn < 2; ++nn) {
            const int nt = 2 * (w & 1) + nn;
            f32x4 acc[2] = {{0.f, 0.f, 0.f, 0.f}, {0.f, 0.f, 0.f, 0.f}};
#pragma unroll
            for (int mm = 0; mm < 2; ++mm)
#pragma unroll
                for (int ks = 0; ks < 2; ++ks) if (ks == 0 || nt >= 2) acc[mm] = mfma16(kbf[mm][ks], tbf[nn][ks], acc[mm]);
            u32x4 pk; pk.x = pk2(acc[0][0], acc[0][1]); pk.y = pk2(acc[0][2], acc[0][3]); pk.z = pk2(acc[1][0], acc[1][1]); pk.w = pk2(acc[1][2], acc[1][3]);
            *(u32x4*)(P.WB + (size_t)(row0 + 16 * nt + fr) * D + h * 128 + 32 * s + 8 * fq) = pk;
        }
#pragma unroll
        for (int e = 0; e < 2; ++e) { const int o = (tid + 512 * e) * 8; *(u32x4*)(P.KDT + (size_t)it * 8192 + o) = *(LP(u32x4))(KDTl + o); }
        if (tid == 0) P.DL[it] = expf(gc_last);
    }
}

constexpr int W_LD = 136, A_LD = 72;
constexpr int SB_W = 0, SB_Q = SB_W + 64 * W_LD * 2, SB_A = SB_Q + 64 * W_LD * 2, SB_KD = SB_A + 64 * A_LD * 2, SB_SIZE = SB_KD + 128 * A_LD * 2;
constexpr int L_PL = 2 * SB_SIZE, L_RL = L_PL + 8 * 64 * 4, L_OL = L_RL + 64 * 4, L_SCAN_END = L_OL + 64 * W_LD * 2;
static_assert(L_SCAN_END <= P2_LDS, "scan LDS");
DI bf16x8 pack8(const f32x4& a, const f32x4& b) { u32x4 p; p.x = pk2(a[0], a[1]); p.y = pk2(a[2], a[3]); p.z = pk2(b[0], b[1]); p.w = pk2(b[2], b[3]); return __builtin_bit_cast(bf16x8, p); }

DI void scan_item(LP(unsigned char) lds, const DnPtrs& P, int b, int h) {
    const int tid = t_id(), w = wave_id(), l = tid & 63, fr = l & 15, fq = l >> 4;
    const int it0 = (b * H + h) * NCH;
    LP(float) PL = (LP(float))(lds + L_PL); LP(float) RL = (LP(float))(lds + L_RL); LP(bf16) OL = (LP(bf16))(lds + L_OL);
    f32x4 S[8];
#pragma unroll
    for (int m = 0; m < 8; ++m) S[m] = (f32x4){0.f, 0.f, 0.f, 0.f};
    u32x4 pw[2], pq[2], pa, pkd[2], pz[2], zcur[2]; unsigned pu[8], ucur[8]; float pdl, dlcur;
    const float dnn = P.dn_norm[16 * w + fr];
#define DN_LOAD(n_) do { const int it_ = it0 + (n_); const size_t r0_ = (size_t)(b * SEQ + (n_) * CH); \
        _Pragma("unroll") for (int e = 0; e < 2; ++e) { const int p_ = tid + 512 * e; \
            pw[e] = *(const u32x4*)(P.WB + (r0_ + (p_ >> 4)) * D + h * 128 + (p_ & 15) * 8); pq[e] = *(const u32x4*)(P.QD + (r0_ + (p_ >> 4)) * D + h * 128 + (p_ & 15) * 8); \
            pkd[e] = *(const u32x4*)(P.KDT + (size_t)it_ * 8192 + (p_ >> 3) * 64 + (p_ & 7) * 8); \
            pz[e] = *(const u32x4*)(P.Z + (r0_ + (p_ >> 4)) * D + h * 128 + (p_ & 15) * 8); } \
        pa = *(const u32x4*)(P.AB + (size_t)it_ * 4096 + (tid >> 3) * 64 + (tid & 7) * 8); \
        _Pragma("unroll") for (int e = 0; e < 8; ++e) pu[e] = P.UB[(size_t)it_ * 4096 + (w * 8 + e) * 64 + l]; \
        pdl = P.DL[it_]; } while (0)
#define DN_STORE(buf_) do { LP(unsigned char) sb_ = lds + (buf_) * SB_SIZE; \
        _Pragma("unroll") for (int e = 0; e < 2; ++e) { const int p_ = tid + 512 * e; \
            *(LP(u32x4))(sb_ + SB_W + ((p_ >> 4) * W_LD + (p_ & 15) * 8) * 2) = pw[e]; *(LP(u32x4))(sb_ + SB_Q + ((p_ >> 4) * W_LD + (p_ & 15) * 8) * 2) = pq[e]; \
            *(LP(u32x4))(sb_ + SB_KD + ((p_ >> 3) * A_LD + (p_ & 7) * 8) * 2) = pkd[e]; } \
        *(LP(u32x4))(sb_ + SB_A + ((tid >> 3) * A_LD + (tid & 7) * 8) * 2) = pa; } while (0)
    wg_sync();
    DN_LOAD(0); DN_STORE(0);
#pragma unroll
    for (int e = 0; e < 8; ++e) ucur[e] = pu[e];
    zcur[0] = pz[0]; zcur[1] = pz[1]; dlcur = pdl;
    wg_sync();
    DN_LOAD(1);
    for (int n = 0; n < NCH; ++n) {
        const size_t row0 = (size_t)(b * SEQ + n * CH);
        LP(unsigned char) sb = lds + (n & 1) * SB_SIZE;
        LP(bf16) Wl = (LP(bf16))(sb + SB_W); LP(bf16) Ql = (LP(bf16))(sb + SB_Q); LP(bf16) Al = (LP(bf16))(sb + SB_A); LP(bf16) KDl = (LP(bf16))(sb + SB_KD);
        const float dl = dlcur;
        bf16x8 Bs[4];
#pragma unroll
        for (int ks = 0; ks < 4; ++ks) Bs[ks] = pack8(S[2 * ks], S[2 * ks + 1]);
        bf16x8 fa[8], fb[8];
#define FR128(dst, base, ld, t0) do { _Pragma("unroll") for (int ii = 0; ii < 2; ++ii) _Pragma("unroll") for (int ks = 0; ks < 4; ++ks) \
            dst[4 * ii + ks] = *(LP(bf16x8))((base) + (16 * ((t0) + ii) + fr) * (ld) + 32 * ks + 8 * fq); } while (0)
#define FR64(dst, base, ld, t0) do { _Pragma("unroll") for (int ii = 0; ii < 4; ++ii) _Pragma("unroll") for (int s2 = 0; s2 < 2; ++s2) \
            dst[2 * ii + s2] = *(LP(bf16x8))((base) + (16 * ((t0) + ii) + fr) * (ld) + 32 * s2 + 8 * fq); } while (0)
        FR128(fa, Wl, W_LD, 0); FR128(fb, Wl, W_LD, 2);
        f32x4 vn[4], o[4];
#pragma unroll
        for (int ii = 0; ii < 2; ++ii) { f32x4 acc = {0.f, 0.f, 0.f, 0.f};
#pragma unroll
            for (int ks = 0; ks < 4; ++ks) acc = mfma16(fa[4 * ii + ks], Bs[ks], acc);
            vn[ii] = acc; }
        FR128(fa, Ql, W_LD, 0);
#pragma unroll
        for (int ii = 0; ii < 2; ++ii) { f32x4 acc = {0.f, 0.f, 0.f, 0.f};
#pragma unroll
            for (int ks = 0; ks < 4; ++ks) acc = mfma16(fb[4 * ii + ks], Bs[ks], acc);
            vn[2 + ii] = acc; }
        FR128(fb, Ql, W_LD, 2);
#pragma unroll
        for (int i = 0; i < 4; ++i) { vn[i][0] = bf_lo(ucur[2 * i]) - vn[i][0]; vn[i][1] = bf_hi(ucur[2 * i]) - vn[i][1]; vn[i][2] = bf_lo(ucur[2 * i + 1]) - vn[i][2]; vn[i][3] = bf_hi(ucur[2 * i + 1]) - vn[i][3]; }
        bf16x8 Bv[2];
        Bv[0] = pack8(vn[0], vn[1]); Bv[1] = pack8(vn[2], vn[3]);
#pragma unroll
        for (int ii = 0; ii < 2; ++ii) { f32x4 acc = {0.f, 0.f, 0.f, 0.f};
#pragma unroll
            for (int ks = 0; ks < 4; ++ks) acc = mfma16(fa[4 * ii + ks], Bs[ks], acc);
            o[ii] = acc; }
        FR64(fa, Al, A_LD, 0);
#pragma unroll
        for (int ii = 0; ii < 2; ++ii) { f32x4 acc = {0.f, 0.f, 0.f, 0.f};
#pragma unroll
            for (int ks = 0; ks < 4; ++ks) acc = mfma16(fb[4 * ii + ks], Bs[ks], acc);
            o[2 + ii] = acc; }
        FR64(fb, KDl, A_LD, 0);
#pragma unroll
        for (int i = 0; i < 4; ++i)
#pragma unroll
            for (int s2 = 0; s2 < 2; ++s2) if (s2 == 0 || i >= 2) o[i] = mfma16(fa[2 * i + s2], Bv[s2], o[i]);
        FR64(fa, KDl, A_LD, 4);
#pragma unroll
        for (int m = 0; m < 4; ++m) { f32x4 acc = S[m] * dl;
#pragma unroll
            for (int s2 = 0; s2 < 2; ++s2) acc = mfma16(fb[2 * m + s2], Bv[s2], acc);
            S[m] = acc; }
#pragma unroll
        for (int m = 0; m < 4; ++m) { f32x4 acc = S[4 + m] * dl;
#pragma unroll
            for (int s2 = 0; s2 < 2; ++s2) acc = mfma16(fa[2 * m + s2], Bv[s2], acc);
            S[4 + m] = acc; }
#undef FR128
#undef FR64
#ifdef PROBE_XBAR
        wg_sync_lds();
#endif
#pragma unroll
        for (int i = 0; i < 4; ++i)
#pragma unroll
            for (int r = 0; r < 4; ++r) { const float s = row_sum16(o[i][r] * o[i][r]); if (fr == 0) PL[w * 64 + 16 * i + 4 * fq + r] = s; }
        wg_sync_lds();
        {
            const int tok = 8 * w + (l >> 3);
            const float s = row_sum8(PL[(l & 7) * 64 + tok]);
            if ((l & 7) == 0) RL[tok] = 1.0f / sqrtf(s * (1.0f / 128.0f) + RMS_EPS);
        }
        if (n + 1 < NCH) DN_STORE((n + 1) & 1);
        wg_sync_lds();
#pragma unroll
        for (int i = 0; i < 4; ++i)
#pragma unroll
            for (int r = 0; r < 4; ++r) { const int tok = 16 * i + 4 * fq + r; OL[tok * W_LD + 16 * w + fr] = (bf16)f2bf(o[i][r] * RL[tok] * dnn); }
        wg_sync_lds();
#pragma unroll
        for (int e = 0; e < 2; ++e) {
            const int p = tid + 512 * e, row = p >> 4, c8 = (p & 15) * 8;
            const u32x4 ov = *(LP(u32x4))(OL + row * W_LD + c8);
            const u32x4 zv = zcur[e];
            u32x4 r;
            r.x = pk2(bf_lo(ov.x) * bf_lo(zv.x), bf_hi(ov.x) * bf_hi(zv.x)); r.y = pk2(bf_lo(ov.y) * bf_lo(zv.y), bf_hi(ov.y) * bf_hi(zv.y));
            r.z = pk2(bf_lo(ov.z) * bf_lo(zv.z), bf_hi(ov.z) * bf_hi(zv.z)); r.w = pk2(bf_lo(ov.w) * bf_lo(zv.w), bf_hi(ov.w) * bf_hi(zv.w));
            *(u32x4*)(P.OCAT + (row0 + row) * 2048 + h * 128 + c8) = r;
        }
#pragma unroll
        for (int e = 0; e < 8; ++e) ucur[e] = pu[e];
        zcur[0] = pz[0]; zcur[1] = pz[1]; dlcur = pdl;
        if (n + 2 < NCH) DN_LOAD(n + 2);
    }
#undef DN_LOAD
#undef DN_STORE
#pragma unroll
    for (int m = 0; m < 8; ++m)
#pragma unroll
        for (int r = 0; r < 4; ++r) P.DSP[((size_t)(b * H + h) * 128 + 16 * m + 4 * fq + r) * 128 + 16 * w + fr] = S[m][r];
}

constexpr int L_CV = 0, L_QS = L_CV + 8 * 384 * 4, L_KS = L_QS + 8 * 128 * 4, L_VS = L_KS + 8 * 128 * 4, L_BG = L_VS + 8 * 128 * 4, L_RED = L_BG + 256, L_OS = L_RED + 2 * 4 * 128 * 4, L_SAMP_END = L_OS + 8 * 128 * 4;
DI void sample_item(LP(unsigned char) lds, const DnPtrs& P, int b, int h) {
    const int tid = t_id(), w = wave_id(), l = tid & 63, dv = tid & 127, dkb = tid >> 7;
    LP(float) CV = (LP(float))(lds + L_CV); LP(float) QS = (LP(float))(lds + L_QS); LP(float) KS = (LP(float))(lds + L_KS); LP(float) VS = (LP(float))(lds + L_VS);
    LP(float) BG = (LP(float))(lds + L_BG); LP(float) RED = (LP(float))(lds + L_RED); LP(float) OS = (LP(float))(lds + L_OS);
    const size_t sbase = ((size_t)(b * H + h) * 128 + 32 * dkb) * 128 + dv;
    const int rowb = MP + 8 * b;
    wg_sync();
    float S[32];
#pragma unroll
    for (int i = 0; i < 32; ++i) S[i] = P.state_delta[sbase + (size_t)i * 128];
    if (tid < 384) {
        const int col = (tid >> 7) * 1024 + h * 128 + (tid & 127);
        float x[11], cw[4];
#pragma unroll
        for (int i = 0; i < 4; ++i) cw[i] = P.conv_w[i * QKVW + col];
#pragma unroll
        for (int i = 0; i < 3; ++i) x[i] = P.state_conv[((size_t)b * 3 + i) * QKVW + col];
#pragma unroll
        for (int t = 0; t < 8; ++t) x[3 + t] = bf2f(P.QKV[(size_t)(rowb + t) * QKVW + col]);
#pragma unroll
        for (int t = 0; t < 8; ++t) CV[t * 384 + tid] = silu_f(x[t] * cw[0] + x[t + 1] * cw[1] + x[t + 2] * cw[2] + x[t + 3] * cw[3]);
    }
    wg_sync();
    {
        const int t = w;
        const float q0 = CV[t * 384 + 2 * l], q1 = CV[t * 384 + 2 * l + 1], k0 = CV[t * 384 + 128 + 2 * l], k1 = CV[t * 384 + 128 + 2 * l + 1];
        const float rq = 1.0f / sqrtf(wave_sum(q0 * q0 + q1 * q1) + L2_EPS) * QSCALE_DN, rk = 1.0f / sqrtf(wave_sum(k0 * k0 + k1 * k1) + L2_EPS);
        QS[t * 128 + 2 * l] = q0 * rq; QS[t * 128 + 2 * l + 1] = q1 * rq; KS[t * 128 + 2 * l] = k0 * rk; KS[t * 128 + 2 * l + 1] = k1 * rk;
        VS[t * 128 + 2 * l] = CV[t * 384 + 256 + 2 * l]; VS[t * 128 + 2 * l + 1] = CV[t * 384 + 256 + 2 * l + 1];
        if (l == 0) { const float* ba = P.BA + (size_t)(rowb + t) * 16; BG[2 * t] = 1.0f / (1.0f + expf(-ba[h])); BG[2 * t + 1] = expf(-expf(P.a_log[h]) * softplus_f(ba[8 + h] + P.dt_bias[h])); }
    }
    wg_sync();
    for (int t = 0; t < 8; ++t) {
        const float beta = BG[2 * t], eg = BG[2 * t + 1];
        float p = 0.f;
#pragma unroll
        for (int i = 0; i < 32; ++i) p += KS[t * 128 + 32 * dkb + i] * S[i];
        RED[dkb * 128 + dv] = p;
        wg_sync();
        const float kS = (RED[dv] + RED[128 + dv]) + (RED[256 + dv] + RED[384 + dv]);
        const float d = beta * (VS[t * 128 + dv] - eg * kS);
        float po = 0.f;
#pragma unroll
        for (int i = 0; i < 32; ++i) { S[i] = eg * S[i] + KS[t * 128 + 32 * dkb + i] * d; po += QS[t * 128 + 32 * dkb + i] * S[i]; }
        RED[512 + dkb * 128 + dv] = po;
        wg_sync();
        if (dkb == 0) OS[t * 128 + dv] = (RED[512 + dv] + RED[640 + dv]) + (RED[768 + dv] + RED[896 + dv]);
    }
    wg_sync();
    {
        const int t = w, row = rowb + t;
        const float o0 = OS[t * 128 + 2 * l], o1 = OS[t * 128 + 2 * l + 1];
        const float rs = 1.0f / sqrtf(wave_sum(o0 * o0 + o1 * o1) * (1.0f / 128.0f) + RMS_EPS);
        const unsigned zz = *(const unsigned*)(P.Z + (size_t)row * D + h * 128 + 2 * l);
        *(unsigned*)(P.OCAT + (size_t)row * 2048 + h * 128 + 2 * l) = pk2(o0 * rs * P.dn_norm[2 * l] * bf_lo(zz), o1 * rs * P.dn_norm[2 * l + 1] * bf_hi(zz));
    }
#pragma unroll
    for (int i = 0; i < 32; ++i) P.DSS[sbase + (size_t)i * 128] = S[i];
}

constexpr int SB_WAVE = 8 * 256 * 4 + 8 * 64 * 4 + 64, L_SB_SS = 8 * SB_WAVE, L_SB_END = L_SB_SS + 4 * 2 * 8 * 4;
static_assert(L_SB_END <= P2_LDS, "sample batch LDS");
DI void sample_batch(LP(unsigned char) lds, const DnPtrs& P, int q4) {
    const int tid = t_id(), w = wave_id(), l = tid & 63, c = l & 15, q = l >> 4;
    const int b = q4 >> 1, h = 4 * (q4 & 1) + (w >> 1), half = w & 1, rowb = MP + 8 * b;
    LP(float) KQ = (LP(float))(lds + w * SB_WAVE);
    LP(float) VV = KQ + 8 * 256;
    LP(float) BG = VV + 8 * 64;
    LP(float) SSQ = (LP(float))(lds + L_SB_SS);
    wg_sync();
    const size_t sbase = ((size_t)(b * H + h) * 128 + q) * 128 + 64 * half + 4 * c;
    {
        float xq[11][2], xk[11][2], xv[11];
        const int cq = h * 128 + 2 * l, cv = 2048 + h * 128 + 64 * half + l;
#pragma unroll
        for (int i = 0; i < 3; ++i) { const float* sc = P.state_conv + ((size_t)b * 3 + i) * QKVW; xq[i][0] = sc[cq]; xq[i][1] = sc[cq + 1]; xk[i][0] = sc[1024 + cq]; xk[i][1] = sc[1024 + cq + 1]; xv[i] = sc[cv]; }
#pragma unroll
        for (int t = 0; t < 8; ++t) { const bf16* r = P.QKV + (size_t)(rowb + t) * QKVW; const unsigned uq = *(const unsigned*)(r + cq), uk = *(const unsigned*)(r + 1024 + cq);
            xq[3 + t][0] = bf_lo(uq); xq[3 + t][1] = bf_hi(uq); xk[3 + t][0] = bf_lo(uk); xk[3 + t][1] = bf_hi(uk); xv[3 + t] = bf2f(r[cv]); }
        float wq[4][2], wk[4][2], wv[4];
#pragma unroll
        for (int i = 0; i < 4; ++i) { wq[i][0] = P.conv_w[i * QKVW + cq]; wq[i][1] = P.conv_w[i * QKVW + cq + 1]; wk[i][0] = P.conv_w[i * QKVW + 1024 + cq]; wk[i][1] = P.conv_w[i * QKVW + 1024 + cq + 1]; wv[i] = P.conv_w[i * QKVW + cv]; }
#pragma unroll
        for (int t = 0; t < 8; ++t) {
            float qq[2], kk[2];
#pragma unroll
            for (int e = 0; e < 2; ++e) { qq[e] = silu_f(xq[t][e] * wq[0][e] + xq[t + 1][e] * wq[1][e] + xq[t + 2][e] * wq[2][e] + xq[t + 3][e] * wq[3][e]);
                                          kk[e] = silu_f(xk[t][e] * wk[0][e] + xk[t + 1][e] * wk[1][e] + xk[t + 2][e] * wk[2][e] + xk[t + 3][e] * wk[3][e]); }
            const float vv = silu_f(xv[t] * wv[0] + xv[t + 1] * wv[1] + xv[t + 2] * wv[2] + xv[t + 3] * wv[3]);
            const float rq = frsq(wave_sum(qq[0] * qq[0] + qq[1] * qq[1]) + L2_EPS) * QSCALE_DN, rk = frsq(wave_sum(kk[0] * kk[0] + kk[1] * kk[1]) + L2_EPS);
#pragma unroll
            for (int e = 0; e < 2; ++e) { const int dk = 2 * l + e, pos = (dk & 3) * 32 + (dk >> 2); KQ[t * 256 + pos] = kk[e] * rk; KQ[t * 256 + 128 + pos] = qq[e] * rq; }
            VV[t * 64 + l] = vv;
            if (l == 0) { const float* ba = P.BA + (size_t)(rowb + t) * 16; BG[2 * t] = 1.0f / (1.0f + expf(-ba[h])); BG[2 * t + 1] = expf(-expf(P.a_log[h]) * softplus_f(ba[8 + h] + P.dt_bias[h])); }
        }
    }
    wave_sync();
    f32x4 S[32];
#pragma unroll
    for (int i = 0; i < 32; ++i) S[i] = *(const f32x4*)(P.state_delta + sbase + (size_t)(4 * i) * 128);
    LP(float) OSW = VV;
#pragma unroll 1
    for (int t = 0; t < 8; ++t) {
        const float beta = BG[2 * t], eg = BG[2 * t + 1];
        f32x4 kS = {0.f, 0.f, 0.f, 0.f};
#pragma unroll
        for (int j = 0; j < 8; ++j) { const f32x4 kv = *(LP(f32x4))(KQ + t * 256 + q * 32 + 4 * j);
#pragma unroll
            for (int e = 0; e < 4; ++e) kS += S[4 * j + e] * kv[e]; }
#pragma unroll
        for (int e = 0; e < 4; ++e) { kS[e] += shfl_xor_f(kS[e], 16); kS[e] += shfl_xor_f(kS[e], 32); }
        const f32x4 vv = *(LP(f32x4))(VV + t * 64 + 4 * c);
        const f32x4 dd = (vv - kS * eg) * beta;
        f32x4 o = {0.f, 0.f, 0.f, 0.f};
#pragma unroll
        for (int j = 0; j < 8; ++j) { const f32x4 kv = *(LP(f32x4))(KQ + t * 256 + q * 32 + 4 * j), qv = *(LP(f32x4))(KQ + t * 256 + 128 + q * 32 + 4 * j);
#pragma unroll
            for (int e = 0; e < 4; ++e) { S[4 * j + e] = S[4 * j + e] * eg + dd * kv[e]; o += S[4 * j + e] * qv[e]; } }
#pragma unroll
        for (int e = 0; e < 4; ++e) { o[e] += shfl_xor_f(o[e], 16); o[e] += shfl_xor_f(o[e], 32); }
        const float ss = row_sum16((o[0] * o[0] + o[1] * o[1]) + (o[2] * o[2] + o[3] * o[3]));
        if (l == 0) SSQ[((w >> 1) * 2 + half) * 8 + t] = ss;
        wave_sync();
        if (q == 0) *(LP(f32x4))(OSW + t * 64 + 4 * c) = o;
    }
#pragma unroll
    for (int i = 0; i < 32; ++i) *(f32x4*)(P.DSS + sbase + (size_t)(4 * i) * 128) = S[i];
    wg_sync();
    if (q == 0) {
        const f32x4 dn4 = *(const f32x4*)(P.dn_norm + 64 * half + 4 * c);
#pragma unroll
        for (int t = 0; t < 8; ++t) {
            const float rs = 1.0f / sqrtf((SSQ[((w >> 1) * 2) * 8 + t] + SSQ[((w >> 1) * 2 + 1) * 8 + t]) * (1.0f / 128.0f) + RMS_EPS);
            const size_t row = (size_t)(rowb + t);
            const u32x2 zz = *(const u32x2*)(P.Z + row * D + h * 128 + 64 * half + 4 * c);
            const f32x4 ot = *(LP(f32x4))(OSW + t * 64 + 4 * c);
            u32x2 ov; ov.x = pk2(ot[0] * rs * dn4[0] * bf_lo(zz.x), ot[1] * rs * dn4[1] * bf_hi(zz.x)); ov.y = pk2(ot[2] * rs * dn4[2] * bf_lo(zz.y), ot[3] * rs * dn4[3] * bf_hi(zz.y));
            *(u32x2*)(P.OCAT + row * 2048 + h * 128 + 64 * half + 4 * c) = ov;
        }
    }
}
}
struct SgPtrs { const bf16* UV; const bf16* SGWT; const float* sgu_w; const float* sgu_b; const float* sgu_norm; bf16* OCAT; float* SGV; };
namespace sg {
using namespace cfg;
constexpr int VT_LD = 136, L_VT = 0, L_R = 4 * 128 * VT_LD * 2, L_SG_END = L_R + 512;
static_assert(L_SG_END <= P2_LDS, "sgu LDS");
DI void sgu_item(LP(unsigned char) lds, const SgPtrs& P, int b, int c) {
    const int tid = t_id(), w = wave_id(), l = tid & 63, fr = l & 15, fq = l >> 4;
    const size_t row0 = (size_t)b * SEQ + 128 * c;
    LP(bf16) VT = (LP(bf16))(lds + L_VT);
    wg_sync();
    {
        u32x4 v[16];
#pragma unroll
        for (int j = 0; j < 16; ++j) v[j] = *(const u32x4*)(P.UV + (row0 + 16 * w + j) * D + 512 + 8 * l);
        float gn[8];
        { const f32x4 g0 = *(const f32x4*)(P.sgu_norm + 8 * l), g1 = *(const f32x4*)(P.sgu_norm + 8 * l + 4); gn[0] = g0[0]; gn[1] = g0[1]; gn[2] = g0[2]; gn[3] = g0[3]; gn[4] = g1[0]; gn[5] = g1[1]; gn[6] = g1[2]; gn[7] = g1[3]; }
        LP(bf16) vt = VT + (size_t)(l >> 4) * 128 * VT_LD;
        const int cc0 = 8 * (l & 15), swz = (l & 15);
#pragma unroll
        for (int jp = 0; jp < 8; ++jp) {
            float x0[8], x1[8];
            { const u32x4 a = v[2 * jp], bq = v[2 * jp + 1];
              x0[0] = bf_lo(a.x); x0[1] = bf_hi(a.x); x0[2] = bf_lo(a.y); x0[3] = bf_hi(a.y); x0[4] = bf_lo(a.z); x0[5] = bf_hi(a.z); x0[6] = bf_lo(a.w); x0[7] = bf_hi(a.w);
              x1[0] = bf_lo(bq.x); x1[1] = bf_hi(bq.x); x1[2] = bf_lo(bq.y); x1[3] = bf_hi(bq.y); x1[4] = bf_lo(bq.z); x1[5] = bf_hi(bq.z); x1[6] = bf_lo(bq.w); x1[7] = bf_hi(bq.w); }
            float s0 = 0.f, s1 = 0.f;
#pragma unroll
            for (int e = 0; e < 8; ++e) { s0 += x0[e] * x0[e]; s1 += x1[e] * x1[e]; }
            const float r0 = 1.0f / sqrtf(wave_sum(s0) * (1.0f / 512.0f) + RMS_EPS), r1 = 1.0f / sqrtf(wave_sum(s1) * (1.0f / 512.0f) + RMS_EPS);
            const int s = 16 * w + 2 * jp;
            const int pos = (((s >> 3) ^ swz) << 3) + (s & 7);
#pragma unroll
            for (int e = 0; e < 8; ++e) *(LP(unsigned))(vt + (cc0 + e) * VT_LD + pos) = pk2(x0[e] * r0 * gn[e], x1[e] * r1 * gn[e]);
        }
    }
    wg_sync();
    {
        const int t = 16 * w + fr, kmax = (16 * w + 15) >> 5;
#pragma unroll 1
        for (int g = 0; g < 4; ++g) {
            LP(bf16) vt = VT + (size_t)g * 128 * VT_LD;
            f32x4 acc[8];
#pragma unroll
            for (int m = 0; m < 8; ++m) acc[m] = (f32x4){0.f, 0.f, 0.f, 0.f};
            bf16x8 wf[4];
#pragma unroll
            for (int ks = 0; ks < 4; ++ks) wf[ks] = *(const bf16x8*)(P.SGWT + ((size_t)g * 128 + t) * 128 + 32 * ks + 8 * fq);
            const float bias = P.sgu_b[g * 128 + t];
            u32x2 uu[8];
#pragma unroll
            for (int m = 0; m < 8; ++m) uu[m] = *(const u32x2*)(P.UV + (row0 + t) * D + g * 128 + 16 * m + 4 * fq);
#pragma unroll
            for (int ks = 0; ks < 4; ++ks) if (ks <= kmax) {
#pragma unroll
                for (int m = 0; m < 8; ++m) acc[m] = mfma16(*(LP(bf16x8))(vt + (16 * m + fr) * VT_LD + (((4 * ks + fq) ^ (2 * m + (fr >> 3))) << 3)), wf[ks], acc[m]);
            }
#pragma unroll
            for (int m = 0; m < 8; ++m) {
                u32x2 o; o.x = pk2(bf_lo(uu[m].x) * (acc[m][0] + bias), bf_hi(uu[m].x) * (acc[m][1] + bias)); o.y = pk2(bf_lo(uu[m].y) * (acc[m][2] + bias), bf_hi(uu[m].y) * (acc[m][3] + bias));
                *(u32x2*)(P.OCAT + (row0 + t) * 2048 + 1024 + g * 128 + 16 * m + 4 * fq) = o;
            }
        }
    }
}
DI void sgu_sample_item(LP(unsigned char) lds, const SgPtrs& P, int b) {
    const int tid = t_id(), w = wave_id(), l = tid & 63, g = tid >> 7;
    LP(float) RED = (LP(float))(lds);
    const size_t rowb = (size_t)MP + 8 * b;
    float v[8], u[8];
    wg_sync();
#pragma unroll
    for (int t = 0; t < 8; ++t) { v[t] = bf2f(P.UV[(rowb + t) * D + 512 + tid]); u[t] = bf2f(P.UV[(rowb + t) * D + tid]); const float s = wave_sum(v[t] * v[t]); if (l == 0) RED[t * 8 + w] = s; }
    wg_sync();
    const float gain = P.sgu_norm[tid];
#pragma unroll
    for (int t = 0; t < 8; ++t) {
        float s = 0.f;
#pragma unroll
        for (int j = 0; j < 8; ++j) s += RED[t * 8 + j];
        v[t] = v[t] * (1.0f / sqrtf(s * (1.0f / 512.0f) + RMS_EPS)) * gain;
        P.SGV[((size_t)b * 8 + t) * 512 + tid] = v[t];
    }
#pragma unroll
    for (int t = 0; t < 8; ++t) {
        float mx = P.sgu_b[g * 128 + t];
#pragma unroll
        for (int s = 0; s <= t; ++s) mx += P.sgu_w[((size_t)g * 128 + t) * 128 + s] * v[s];
        P.OCAT[(rowb + t) * 2048 + 1024 + tid] = (bf16)f2bf(u[t] * mx);
    }
}
}

namespace at {
using namespace cfg;
constexpr int K_LD = 136, V_LD = 264, L_K = 0, L_V = 256 * K_LD * 2, L_AT_END = L_V + 128 * V_LD * 2, OS_LD = 72;
static_assert(L_AT_END <= P2_LDS && 8 * 32 * OS_LD * 2 <= L_V, "attention LDS");
DI int crow(int i, int h) { return (i & 3) + 8 * (i >> 2) + 4 * h; }
DI void attn_item(LP(unsigned char) lds, const bf16* Q, int nq, const float* K, const float* V, bf16* O) {
    const int tid = t_id(), w = wave_id(), l = tid & 63, r32 = l & 31, hh = l >> 5;
    LP(bf16) KL = (LP(bf16))(lds + L_K); LP(bf16) VT = (LP(bf16))(lds + L_V);
    wg_sync();
    {
        f32x4 kv[16];
#pragma unroll
        for (int e = 0; e < 16; ++e) { const int p = tid + 512 * e; kv[e] = *(const f32x4*)(K + (size_t)(p >> 5) * 512 + (p & 31) * 4); }
#pragma unroll
        for (int e = 0; e < 16; ++e) { const int p = tid + 512 * e; u32x2 pk; pk.x = pk2(kv[e][0], kv[e][1]); pk.y = pk2(kv[e][2], kv[e][3]); *(LP(u32x2))(KL + (p >> 5) * K_LD + (p & 31) * 4) = pk; }
    }
    {
        f32x4 v0[8], v1[8];
#pragma unroll
        for (int e = 0; e < 8; ++e) { const int u = tid + 512 * e, d4 = (u & 31) * 4, key = 2 * (u >> 5); v0[e] = *(const f32x4*)(V + (size_t)key * 512 + d4); v1[e] = *(const f32x4*)(V + (size_t)(key + 1) * 512 + d4); }
#pragma unroll
        for (int e = 0; e < 8; ++e) {
            const int u = tid + 512 * e, d4 = (u & 31) * 4, kp = perm16k(2 * (u >> 5));
            const int pos = (((kp >> 3) ^ (u & 31)) << 3) + (kp & 7);
#pragma unroll
            for (int i = 0; i < 4; ++i) *(LP(unsigned))(VT + (d4 + i) * V_LD + pos) = pk2(v0[e][i], v1[e][i]);
        }
    }
    wg_sync();
    const int q0 = 32 * w;
    const bool active = q0 < nq;
    bf16x8 Pf[8][2];
    float inv = 0.f;
    if (active) {
        bf16x8 Bq[8];
        const bool qok = (q0 + r32) < nq;
#pragma unroll
        for (int ks = 0; ks < 8; ++ks) { Bq[ks] = (bf16x8){0, 0, 0, 0, 0, 0, 0, 0}; if (qok) Bq[ks] = *(const bf16x8*)(Q + (size_t)(q0 + r32) * 512 + 16 * ks + 8 * hh); }
        f32x16 acc[8];
#pragma unroll
        for (int kt = 0; kt < 8; ++kt) {
#pragma unroll
            for (int i = 0; i < 16; ++i) acc[kt][i] = 0.f;
#pragma unroll
            for (int ks = 0; ks < 8; ++ks) acc[kt] = mfma32(*(LP(bf16x8))(KL + (32 * kt + r32) * K_LD + 16 * ks + 8 * hh), Bq[ks], acc[kt]);
#ifndef HOST_EMU
            asm volatile("" ::: "memory");
#endif
        }
        float mx = -3.0e38f;
#pragma unroll
        for (int kt = 0; kt < 8; ++kt)
#pragma unroll
            for (int i = 0; i < 16; ++i) mx = fmaxf(mx, acc[kt][i]);
        mx = fmaxf(mx, shfl_xor_f(mx, 32));
        float sum = 0.f;
#pragma unroll
        for (int kt = 0; kt < 8; ++kt) {
#pragma unroll
            for (int i = 0; i < 16; ++i) { const float p = fexp2(acc[kt][i] - mx); acc[kt][i] = p; sum += p; }
#pragma unroll
            for (int s = 0; s < 2; ++s) {
                u32x4 pa; pa.x = pk2(acc[kt][8 * s], acc[kt][8 * s + 1]); pa.y = pk2(acc[kt][8 * s + 2], acc[kt][8 * s + 3]); pa.z = pk2(acc[kt][8 * s + 4], acc[kt][8 * s + 5]); pa.w = pk2(acc[kt][8 * s + 6], acc[kt][8 * s + 7]);
                Pf[kt][s] = __builtin_bit_cast(bf16x8, pa);
            }
        }
        sum += shfl_xor_f(sum, 32);
        inv = 1.0f / sum;
    }
    wg_sync();
    if (active) {
        LP(bf16) OS = (LP(bf16))(lds + L_K) + (size_t)w * 32 * OS_LD;
        float invq[16];
#pragma unroll
        for (int i = 0; i < 16; ++i) invq[i] = shfl_f(inv, crow(i, hh));
#pragma unroll
        for (int dh = 0; dh < 2; ++dh) {
            f32x16 o[2];
#pragma unroll
            for (int dt = 0; dt < 2; ++dt)
#pragma unroll
                for (int i = 0; i < 16; ++i) o[dt][i] = 0.f;
#pragma unroll
            for (int kt = 0; kt < 8; ++kt) {
#pragma unroll
                for (int s = 0; s < 2; ++s) {
#pragma unroll
                    for (int dt = 0; dt < 2; ++dt) { const int d = 64 * dh + 32 * dt + r32;
                        o[dt] = mfma32(Pf[kt][s], *(LP(bf16x8))(VT + d * V_LD + (((4 * kt + 2 * s + hh) ^ ((d >> 2) & 31)) << 3)), o[dt]); }
                }
#ifndef HOST_EMU
                asm volatile("" ::: "memory");
#endif
            }
#pragma unroll
            for (int i = 0; i < 16; ++i)
#pragma unroll
                for (int dt = 0; dt < 2; ++dt) OS[crow(i, hh) * OS_LD + 32 * dt + r32] = (bf16)f2bf(o[dt][i] * invq[i]);
            wave_sync();
#pragma unroll
            for (int j = 0; j < 4; ++j) {
                const int ch = l + 64 * j, q = ch >> 3, c8 = (ch & 7) * 8;
                const u32x4 ov = *(LP(u32x4))(OS + q * OS_LD + c8);
                if (q0 + q < nq) *(u32x4*)(O + (size_t)(q0 + q) * 2048 + 64 * dh + c8) = ov;
            }
            wave_sync();
        }
    }
}
}
namespace mini {
using namespace cfg;
constexpr int ML_LD = 264, ML_STAGE = 2 * 64 * ML_LD * 2, L_MINI_RED = 2 * ML_STAGE;
static_assert(L_MINI_RED + 512 <= P2_LDS, "mini LDS");
DI void mm_tile(LP(unsigned char) lds, const bf16* A, int lda, const bf16* Bt, int ldb, int K, int row0, int col0, f32x4 (&acc)[2]) {
    const int tid = t_id(), w = wave_id(), l = tid & 63, fr = l & 15, fq = l >> 4;
    u32x4 ra[4], rb[4];
#define MM_FETCH(k0) do { _Pragma("unroll") for (int e = 0; e < 4; ++e) { const int c_ = tid + 512 * e; \
        ra[e] = *(const u32x4*)(A + (size_t)(row0 + (c_ >> 5)) * lda + (k0) + 8 * (c_ & 31)); rb[e] = *(const u32x4*)(Bt + (size_t)(col0 + (c_ >> 5)) * ldb + (k0) + 8 * (c_ & 31)); } } while (0)
#define MM_PUT(st) do { LP(bf16) as_ = (LP(bf16))(lds + (st) * ML_STAGE); LP(bf16) bs_ = as_ + 64 * ML_LD; _Pragma("unroll") for (int e = 0; e < 4; ++e) { const int c_ = tid + 512 * e; \
        *(LP(u32x4))(as_ + (c_ >> 5) * ML_LD + 8 * (c_ & 31)) = ra[e]; *(LP(u32x4))(bs_ + (c_ >> 5) * ML_LD + 8 * (c_ & 31)) = rb[e]; } } while (0)
    wg_sync();
    MM_FETCH(0); MM_PUT(0);
    wg_sync_lds();
    const int ns = K >> 8;
#pragma unroll 1
    for (int s = 0; s < ns; ++s) {
        if (s + 1 < ns) MM_FETCH((s + 1) << 8);
        LP(bf16) as = (LP(bf16))(lds + (s & 1) * ML_STAGE) + (16 * (w & 3) + fr) * ML_LD + 8 * fq;
        LP(bf16) bs = (LP(bf16))(lds + (s & 1) * ML_STAGE) + (64 + 32 * (w >> 2) + fr) * ML_LD + 8 * fq;
        bf16x8 fa[8], f0[8], f1[8];
#pragma unroll
        for (int j = 0; j < 8; ++j) { fa[j] = *(LP(bf16x8))(as + 32 * j); f0[j] = *(LP(bf16x8))(bs + 32 * j); f1[j] = *(LP(bf16x8))(bs + 16 * ML_LD + 32 * j); }
#pragma unroll
        for (int j = 0; j < 8; ++j) { acc[0] = mfma16(f0[j], fa[j], acc[0]); acc[1] = mfma16(f1[j], fa[j], acc[1]); }
        if (s + 1 < ns) MM_PUT((s + 1) & 1);
        wg_sync_lds();
    }
#undef MM_FETCH
#undef MM_PUT
}
DI int tile_of(int i) { const int x = i & 7, j = i >> 3; return 16 * (4 * (x >> 1) + (j >> 3)) + 8 * (x & 1) + (j & 7); }
struct MiniPtrs { const bf16* OCAT; const bf16* WBR; const bf16* GATES; bf16* MERGED; const bf16* WO; const float* xs; float* Y; bf16* X1B; float* SS1; const bf16* HB; const bf16* WDN; float* SS2; };
DI void br_tile(LP(unsigned char) lds, const MiniPtrs& P, int t) {
    const int tid = t_id(), w = wave_id(), l = tid & 63, fr = l & 15, fq = l >> 4;
    const int row0 = MP + 64 * (t >> 4), col0 = 64 * (t & 15), row = row0 + 16 * (w & 3) + fr;
    const int koff[3] = {0, 1024, 1536}, klen[3] = {1024, 512, 512};
    f32x4 m[2] = {{0.f, 0.f, 0.f, 0.f}, {0.f, 0.f, 0.f, 0.f}};
#pragma unroll
    for (int b = 0; b < 3; ++b) {
        f32x4 acc[2] = {{0.f, 0.f, 0.f, 0.f}, {0.f, 0.f, 0.f, 0.f}};
        mm_tile(lds, P.OCAT + koff[b], 2048, P.WBR + koff[b], 2048, klen[b], row0, col0, acc);
#pragma unroll
        for (int n = 0; n < 2; ++n) {
            const u32x2 g = *(const u32x2*)(P.GATES + (size_t)row * NGATE + b * D + col0 + 32 * (w >> 2) + 16 * n + 4 * fq);
            m[n][0] += bf_lo(g.x) * acc[n][0]; m[n][1] += bf_hi(g.x) * acc[n][1]; m[n][2] += bf_lo(g.y) * acc[n][2]; m[n][3] += bf_hi(g.y) * acc[n][3];
        }
    }
#pragma unroll
    for (int n = 0; n < 2; ++n) { u32x2 o; o.x = pk2(m[n][0], m[n][1]); o.y = pk2(m[n][2], m[n][3]); *(u32x2*)(P.MERGED + (size_t)row * D + col0 + 32 * (w >> 2) + 16 * n + 4 * fq) = o; }
}
DI void gate_tile(LP(unsigned char) lds, const bf16* XB, const bf16* WG, const float* rstd, bf16* GATES, int t) {
    const int tid = t_id(), w = wave_id(), l = tid & 63, fr = l & 15, fq = l >> 4;
    const int row0 = MP + 64 * (t / 48), col0 = 64 * (t % 48), row = row0 + 16 * (w & 3) + fr;
    f32x4 acc[2] = {{0.f, 0.f, 0.f, 0.f}, {0.f, 0.f, 0.f, 0.f}};
    const float rs = rstd[row];
    mm_tile(lds, XB, D, WG, D, D, row0, col0, acc);
#pragma unroll
    for (int n = 0; n < 2; ++n) { u32x2 o; o.x = pk2(sigmoid_f(acc[n][0] * rs), sigmoid_f(acc[n][1] * rs)); o.y = pk2(sigmoid_f(acc[n][2] * rs), sigmoid_f(acc[n][3] * rs));
        *(u32x2*)(GATES + (size_t)row * NGATE + col0 + 32 * (w >> 2) + 16 * n + 4 * fq) = o; }
}
DI void res_tile(LP(unsigned char) lds, const bf16* A, int lda, const bf16* Bt, int ldb, int K, const float* xin, int xin_row0, const bf16* xin_b, float* Y, bf16* XB, float* SS, int t) {
    const int tid = t_id(), w = wave_id(), l = tid & 63, fr = l & 15, fq = l >> 4;
    const int row0 = MP + 64 * (t >> 4), col0 = 64 * (t & 15), row = row0 + 16 * (w & 3) + fr;
    LP(float) RED = (LP(float))(lds + L_MINI_RED);
    f32x4 acc[2] = {{0.f, 0.f, 0.f, 0.f}, {0.f, 0.f, 0.f, 0.f}};
    mm_tile(lds, A, lda, Bt, ldb, K, row0, col0, acc);
    float ss = 0.f;
#pragma unroll
    for (int n = 0; n < 2; ++n) {
        const int c = col0 + 32 * (w >> 2) + 16 * n + 4 * fq;
        f32x4 xi;
        if (xin_b) { const u32x2 xb = *(const u32x2*)(xin_b + (size_t)row * D + c); xi = (f32x4){bf_lo(xb.x), bf_hi(xb.x), bf_lo(xb.y), bf_hi(xb.y)}; }
        else xi = *(const f32x4*)(xin + (size_t)(row - xin_row0) * D + c);
        const f32x4 x = xi + acc[n];
        if (Y) *(f32x4*)(Y + (size_t)row * D + c) = x;
        if (XB) { u32x2 o; o.x = pk2(x[0], x[1]); o.y = pk2(x[2], x[3]); *(u32x2*)(XB + (size_t)row * D + c) = o; }
        ss += (x[0] * x[0] + x[1] * x[1]) + (x[2] * x[2] + x[3] * x[3]);
    }
    ss += shfl_xor_f(ss, 16); ss += shfl_xor_f(ss, 32);
    wg_sync();
    if (w >= 4 && fq == 0) RED[16 * (w & 3) + fr] = ss;
    wg_sync();
    if (w < 4 && fq == 0) SS[(size_t)row * 16 + (t & 15)] = ss + RED[16 * w + fr];
}
#ifndef HOST_EMU
DI void fin_tile(LP(unsigned char) lds, const bf16* A, int lda, const bf16* Bt, int ldb, int K, const bf16* xin_b, const float* gain, float* Y, float* SS, unsigned* cnt, unsigned* tmo, int t) {
    const int tid = t_id(), w = wave_id(), l = tid & 63, fr = l & 15, fq = l >> 4;
    const int row0 = MP + 64 * (t >> 4), col0 = 64 * (t & 15), row = row0 + 16 * (w & 3) + fr;
    LP(float) RED = (LP(float))(lds + L_MINI_RED);
    f32x4 acc[2] = {{0.f, 0.f, 0.f, 0.f}, {0.f, 0.f, 0.f, 0.f}};
    mm_tile(lds, A, lda, Bt, ldb, K, row0, col0, acc);
    float ss = 0.f;
#pragma unroll
    for (int n = 0; n < 2; ++n) {
        const int c = col0 + 32 * (w >> 2) + 16 * n + 4 * fq;
        const u32x2 xb = *(const u32x2*)(xin_b + (size_t)row * D + c);
        acc[n] = acc[n] + (f32x4){bf_lo(xb.x), bf_hi(xb.x), bf_lo(xb.y), bf_hi(xb.y)};
        ss += (acc[n][0] * acc[n][0] + acc[n][1] * acc[n][1]) + (acc[n][2] * acc[n][2] + acc[n][3] * acc[n][3]);
    }
    ss += shfl_xor_f(ss, 16); ss += shfl_xor_f(ss, 32);
    wg_sync();
    if (w >= 4 && fq == 0) RED[16 * (w & 3) + fr] = ss;
    wg_sync();
    if (w < 4) {
        if (fq == 0) __hip_atomic_store((unsigned*)(SS + (size_t)row * 16 + (t & 15)), __float_as_uint(ss + RED[16 * w + fr]), __ATOMIC_RELAXED, __HIP_MEMORY_SCOPE_AGENT);
        asm volatile("s_waitcnt vmcnt(0)" ::: "memory");
        if (l == 0) __hip_atomic_fetch_add(cnt + 64 * (t >> 4), 1u, __ATOMIC_RELAXED, __HIP_MEMORY_SCOPE_AGENT);
    }
    if (w == 0) {
        unsigned spins = 0;
        while ((unsigned)__builtin_amdgcn_readfirstlane(__hip_atomic_load(cnt + 64 * (t >> 4), __ATOMIC_RELAXED, __HIP_MEMORY_SCOPE_AGENT)) < 64u) {
            __builtin_amdgcn_s_sleep(2);
            if (++spins > (1u << 22)) { if (l == 0) __hip_atomic_store(tmo, 1u, __ATOMIC_RELAXED, __HIP_MEMORY_SCOPE_AGENT); break; }
        }
        __builtin_amdgcn_fence(__ATOMIC_ACQUIRE, "agent");
    }
    asm volatile("s_waitcnt vmcnt(0) lgkmcnt(0)" ::: "memory"); __builtin_amdgcn_s_barrier(); asm volatile("" ::: "memory");
    if (w < 4 && fq == 0) {
        const unsigned* sl = (const unsigned*)(SS + (size_t)row * 16);
        float s = 0.f;
#pragma unroll
        for (int j = 0; j < 16; ++j) s += __uint_as_float(__hip_atomic_load(sl + j, __ATOMIC_RELAXED, __HIP_MEMORY_SCOPE_AGENT));
        RED[64 + 16 * w + fr] = 1.0f / sqrtf(s * (1.0f / D) + RMS_EPS);
    }
    wg_sync();
    const float rs = RED[64 + 16 * (w & 3) + fr];
#pragma unroll
    for (int n = 0; n < 2; ++n) { const int c = col0 + 32 * (w >> 2) + 16 * n + 4 * fq; *(f32x4*)(Y + (size_t)row * D + c) = acc[n] * rs * *(const f32x4*)(gain + c); }
}
#endif
}
#ifndef HOST_EMU
namespace ep {
using namespace cfg;
using pg8::Unit; using pg8::HALF; using pg8::BM;
DI u32x4 pack8f(const f32x4& a, const f32x4& b) { u32x4 w; w.x = pg8::cvt_pk_bf16(a[0], a[1]); w.y = pg8::cvt_pk_bf16(a[2], a[3]); w.z = pg8::cvt_pk_bf16(b[0], b[1]); w.w = pg8::cvt_pk_bf16(b[2], b[3]); return w; }
DI void unpack8(const u32x4& w, f32x4& a, f32x4& b) { a[0] = bf_lo(w.x); a[1] = bf_hi(w.x); a[2] = bf_lo(w.y); a[3] = bf_hi(w.y); b[0] = bf_lo(w.z); b[1] = bf_hi(w.z); b[2] = bf_lo(w.w); b[3] = bf_hi(w.w); }

struct EpiG1 {
    static constexpr bool PERM = true, AFTER_DRAIN = false;
    bf16 *QKV, *Z, *UV, *QMEM, *HALO; float *CSP, *CSS; const float* rstd;
    DI void operator()(const f32x4 (&acc)[2][2][4][2], const Unit& u, int wr, int wc, int fr, int fq) const {
        const int row0 = u.pm * BM + wr * 64 + fr, pn = u.pn;
        bf16* base; int ld, colt, mode;
        if (pn < 12) { base = QKV; ld = QKVW; colt = pn * 256; mode = 0; }
        else if (pn < 16) { base = Z; ld = D; colt = (pn - 12) * 256; mode = 1; }
        else if (pn < 20) { base = UV; ld = D; colt = (pn - 16) * 256; mode = 2; }
        else { base = QMEM; ld = MEMW; colt = (pn - 20) * 256; mode = 3; }
        const int col0 = colt + wc * 32 + 8 * fq;
        float rsv[2][4];
#pragma unroll
        for (int ai = 0; ai < 2; ++ai)
#pragma unroll
            for (int m = 0; m < 4; ++m) rsv[ai][m] = rstd[row0 + ai * HALF + m * 16];
#pragma unroll
        for (int ai = 0; ai < 2; ++ai)
#pragma unroll
            for (int m = 0; m < 4; ++m) {
                const int r = row0 + ai * HALF + m * 16; const float rs = rsv[ai][m];
#pragma unroll
                for (int bj = 0; bj < 2; ++bj) {
                    f32x4 v0 = acc[ai][bj][m][0] * rs, v1 = acc[ai][bj][m][1] * rs;
                    if (mode == 1) {
#pragma unroll
                        for (int j = 0; j < 4; ++j) { v0[j] = silu_f(v0[j]); v1[j] = silu_f(v1[j]); } }
                    else if (mode == 2) {
#pragma unroll
                        for (int j = 0; j < 4; ++j) { v0[j] = gelu_tanh_f(v0[j]); v1[j] = gelu_tanh_f(v1[j]); } }
                    else if (mode == 3) { v0 = v0 * QSCALE_MEM; v1 = v1 * QSCALE_MEM; }
                    const u32x4 w = pack8f(v0, v1);
                    *(u32x4*)(base + (size_t)r * ld + col0 + bj * HALF) = w;
                    if (mode == 0) {
                        const int c = col0 + bj * HALF;
                        if (m == 3 && fr >= 13) {
                            *(u32x4*)(HALO + ((size_t)(r >> 6) * 3 + ((r & 63) - 61)) * QKVW + c) = w;
                            if (r < MP && (r & 2047) >= 2045) { float* d = CSP + ((size_t)(r >> 11) * 3 + ((r & 2047) - 2045)) * QKVW + c; *(f32x4*)d = v0; *(f32x4*)(d + 4) = v1; }
                        }
                        if (r >= MP && (r & 7) >= 5) { float* d = CSS + ((size_t)((r - MP) >> 3) * 3 + ((r & 7) - 5)) * QKVW + c; *(f32x4*)d = v0; *(f32x4*)(d + 4) = v1; }
                    }
                }
            }
    }
};
struct EpiKV {
    static constexpr bool PERM = false, AFTER_DRAIN = false;
    float *MK, *MV; const float* rstd;
    DI void operator()(const f32x4 (&acc)[2][2][4][2], const Unit& u, int wr, int wc, int fr, int fq) const {
        const int row0 = u.pm * BM + wr * 64 + fr, col0 = u.pn * BM + wc * 32 + 4 * fq;
        float rsv[2][4];
#pragma unroll
        for (int ai = 0; ai < 2; ++ai)
#pragma unroll
            for (int m = 0; m < 4; ++m) rsv[ai][m] = rstd[row0 + ai * HALF + m * 16];
#pragma unroll
        for (int ai = 0; ai < 2; ++ai)
#pragma unroll
            for (int m = 0; m < 4; ++m) {
                const int r = row0 + ai * HALF + m * 16; const float rs = rsv[ai][m];
#pragma unroll
                for (int bj = 0; bj < 2; ++bj)
#pragma unroll
                    for (int n = 0; n < 2; ++n) { const int c = col0 + bj * HALF + n * 16; float* d = (c < MEMW) ? MK + (size_t)r * MEMW + c : MV + (size_t)r * MEMW + (c - MEMW); *(f32x4*)d = acc[ai][bj][m][n] * rs; }
            }
    }
};
struct EpiGate {
    static constexpr bool PERM = true, AFTER_DRAIN = false;
    bf16* G; const float* rstd; int skip;
    DI void operator()(const f32x4 (&acc)[2][2][4][2], const Unit& u, int wr, int wc, int fr, int fq) const {
        if (skip) { asm volatile("" :: "v"(acc[0][0][0][0][0]), "v"(acc[1][1][3][1][3])); return; }
        const int row0 = u.pm * BM + wr * 64 + fr, col0 = u.pn * BM + wc * 32 + 8 * fq;
        float rsv[2][4];
#pragma unroll
        for (int ai = 0; ai < 2; ++ai)
#pragma unroll
            for (int m = 0; m < 4; ++m) rsv[ai][m] = rstd[row0 + ai * HALF + m * 16];
#pragma unroll
        for (int ai = 0; ai < 2; ++ai)
#pragma unroll
            for (int m = 0; m < 4; ++m) {
                const int r = row0 + ai * HALF + m * 16; const float rs = rsv[ai][m];
#pragma unroll
                for (int bj = 0; bj < 2; ++bj) {
                    f32x4 v0 = acc[ai][bj][m][0] * rs, v1 = acc[ai][bj][m][1] * rs;
#pragma unroll
                    for (int j = 0; j < 4; ++j) { v0[j] = sigmoid_f(v0[j]); v1[j] = sigmoid_f(v1[j]); }
                    *(u32x4*)(G + (size_t)r * NGATE + col0 + bj * HALF) = pack8f(v0, v1);
                }
            }
    }
};
struct EpiBr {
    static constexpr bool PERM = true, AFTER_DRAIN = false;
    const bf16* G; bf16* MG; int b;
    DI void operator()(const f32x4 (&acc)[2][2][4][2], const Unit& u, int wr, int wc, int fr, int fq) const {
        const int row0 = u.pm * BM + wr * 64 + fr, col0 = u.pn * BM + wc * 32 + 8 * fq;
#pragma unroll
        for (int ai = 0; ai < 2; ++ai) {
            u32x4 gv[4][2], ov[4][2];
#pragma unroll
            for (int m = 0; m < 4; ++m)
#pragma unroll
                for (int bj = 0; bj < 2; ++bj) {
                    const size_t r = (size_t)(row0 + ai * HALF + m * 16); const int c = col0 + bj * HALF;
                    gv[m][bj] = *(const u32x4*)(G + r * NGATE + b * D + c);
                    ov[m][bj] = (b > 0) ? *(const u32x4*)(MG + r * D + c) : (u32x4){0u, 0u, 0u, 0u};
                }
#pragma unroll
            for (int m = 0; m < 4; ++m)
#pragma unroll
                for (int bj = 0; bj < 2; ++bj) {
                    const size_t r = (size_t)(row0 + ai * HALF + m * 16); const int c = col0 + bj * HALF;
                    f32x4 g0, g1, o0, o1; unpack8(gv[m][bj], g0, g1); unpack8(ov[m][bj], o0, o1);
                    const f32x4 v0 = acc[ai][bj][m][0] * g0 + o0, v1 = acc[ai][bj][m][1] * g1 + o1;
                    *(u32x4*)(MG + r * D + c) = pack8f(v0, v1);
                }
            asm volatile("" ::: "memory");
        }
    }
};
struct EpiRes {
    static constexpr bool PERM = false, AFTER_DRAIN = false;
    const float* xin_p; const float* xin_s; const bf16* xin_b; float* Y; bf16* XB; float* SS;
    DI void operator()(const f32x4 (&acc)[2][2][4][2], const Unit& u, int wr, int wc, int fr, int fq) const {
        const int row0 = u.pm * BM + wr * 64 + fr, col0 = u.pn * BM + wc * 32 + 4 * fq;
#pragma unroll
        for (int ai = 0; ai < 2; ++ai) {
            f32x4 xv[4][2][2];
            if (xin_b) {
                u32x2 xb[4][2][2];
#pragma unroll
                for (int m = 0; m < 4; ++m)
#pragma unroll
                    for (int bj = 0; bj < 2; ++bj)
#pragma unroll
                        for (int n = 0; n < 2; ++n) xb[m][bj][n] = *(const u32x2*)(xin_b + (size_t)(row0 + ai * HALF + m * 16) * D + col0 + bj * HALF + n * 16);
#pragma unroll
                for (int m = 0; m < 4; ++m)
#pragma unroll
                    for (int bj = 0; bj < 2; ++bj)
#pragma unroll
                        for (int n = 0; n < 2; ++n) xv[m][bj][n] = (f32x4){bf_lo(xb[m][bj][n].x), bf_hi(xb[m][bj][n].x), bf_lo(xb[m][bj][n].y), bf_hi(xb[m][bj][n].y)};
            } else {
#pragma unroll
                for (int m = 0; m < 4; ++m) {
                    const int r = row0 + ai * HALF + m * 16;
                    const float* xin = (r < MP) ? xin_p + (size_t)r * D : xin_s + (size_t)(r - MP) * D;
#pragma unroll
                    for (int bj = 0; bj < 2; ++bj)
#pragma unroll
                        for (int n = 0; n < 2; ++n) xv[m][bj][n] = *(const f32x4*)(xin + col0 + bj * HALF + n * 16);
                }
            }
#pragma unroll
            for (int m = 0; m < 4; ++m) {
                const int r = row0 + ai * HALF + m * 16;
                float ss = 0.f;
#pragma unroll
                for (int bj = 0; bj < 2; ++bj)
#pragma unroll
                    for (int n = 0; n < 2; ++n) {
                        const int c = col0 + bj * HALF + n * 16;
                        const f32x4 x = xv[m][bj][n] + acc[ai][bj][m][n];
                        if (Y) *(f32x4*)(Y + (size_t)r * D + c) = x;
                        if (XB) { u32x2 w; w.x = pg8::cvt_pk_bf16(x[0], x[1]); w.y = pg8::cvt_pk_bf16(x[2], x[3]); *(u32x2*)(XB + (size_t)r * D + c) = w; }
                        ss += (x[0] * x[0] + x[1] * x[1]) + (x[2] * x[2] + x[3] * x[3]);
                    }
                ss += __shfl_xor(ss, 16); ss += __shfl_xor(ss, 32);
                if (fq == 0) SS[(size_t)r * 16 + u.pn * 4 + wc] = ss;
            }
            asm volatile("" ::: "memory");
        }
    }
};
DI float rstd_from_ss(const float* SS, int r) {
    const f32x4 a = *(const f32x4*)(SS + (size_t)r * 16), b = *(const f32x4*)(SS + (size_t)r * 16 + 4), c = *(const f32x4*)(SS + (size_t)r * 16 + 8), d = *(const f32x4*)(SS + (size_t)r * 16 + 12);
    const float s = (((a[0] + a[1]) + (a[2] + a[3])) + ((b[0] + b[1]) + (b[2] + b[3]))) + (((c[0] + c[1]) + (c[2] + c[3])) + ((d[0] + d[1]) + (d[2] + d[3])));
    return 1.0f / sqrtf(s * (1.0f / D) + RMS_EPS);
}
struct EpiGU {
    static constexpr bool PERM = true, AFTER_DRAIN = false;
    const float* SS; bf16* HB;
    DI void operator()(const f32x4 (&acc)[2][2][4][2], const Unit& u, int wr, int wc, int fr, int fq) const {
        const int row0 = u.pm * BM + wr * 64 + fr, col0 = u.pn * HALF + wc * 32 + 8 * fq;
#pragma unroll
        for (int ai = 0; ai < 2; ++ai) {
            f32x4 sv[4][4];
#pragma unroll
            for (int m = 0; m < 4; ++m)
#pragma unroll
                for (int j = 0; j < 4; ++j) sv[m][j] = *(const f32x4*)(SS + (size_t)(row0 + ai * HALF + m * 16) * 16 + 4 * j);
#pragma unroll
            for (int m = 0; m < 4; ++m) {
                const int r = row0 + ai * HALF + m * 16;
                const f32x4 a4 = sv[m][0], b4 = sv[m][1], c4 = sv[m][2], d4 = sv[m][3];
                const float ssum = (((a4[0] + a4[1]) + (a4[2] + a4[3])) + ((b4[0] + b4[1]) + (b4[2] + b4[3]))) + (((c4[0] + c4[1]) + (c4[2] + c4[3])) + ((d4[0] + d4[1]) + (d4[2] + d4[3])));
                const float rs = 1.0f / sqrtf(ssum * (1.0f / D) + RMS_EPS);
                f32x4 h0, h1;
#pragma unroll
                for (int j = 0; j < 4; ++j) { h0[j] = silu_f(acc[ai][0][m][0][j] * rs) * (acc[ai][1][m][0][j] * rs); h1[j] = silu_f(acc[ai][0][m][1][j] * rs) * (acc[ai][1][m][1][j] * rs); }
                *(u32x4*)(HB + (size_t)r * FF + col0) = pack8f(h0, h1);
            }
            asm volatile("" ::: "memory");
        }
    }
};
struct EpiFinal {
    static constexpr bool PERM = false, AFTER_DRAIN = true;
    const bf16* xin_b; const float* gain; float* Y; float* SS; unsigned* cnt; unsigned* tmo;
    DI void fused(f32x4 (&acc)[2][2][4][2], const Unit& u, int wr, int wc, int fr, int fq, PG8_LAS unsigned char* lds, int wid, int lane) const {
        PG8_LAS float* P = (PG8_LAS float*)lds;
        PG8_LAS float* R = (PG8_LAS float*)(lds + 8192);
        const int row0 = u.pm * BM + wr * 64 + fr, col0 = u.pn * BM + wc * 32 + 4 * fq;
#pragma unroll
        for (int ai = 0; ai < 2; ++ai) {
            u32x2 xb[4][2][2];
#pragma unroll
            for (int m = 0; m < 4; ++m)
#pragma unroll
                for (int bj = 0; bj < 2; ++bj)
#pragma unroll
                    for (int n = 0; n < 2; ++n) xb[m][bj][n] = *(const u32x2*)(xin_b + (size_t)(row0 + ai * HALF + m * 16) * D + col0 + bj * HALF + n * 16);
#pragma unroll
            for (int m = 0; m < 4; ++m) {
                float ss = 0.f;
#pragma unroll
                for (int bj = 0; bj < 2; ++bj)
#pragma unroll
                    for (int n = 0; n < 2; ++n) {
                        const f32x4 x = (f32x4){bf_lo(xb[m][bj][n].x), bf_hi(xb[m][bj][n].x), bf_lo(xb[m][bj][n].y), bf_hi(xb[m][bj][n].y)} + acc[ai][bj][m][n];
                        acc[ai][bj][m][n] = x; ss += (x[0] * x[0] + x[1] * x[1]) + (x[2] * x[2] + x[3] * x[3]);
                    }
                ss += __shfl_xor(ss, 16); ss += __shfl_xor(ss, 32);
                if (fq == 0) P[(ai * HALF + wr * 64 + m * 16 + fr) * 4 + wc] = ss;
            }
            asm volatile("" ::: "memory");
        }
        asm volatile("s_waitcnt lgkmcnt(0)" ::: "memory"); __builtin_amdgcn_s_barrier(); asm volatile("" ::: "memory");
        const int row = wid * 32 + (lane & 31);
        if (lane < 32) {
            const float t = (P[row * 4 + 0] + P[row * 4 + 1]) + (P[row * 4 + 2] + P[row * 4 + 3]);
            __hip_atomic_store((unsigned*)(SS + (size_t)(u.pm * BM + row) * 16 + u.pn), __float_as_uint(t), __ATOMIC_RELAXED, __HIP_MEMORY_SCOPE_AGENT);
        }
        asm volatile("s_waitcnt vmcnt(0)" ::: "memory");
        if (lane == 0) __hip_atomic_fetch_add(cnt + 64 * u.pm, 1u, __ATOMIC_RELAXED, __HIP_MEMORY_SCOPE_AGENT);
        if (wid == 0) {
            unsigned spins = 0;
            while ((unsigned)__builtin_amdgcn_readfirstlane(__hip_atomic_load(cnt + 64 * u.pm, __ATOMIC_RELAXED, __HIP_MEMORY_SCOPE_AGENT)) < 32u) {
                __builtin_amdgcn_s_sleep(2);
                if (++spins > (1u << 22)) { if (lane == 0) __hip_atomic_store(tmo, 1u, __ATOMIC_RELAXED, __HIP_MEMORY_SCOPE_AGENT); break; }
            }
            __builtin_amdgcn_fence(__ATOMIC_ACQUIRE, "agent");
        }
        asm volatile("s_waitcnt vmcnt(0) lgkmcnt(0)" ::: "memory"); __builtin_amdgcn_s_barrier(); asm volatile("" ::: "memory");
        if (lane < 32) {
            const unsigned* sl = (const unsigned*)(SS + (size_t)(u.pm * BM + row) * 16);
            const float s = (__uint_as_float(__hip_atomic_load(sl + 0, __ATOMIC_RELAXED, __HIP_MEMORY_SCOPE_AGENT)) + __uint_as_float(__hip_atomic_load(sl + 1, __ATOMIC_RELAXED, __HIP_MEMORY_SCOPE_AGENT)))
                          + (__uint_as_float(__hip_atomic_load(sl + 2, __ATOMIC_RELAXED, __HIP_MEMORY_SCOPE_AGENT)) + __uint_as_float(__hip_atomic_load(sl + 3, __ATOMIC_RELAXED, __HIP_MEMORY_SCOPE_AGENT)));
            R[row] = 1.0f / sqrtf(s * (1.0f / D) + RMS_EPS);
        }
        asm volatile("s_waitcnt lgkmcnt(0)" ::: "memory"); __builtin_amdgcn_s_barrier(); asm volatile("" ::: "memory");
        f32x4 gv[2][2];
#pragma unroll
        for (int bj = 0; bj < 2; ++bj)
#pragma unroll
            for (int n = 0; n < 2; ++n) gv[bj][n] = *(const f32x4*)(gain + col0 + bj * HALF + n * 16);
#pragma unroll
        for (int ai = 0; ai < 2; ++ai)
#pragma unroll
            for (int m = 0; m < 4; ++m) {
                const int rl = ai * HALF + wr * 64 + m * 16 + fr; const float rs = R[rl];
#pragma unroll
                for (int bj = 0; bj < 2; ++bj)
#pragma unroll
                    for (int n = 0; n < 2; ++n) *(f32x4*)(Y + (size_t)(u.pm * BM + rl) * D + col0 + bj * HALF + n * 16) = acc[ai][bj][m][n] * rs * gv[bj][n];
            }
    }
};
}
using namespace cfg;
constexpr int NWAVES = 8;
#ifndef MK_N_LAUNCHES
#define MK_N_LAUNCHES 1
#endif
constexpr int N_PHASES = 9;
struct Args { const float* in[26]; float* out; unsigned char* ws; int ph_lo, ph_hi, li, pad; };
static_assert(sizeof(Args) == 26 * 8 + 8 + 8 + 16, "no padding bytes in the kernel argument");
enum { I_XP = 0, I_XS, I_SD, I_SC, I_CK, I_CV, I_MEM, I_NMIX, I_WIN, I_CONVW, I_ALOG, I_DTB, I_DNN, I_SGN, I_SGW, I_SGB, I_WBD, I_WBS, I_WBM, I_WO, I_MNORM, I_WKV, I_NFFN, I_WGU, I_WDN, I_NFIN };

DI void p0_transpose_item(const float* W, int ld_src, int n0, int k0, const float* gain, bf16* WT, int ld_dst, int drow0, int koff, LAS float* scr, int lane) {
    float wv[32], gv[32];
#pragma unroll
    for (int i = 0; i < 32; ++i) { const int kk = 2 * i + (lane >> 5); wv[i] = W[(size_t)(k0 + kk) * ld_src + n0 + (lane & 31)]; gv[i] = gain ? gain[k0 + kk] : 1.0f; }
#pragma unroll
    for (int i = 0; i < 32; ++i) { const int kk = 2 * i + (lane >> 5); scr[kk * 33 + (lane & 31)] = wv[i] * gv[i]; }
    LDS_WAIT(); asm volatile("" ::: "memory");
    const int c = lane & 7;
#pragma unroll
    for (int j = 0; j < 4; ++j) { const int n = (lane >> 3) + 8 * j; const LAS float* s = scr + (8 * c) * 33 + n;
        v4u o; o.x = pk2(s[0 * 33], s[1 * 33]); o.y = pk2(s[2 * 33], s[3 * 33]); o.z = pk2(s[4 * 33], s[5 * 33]); o.w = pk2(s[6 * 33], s[7 * 33]);
        *(GAS v4u*)(WT + (size_t)(drow0 + n) * ld_dst + koff + k0 + 8 * c) = o; }
    LDS_WAIT(); asm volatile("" ::: "memory");
}

DI void p0_prologue(const Args& a, LAS unsigned char* lds, int vcu, int G) {
    const int tid = t_id(), lane = tid & 63, wave = __builtin_amdgcn_readfirstlane(tid >> 6);
    unsigned char* ws = a.ws;
    LAS float* scr = (LAS float*)(lds + wave * 16384);
    const int gw = vcu * NWAVES + wave, NGW = G * NWAVES;
    constexpr int I0 = 16 * 272, I1 = I0 + 16 * 32, I2 = I1 + 8 * 32, I3 = I2 + 8 * 32, I4 = I3 + 16 * 32, I5 = I4 + 16 * 32, I6 = I5 + 16 * 176, I7 = I6 + 44 * 32;
#ifndef DUP0
#define DUP0 0
#endif
    for (int rep0 = 0; rep0 < ((DUP0 & 1) ? 2 : 1); ++rep0)
    for (int it = gw; it < I7; it += NGW) {
        if (it < I0) { const int kb = it / 272, nb = it % 272, dr = 32 * nb; p0_transpose_item(a.in[I_WIN], DIN, dr < 4096 ? dr : dr + 16, 64 * kb, a.in[I_NMIX], (bf16*)(ws + WS_WIN), D, dr, 0, scr, lane); }
        else if (it < I1) { const int r = it - I0, kb = r / 32, nb = r % 32; p0_transpose_item(a.in[I_WBD], D, 32 * nb, 64 * kb, nullptr, (bf16*)(ws + WS_WBR), 2048, 32 * nb, 0, scr, lane); }
        else if (it < I2) { const int r = it - I1, kb = r / 32, nb = r % 32; p0_transpose_item(a.in[I_WBS], D, 32 * nb, 64 * kb, nullptr, (bf16*)(ws + WS_WBR), 2048, 32 * nb, 1024, scr, lane); }
        else if (it < I3) { const int r = it - I2, kb = r / 32, nb = r % 32; p0_transpose_item(a.in[I_WBM], D, 32 * nb, 64 * kb, nullptr, (bf16*)(ws + WS_WBR), 2048, 32 * nb, 1536, scr, lane); }
        else if (it < I4) { const int r = it - I3, kb = r / 32, nb = r % 32; p0_transpose_item(a.in[I_WO], D, 32 * nb, 64 * kb, nullptr, (bf16*)(ws + WS_WO), D, 32 * nb, 0, scr, lane); }
        else if (it < I5) { const int r = it - I4, kb = r / 32, nb = r % 32; p0_transpose_item(a.in[I_WKV], D, 32 * nb, 64 * kb, a.in[I_MNORM], (bf16*)(ws + WS_WKV), D, 32 * nb, 0, scr, lane); }
        else if (it < I6) { const int r = it - I5, kb = r / 176, nb = r % 176, n0 = 32 * nb, up = n0 >= FF, f0 = n0 - up * FF;
            p0_transpose_item(a.in[I_WGU], 2 * FF, n0, 64 * kb, a.in[I_NFFN], (bf16*)(ws + WS_WGU), D, 256 * (f0 / 128) + 128 * up + (f0 % 128), 0, scr, lane); }
        else { const int r = it - I6, kb = r / 32, nb = r % 32; p0_transpose_item(a.in[I_WDN], D, 32 * nb, 64 * kb, nullptr, (bf16*)(ws + WS_WDN), FF, 32 * nb, 0, scr, lane); }
    }
    { bf16* sw = (bf16*)(ws + WS_SGW); const float* w = a.in[I_SGW];
      for (int i = (vcu * NWAVES * 64) + tid; i < 4 * 128 * 128; i += G * NWAVES * 64) { const int t = (i >> 7) & 127, s = i & 127; sw[i] = (bf16)f2bf(s <= t ? w[i] : 0.f); } }
    __syncthreads();
    LAS float* img = (LAS float*)lds;
    for (int i = tid; i < 16 * 1024; i += NWAVES * 64) { const int k = i >> 4, c = i & 15; img[c * 1024 + k] = a.in[I_WIN][(size_t)k * DIN + 4096 + c] * a.in[I_NMIX][k]; }
    __syncthreads();
    bf16* XB = (bf16*)(ws + WS_XB); float* RS = (float*)(ws + WS_RSTDX); float* BA = (float*)(ws + WS_BA);
    f32x4 vnx[4];
    { const int m = gw; if (m < M) { const float* xrow = (m < MP) ? a.in[I_XP] + (size_t)m * D : a.in[I_XS] + (size_t)(m - MP) * D; const GAS f32x4* xr = (const GAS f32x4*)xrow + lane;
#pragma unroll
        for (int j = 0; j < 4; ++j) vnx[j] = xr[64 * j]; } }
    for (int m = gw; m < M; m += NGW) {
        f32x4 v[4]; float s = 0.f;
#pragma unroll
        for (int j = 0; j < 4; ++j) v[j] = vnx[j];
        { const int mn = m + NGW; if (mn < M) { const float* xrow = (mn < MP) ? a.in[I_XP] + (size_t)mn * D : a.in[I_XS] + (size_t)(mn - MP) * D; const GAS f32x4* xr = (const GAS f32x4*)xrow + lane;
#pragma unroll
            for (int j = 0; j < 4; ++j) vnx[j] = xr[64 * j]; } }
#pragma unroll
        for (int j = 0; j < 4; ++j) s += (v[j].x * v[j].x + v[j].y * v[j].y) + (v[j].z * v[j].z + v[j].w * v[j].w);
        const float rstd = 1.f / sqrtf(wave_sum(s) * (1.f / D) + RMS_EPS);
        GAS unsigned long long* o8 = (GAS unsigned long long*)(XB + (size_t)m * D) + lane;
#pragma unroll
        for (int j = 0; j < 4; ++j) o8[64 * j] = (unsigned long long)pk2(v[j].x, v[j].y) | ((unsigned long long)pk2(v[j].z, v[j].w) << 32);
        float mine = 0.f;
#pragma unroll 1
        for (int c = 0; c < 16; ++c) {
            float p = 0.f;
#pragma unroll
            for (int j = 0; j < 4; ++j) { const f32x4 wv = *(const LAS f32x4*)(img + c * 1024 + 256 * j + 4 * lane); p += (v[j].x * wv.x + v[j].y * wv.y) + (v[j].z * wv.z + v[j].w * wv.w); }
            p = wave_sum(p);
            if (lane == c) mine = p;
        }
        if (lane < 16) BA[(size_t)m * 16 + lane] = mine * rstd;
        if (lane == 0) RS[m] = rstd;
    }
    bf16* MB = (bf16*)(ws + WS_MB); float* RM = (float*)(ws + WS_RSTDM);
    for (int m = gw; m < NB * MEMT; m += NGW) {
        const GAS f32x4* xr = (const GAS f32x4*)(a.in[I_MEM] + (size_t)m * D) + lane;
        f32x4 v[4]; float s = 0.f;
#pragma unroll
        for (int j = 0; j < 4; ++j) { v[j] = xr[64 * j]; s += (v[j].x * v[j].x + v[j].y * v[j].y) + (v[j].z * v[j].z + v[j].w * v[j].w); }
        const float rstd = 1.f / sqrtf(wave_sum(s) * (1.f / D) + RMS_EPS);
        GAS unsigned long long* o8 = (GAS unsigned long long*)(MB + (size_t)m * D) + lane;
#pragma unroll
        for (int j = 0; j < 4; ++j) o8[64 * j] = (unsigned long long)pk2(v[j].x, v[j].y) | ((unsigned long long)pk2(v[j].z, v[j].w) << 32);
        if (lane == 0) RM[m] = rstd;
    }
}

DI void stagger_delay(unsigned ticks) { const unsigned long long t0 = __builtin_amdgcn_s_memrealtime(); while (__builtin_amdgcn_s_memrealtime() - t0 < ticks) __builtin_amdgcn_s_sleep(8); }
struct RotOrder : pg8::StaticOrder { };

__global__ void __launch_bounds__(NWAVES * 64, 2) hyb_fwd(Args args) {
    extern __shared__ __attribute__((aligned(16))) unsigned char lds_raw[];
    LAS unsigned char* lds = (LAS unsigned char*)lds_raw;
    volatile LAS unsigned* MISC = (volatile LAS unsigned*)(lds + MISC_OFF);
    const int G = gridDim.x, bx = blockIdx.x, vcu = (G % 8 == 0) ? (bx % 8) * (G / 8) + bx / 8 : bx;
    for (int u = t_id(); u < 128; u += NWAVES * 64) ((LAS unsigned*)(lds + MISC_OFF))[u] = 0u;
    unsigned char* const ws = args.ws; float* const out = args.out; gu32* const ctl = (gu32*)(ws + WS_CTL);
    __syncthreads();
    XcdBarrier bar; bar.bar = (unsigned*)(ctl + CW_BAR) + args.li * XCD_BAR_WORDS; bar.x = 0; bar.st = nullptr;
    if (MK_N_LAUNCHES <= 2) bar = xcd_barrier_post((unsigned*)(ctl + CW_BAR) + args.li * XCD_BAR_WORDS, MISC + 8);
    const int lo = args.ph_lo, hi = args.ph_hi, pass = args.li;
#ifndef PH_MASK
#define PH_MASK 0x3ff
#endif
#define IN(k) (((PH_MASK >> (k)) & 1) && lo <= (k) && (k) < hi)
#define SEAM(k) do { if (IN(k) && IN((k) + 1)) xcd_barrier(bar); } while (0)
    bf16* const XB = (bf16*)(ws + WS_XB); const float* const RSX = (const float*)(ws + WS_RSTDX);

    if (IN(0)) { p0_prologue(args, lds, vcu, G); }
    SEAM(0);
    if (IN(1)) {
#ifdef STAGGER
        if ((bx >> 3) & 1) stagger_delay(STAGGER);
#endif
        { pg8::Gemm g{XB, (const bf16*)(ws + WS_WIN), MP, 4096, D, D, D}; pg8::StaticOrder S; S.init(MP, 4096, G, bx);
          ep::EpiG1 E{(bf16*)(ws + WS_QKV), (bf16*)out  , (bf16*)out + (size_t)M * D, (bf16*)(ws + WS_QMEM), (bf16*)(ws + WS_HALO), out + O_CSP, out + O_CSS, RSX};
          pg8::gemm_phase<ep::EpiG1, pg8::StaticOrder, true, true>(lds, g, S, E); }
    }
    SEAM(1);
    DnPtrs DP{(const bf16*)(ws + WS_QKV), (const bf16*)(ws + WS_HALO), (const float*)(ws + WS_BA), args.in[I_CONVW], args.in[I_ALOG], args.in[I_DTB], args.in[I_DNN],
              (bf16*)(ws + WS_WB), (bf16*)(ws + WS_QD), (bf16*)(ws + WS_KDT), (unsigned*)(ws + WS_UB), (bf16*)(ws + WS_AB), (float*)(ws + WS_DL),
              (const bf16*)out, (bf16*)(ws + WS_OCAT), out + O_DSP, args.in[I_SD], args.in[I_SC], out + O_DSS};
    if (IN(2)) {
        dn::PrepRaw R;
        if (vcu < NB * H * NCH) dn::prep_fetch(DP, R, vcu >> 8, (vcu >> 5) & 7, vcu & 31);
        for (int i = vcu; i < NB * H * NCH; i += G) { const int in = i + G; dn::prep_item(lds, DP, i >> 8, (i >> 5) & 7, i & 31, R, in < NB * H * NCH, in >> 8, (in >> 5) & 7, in & 31); }
        __syncthreads();
    }
    SEAM(2);
    if (IN(3)) {
#ifndef IT_MASK
#define IT_MASK 0x3f
#endif
#ifndef DUPQ
#define DUPQ 0
#endif
        gu32* const sub = ctl + 3072 + 64 * pass;
        if (bx < NB * H) { for (int rep = 0; rep < ((DUPQ & 1) ? 2 : 1); ++rep) dn::scan_item(lds, DP, bx >> 3, bx & 7); }
        else {
            const int cr = bx - NB * H, nq_ = G - NB * H, c = (nq_ % 8 == 0) ? (cr % 8) * (nq_ / 8) + cr / 8 : cr;
            { pg8::Gemm g{XB, (const bf16*)(ws + WS_WIN), M, N1, D, D, D}; pg8::ListG1 S{c, nq_};
              ep::EpiG1 E{(bf16*)(ws + WS_QKV), (bf16*)out, (bf16*)out + (size_t)M * D, (bf16*)(ws + WS_QMEM), (bf16*)(ws + WS_HALO), out + O_CSP, out + O_CSS, RSX};
              pg8::gemm_phase<ep::EpiG1, pg8::ListG1, true, true>(lds, g, S, E); }
            const int e = c - (pg8::ListG1::NU - 2 * nq_);
            constexpr int NGU = (MS / 256) * (NGATE / 256), NKV = (NB * MEMT / 256) * (D / 256);
            if (e >= 0 && e < NGU) { pg8::Gemm g{XB, (const bf16*)(ws + WS_WIN) + (size_t)N1 * D, M, NGATE, D, D, D}; pg8::OneUnit S{MP / 256 + e / (NGATE / 256), e % (NGATE / 256)};
                ep::EpiGate E{(bf16*)(ws + WS_GATES_S) - (size_t)MP * NGATE, RSX, 0};
                pg8::gemm_phase<ep::EpiGate, pg8::OneUnit, true, true>(lds, g, S, E); }
            else if (e >= NGU && e < NGU + NKV) { const int k = e - NGU; pg8::Gemm g{(const bf16*)(ws + WS_MB), (const bf16*)(ws + WS_WKV), NB * MEMT, D, D, D, D}; pg8::OneUnit S{k / (D / 256), k % (D / 256)};
                ep::EpiKV E{out + O_MK, out + O_MV, (const float*)(ws + WS_RSTDM)};
                pg8::gemm_phase<ep::EpiKV, pg8::OneUnit, true, true>(lds, g, S, E); }
        }
        asm volatile("s_waitcnt vmcnt(0)" ::: "memory");
        __syncthreads();
        if (threadIdx.x == 0) {
            if (bx >= NB * H) { __builtin_amdgcn_fence(__ATOMIC_RELEASE, "agent"); asm volatile("s_waitcnt vmcnt(0)" ::: "memory"); (void)xb_add((unsigned*)sub, 1u); }
            XB_SPIN(xb_ld((unsigned*)sub) < (unsigned)(G - NB * H), (unsigned*)(ctl + CW_BAR) + args.li * XCD_BAR_WORDS);
            __builtin_amdgcn_fence(__ATOMIC_ACQUIRE, "agent"); asm volatile("s_waitcnt vmcnt(0)" ::: "memory");
        }
        __syncthreads();
        SgPtrs SP{(const bf16*)out + (size_t)M * D, (const bf16*)(ws + WS_SGW), args.in[I_SGW], args.in[I_SGB], args.in[I_SGN], (bf16*)(ws + WS_OCAT), out + O_SGV};
        const bf16* QM = (const bf16*)(ws + WS_QMEM); bf16* OC = (bf16*)(ws + WS_OCAT);
#ifndef SB_REP
#define SB_REP 1
#endif
#ifndef SG_REP
#define SG_REP 1
#endif
#ifndef PA_REP
#define PA_REP 1
#endif
#ifndef SA_REP
#define SA_REP 1
#endif
#ifndef SS_REP
#define SS_REP 1
#endif
        constexpr int QG = 0, Q0 = QG + SG_REP * (NB * 16), Q1 = Q0 + SB_REP * (DB * H / 4), Q2 = Q1 + PA_REP * (NB * MEMH * 8), Q3 = Q2 + SA_REP * (DB * MEMH), Q4 = Q3 + SS_REP * DB;
#define Q_FETCH() do { __syncthreads(); if (t_id() == 0) MISC[16] = __hip_atomic_fetch_add(ctl + 2048 + 64 * pass, 1u, __ATOMIC_RELAXED, __HIP_MEMORY_SCOPE_AGENT); __syncthreads(); q = (int)MISC[16]; } while (0)
        int q; Q_FETCH();
        while (q < Q0) { const int r = (q - QG) % (NB * 16); sg::sgu_item(lds, SP, r >> 4, r & 15); Q_FETCH(); }
        while (q < Q1) { dn::sample_batch(lds, DP, (q - Q0) % (DB * H / 4)); Q_FETCH(); }
        while (q < Q3) {
            const bf16* Qp; const float* Kp; const float* Vp; bf16* Op; int nq;
            if (q >= Q2) { const int r = (q - Q2) % (DB * MEMH), b = r >> 2, hd = r & 3; nq = 8;
                Qp = QM + (size_t)(MP + 8 * b) * MEMW + hd * 128; Kp = args.in[I_CK] + (size_t)b * MEMT * MEMW + hd * 128; Vp = args.in[I_CV] + (size_t)b * MEMT * MEMW + hd * 128; Op = OC + (size_t)(MP + 8 * b) * 2048 + 1536 + hd * 128; }
            else { const int r = (q - Q1) % (NB * MEMH * 8), b = r >> 5, hd = (r >> 3) & 3, qb = r & 7; const size_t row = (size_t)b * SEQ + 256 * qb; nq = 256;
                Qp = QM + row * MEMW + hd * 128; Kp = out + O_MK + (size_t)b * MEMT * MEMW + hd * 128; Vp = out + O_MV + (size_t)b * MEMT * MEMW + hd * 128; Op = OC + row * 2048 + 1536 + hd * 128; }
            at::attn_item(lds, Qp, nq, Kp, Vp, Op);
            Q_FETCH();
        }
        while (q < Q4) { sg::sgu_sample_item(lds, SP, (q - Q3) % DB); Q_FETCH(); }
#undef Q_FETCH
        __syncthreads();
    }
    SEAM(3);
#ifdef P3_FILL
    if (IN(4)) { u32x4* gp = (u32x4*)(ws + WS_GATES); const size_t n16 = (size_t)M * NGATE * 2 / 16;
        for (size_t i = (size_t)bx * 512 + t_id(); i < n16; i += (size_t)G * 512) { const unsigned w = 0x3f003e80u + (unsigned)(i & 63); gp[i] = (u32x4){w, w, w, w}; } }
    if (0) {
#else
    if (IN(4)) {
#endif
        pg8::Gemm g{XB, (const bf16*)(ws + WS_WIN) + (size_t)N1 * D, MP, NGATE, D, D, D}; pg8::StaticOrder S; S.init(MP, NGATE, G, bx);
#ifdef PROBE_SKIP_EPI
        ep::EpiGate E{(bf16*)(ws + WS_GATES), RSX, args.li};
#else
        ep::EpiGate E{(bf16*)(ws + WS_GATES), RSX, 0};
#endif
        pg8::gemm_phase<ep::EpiGate, pg8::StaticOrder, true, true>(lds, g, S, E);
    }
    SEAM(4);
    if (IN(5)) {
        const bf16* OC = (const bf16*)(ws + WS_OCAT); const bf16* WBR = (const bf16*)(ws + WS_WBR);
        const int koff[3] = {0, 1024, 1536}, klen[3] = {1024, 512, 512};
#pragma unroll
        for (int b = 0; b < 3; ++b) {
#ifdef P4_PASSES
            if (!((P4_PASSES >> b) & 1)) continue;
#endif
            pg8::Gemm g{OC + koff[b], WBR + koff[b], MP, D, klen[b], 2048, 2048}; pg8::StaticOrder S; S.init(MP, D, G, bx);
            ep::EpiBr E{(const bf16*)(ws + WS_GATES), (bf16*)(ws + WS_MERGED), b};
            pg8::gemm_phase<ep::EpiBr, pg8::StaticOrder, true, true>(lds, g, S, E);
        }
        { const mini::MiniPtrs MPp{OC, WBR, (const bf16*)(ws + WS_GATES_S) - (size_t)MP * NGATE, (bf16*)(ws + WS_MERGED), nullptr, nullptr, nullptr, nullptr, nullptr, nullptr, nullptr, nullptr};
#ifndef DUP_MINI
#define DUP_MINI 1
#endif
          for (int rep = 0; rep < DUP_MINI; ++rep) for (int t = bx; t < 256; t += G) mini::br_tile(lds, MPp, mini::tile_of(t)); }
    }
    SEAM(5);
    if (IN(6)) {
        pg8::Gemm g{(const bf16*)(ws + WS_MERGED), (const bf16*)(ws + WS_WO), MP, D, D, D, D}; pg8::StaticOrder S; S.init(MP, D, G, bx);
        ep::EpiRes E{args.in[I_XP], args.in[I_XS], nullptr, nullptr, (bf16*)(ws + WS_X1B), (float*)(ws + WS_SS1)};
        pg8::gemm_phase<ep::EpiRes, pg8::StaticOrder, true, true>(lds, g, S, E);
        for (int t = bx; t < 256; t += G) mini::res_tile(lds, (const bf16*)(ws + WS_MERGED), D, (const bf16*)(ws + WS_WO), D, D, args.in[I_XS], MP, nullptr, nullptr, (bf16*)(ws + WS_X1B), (float*)(ws + WS_SS1), mini::tile_of(t));
        __syncthreads();
    }
    SEAM(6);
    if (IN(7)) {
#ifdef STAGGER
        if ((bx >> 3) & 1) stagger_delay(STAGGER);
#endif
        pg8::Gemm g{(const bf16*)(ws + WS_X1B), (const bf16*)(ws + WS_WGU), M, 2 * FF, D, D, D}; pg8::StaticOrder S; S.init(M, 2 * FF, G, bx);
        ep::EpiGU E{(const float*)(ws + WS_SS1), (bf16*)(ws + WS_HB)};
        pg8::gemm_phase<ep::EpiGU, pg8::StaticOrder, true, true>(lds, g, S, E);
    }
    SEAM(7);
    if (IN(8)) {
        pg8::Gemm g{(const bf16*)(ws + WS_HB), (const bf16*)(ws + WS_WDN), MP, D, FF, FF, FF}; pg8::StaticOrder S; S.init(MP, D, G, bx);
        ep::EpiFinal E{(const bf16*)(ws + WS_X1B), args.in[I_NFIN], out + O_Y, (float*)(ws + WS_SS2), (unsigned*)(ctl + CW_FIN), (unsigned*)(ctl + CW_TMO)};
        pg8::gemm_phase<ep::EpiFinal, pg8::StaticOrder, false, true>(lds, g, S, E);
        for (int t = bx; t < 256; t += G) mini::fin_tile(lds, (const bf16*)(ws + WS_HB), FF, (const bf16*)(ws + WS_WDN), FF, FF, (const bf16*)(ws + WS_X1B), args.in[I_NFIN], out + O_Y, (float*)(ws + WS_SS2), (unsigned*)(ctl + CW_FIN2), (unsigned*)(ctl + CW_TMO), mini::tile_of(t));
    }
#undef IN
#undef SEAM
}

extern "C" void kernel_launch(void* const* d_in, const int* in_sizes, int n_in, void* d_out, int out_size, void* d_ws, size_t ws_size, hipStream_t stream) {
    static int grid = 0;
    if (grid == 0) {
        if (n_in != 26 || in_sizes[0] != MP * D || (size_t)out_size != O_END || ws_size < WS_END) { fprintf(stderr, "kernel_launch: unexpected shapes (n_in %d, in0 %d, out %d, ws %zu < %zu); nothing launched\n", n_in, n_in > 0 ? in_sizes[0] : -1, out_size, ws_size, (size_t)WS_END); grid = -1; return; }
        int dev = 0, cus = 0, per_cu = 0;
        if (hipGetDevice(&dev) != hipSuccess || hipDeviceGetAttribute(&cus, hipDeviceAttributeMultiprocessorCount, dev) != hipSuccess) { grid = -1; return; }
        if (hipFuncSetAttribute((const void*)hyb_fwd, hipFuncAttributeMaxDynamicSharedMemorySize, LDS_BYTES) != hipSuccess) { fprintf(stderr, "kernel_launch: hipFuncSetAttribute failed\n"); grid = -1; return; }
        if (hipOccupancyMaxActiveBlocksPerMultiprocessor(&per_cu, (const void*)hyb_fwd, NWAVES * 64, LDS_BYTES) != hipSuccess || per_cu < 1) fprintf(stderr, "kernel_launch: occupancy query reports %d blocks per CU\n", per_cu);
        (void)hipGetLastError();
        grid = cus;
        if (cus != 256) { fprintf(stderr, "kernel_launch: built for a 256-CU device (one 256x256 unit per CU in the N = 1024 projections, fused row-statistics exchanges); found %d CUs; nothing launched\n", cus); grid = -1; return; }
    }
    if (grid < 0) return;
    if (hipMemsetAsync((char*)d_ws + WS_CTL, 0, CTL_ZERO_BYTES, stream) != hipSuccess) return;
    Args a{};
    for (int i = 0; i < 26; ++i) a.in[i] = (const float*)d_in[i];
    a.out = (float*)d_out; a.ws = (unsigned char*)d_ws;
#if MK_N_LAUNCHES == 1
    a.ph_lo = 0; a.ph_hi = N_PHASES;
    hipLaunchKernelGGL(hyb_fwd, dim3(grid), dim3(NWAVES * 64), LDS_BYTES, stream, a);
#elif MK_N_LAUNCHES == 2
    a.ph_lo = 0; a.ph_hi = PROBE_HI + 1; a.li = 0; hipLaunchKernelGGL(hyb_fwd, dim3(grid), dim3(NWAVES * 64), LDS_BYTES, stream, a);
    a.ph_lo = PROBE_LO; a.ph_hi = N_PHASES; a.li = 1; hipLaunchKernelGGL(hyb_fwd, dim3(grid), dim3(NWAVES * 64), LDS_BYTES, stream, a);
#else
    for (int p = 0; p < N_PHASES; ++p) { a.ph_lo = p; a.ph_hi = p + 1; hipLaunchKernelGGL(hyb_fwd, dim3(grid), dim3(NWAVES * 64), LDS_BYTES, stream, a); }
#endif
}
#endif
```
